# Optimizing an MI355X kernel written in HIP

```python
import math
import jax, jax.numpy as jnp
from jax import lax
import numpy as np

D_MODEL = 2048
BATCH = 2
SEQ = 8192
DEPTH = 2

CHUNK = 64
N_MIXERS = 2
N_RET_LAYERS = (DEPTH + 1) // 2
N_SSD_LAYERS = DEPTH // 2
RMS_EPS = 1e-6

RET_HEAD_DK = 256
RET_HEADS = D_MODEL // RET_HEAD_DK
RET_QK = RET_HEADS * RET_HEAD_DK
RET_HEAD_DV = 2 * RET_HEAD_DK
RET_V = RET_HEADS * RET_HEAD_DV
RET_IN = 2 * RET_QK + 2 * RET_V
ROPE_BASE = 10000.0
GN_EPS = 1e-5

SSD_EXPAND = 2
SSD_D_INNER = SSD_EXPAND * D_MODEL
SSD_HEADDIM = 64
SSD_HEADS = SSD_D_INNER // SSD_HEADDIM
SSD_GROUPS = 8
SSD_HEADS_PER_GROUP = SSD_HEADS // SSD_GROUPS
SSD_STATE = 128
SSD_CONV_W = 4
SSD_CONV_DIM = SSD_D_INNER + 2 * SSD_GROUPS * SSD_STATE
SSD_IN = SSD_D_INNER + SSD_CONV_DIM + SSD_HEADS
SSD_NORM_GROUPS = SSD_GROUPS

D_FF = 4 * D_MODEL

kernel_name = "hybrid_retention_ssd_sandwich_trunk"


def rms_norm(x, w):
    xf = x.astype(jnp.float32)
    y = xf * lax.rsqrt(jnp.mean(xf * xf, axis=-1, keepdims=True) + RMS_EPS)
    return (y * w.astype(jnp.float32)).astype(x.dtype)


def to_chunks(t):
    b, s = t.shape[:2]
    return jnp.moveaxis(t.reshape(b, s // CHUNK, CHUNK, *t.shape[2:]), 1, 0)


def from_chunks(t):
    t = jnp.moveaxis(t, 0, 1)
    return t.reshape(t.shape[0], t.shape[1] * t.shape[2], *t.shape[3:])


def rotary(t, pos):
    half = t.shape[-1] // 2
    inv_freq = ROPE_BASE ** (-jnp.arange(half, dtype=jnp.float32) / half)
    ang = pos.astype(jnp.float32)[:, None] * inv_freq[None, :]
    cos = jnp.cos(ang)[None, :, None, :]
    sin = jnp.sin(ang)[None, :, None, :]
    t1, t2 = t[..., :half], t[..., half:]
    return jnp.concatenate([t1 * cos - t2 * sin, t1 * sin + t2 * cos], axis=-1)


def retention_mixer(u, w_in, gn_w, w_out):
    b, s, _ = u.shape
    f32 = jnp.float32
    proj = u @ w_in
    q, k, v, g = jnp.split(proj, [RET_QK, 2 * RET_QK, 2 * RET_QK + RET_V], axis=-1)
    pos = jnp.arange(s)
    q = rotary(q.astype(f32).reshape(b, s, RET_HEADS, RET_HEAD_DK), pos)
    k = rotary(k.astype(f32).reshape(b, s, RET_HEADS, RET_HEAD_DK), pos) * (RET_HEAD_DK ** -0.5)
    v = v.astype(f32).reshape(b, s, RET_HEADS, RET_HEAD_DV)

    log_gamma = jnp.log1p(-jnp.exp2(-5.0 - jnp.arange(RET_HEADS, dtype=f32)))
    idx = jnp.arange(CHUNK, dtype=f32)
    dist = jnp.abs(idx[:, None] - idx[None, :])
    dmat = jnp.exp(dist[None] * log_gamma[:, None, None])
    xi = jnp.exp((idx[:, None] + 1.0) * log_gamma[None, :])
    zeta = jnp.exp((CHUNK - 1.0 - idx)[:, None] * log_gamma[None, :])
    chunk_decay = jnp.exp(CHUNK * log_gamma)

    def step(state, inp):
        qc, kc, vc = inp
        scores = jnp.einsum('blhd,bmhd->bhlm', qc, kc) * dmat[None]
        inner = jnp.einsum('bhlm,bmhv->blhv', scores, vc)
        cross = jnp.einsum('blhd,bhdv->blhv', qc, state) * xi[None, :, :, None]
        state = state * chunk_decay[None, :, None, None] + jnp.einsum(
            'bmhd,bmhv->bhdv', kc * zeta[None, :, :, None], vc)
        return state, inner + cross

    state0 = jnp.zeros((b, RET_HEADS, RET_HEAD_DK, RET_HEAD_DV), f32)
    _, o = lax.scan(step, state0, (to_chunks(q), to_chunks(k), to_chunks(v)))
    o = from_chunks(o)
    mu = jnp.mean(o, axis=-1, keepdims=True)
    var = jnp.mean(jnp.square(o - mu), axis=-1, keepdims=True)
    o = ((o - mu) * lax.rsqrt(var + GN_EPS)).reshape(b, s, RET_V) * gn_w.astype(f32)
    y = jax.nn.silu(g.astype(f32)) * o
    return y.astype(u.dtype) @ w_out


def causal_depthwise_conv(t, w, bias):
    s = t.shape[1]
    width = w.shape[0]
    tp = jnp.pad(t, ((0, 0), (width - 1, 0), (0, 0)))
    out = bias[None, None, :]
    for tap in range(width):
        out = out + tp[:, tap:tap + s, :] * w[tap][None, None, :]
    return out


def ssd_mixer(u, w_in, conv_w, conv_b, dt_bias, a_log, d_skip, norm_w, w_out):
    b, s, _ = u.shape
    f32 = jnp.float32
    G, R, P, N = SSD_GROUPS, SSD_HEADS_PER_GROUP, SSD_HEADDIM, SSD_STATE
    proj = u @ w_in
    z, xbc, dt = jnp.split(proj, [SSD_D_INNER, SSD_D_INNER + SSD_CONV_DIM], axis=-1)
    xbc = jax.nn.silu(causal_depthwise_conv(xbc, conv_w, conv_b))
    xs, bm, cm = jnp.split(xbc, [SSD_D_INNER, SSD_D_INNER + G * N], axis=-1)
    xs = xs.astype(f32).reshape(b, s, G, R, P)
    bm = bm.astype(f32).reshape(b, s, G, N)
    cm = cm.astype(f32).reshape(b, s, G, N)
    dt = jax.nn.softplus(dt.astype(f32) + dt_bias.astype(f32)).reshape(b, s, G, R)
    a = -jnp.exp(a_log.astype(f32)).reshape(G, R)
    da = dt * a[None, None]
    xdt = xs * dt[..., None]
    tril = jnp.tril(jnp.ones((CHUNK, CHUNK), dtype=bool))

    def step(state, inp):
        xc, ac, bc, cc = inp
        acum = jnp.cumsum(ac, axis=1)
        seg = acum[:, :, None] - acum[:, None, :]
        lmat = jnp.exp(jnp.where(tril[None, :, :, None, None], seg, -jnp.inf))
        cb = jnp.einsum('blgn,bsgn->blsg', cc, bc)
        y_diag = jnp.einsum('blsgr,bsgrp->blgrp', cb[..., None] * lmat, xc)
        y_off = jnp.einsum('blgn,bgrpn->blgrp', cc, state) * jnp.exp(acum)[..., None]
        decay_to_end = jnp.exp(acum[:, -1:] - acum)
        state = state * jnp.exp(acum[:, -1])[..., None, None] + jnp.einsum(
            'bsgn,bsgrp->bgrpn', bc, xc * decay_to_end[..., None])
        return state, y_diag + y_off

    state0 = jnp.zeros((b, G, R, P, N), f32)
    _, ys = lax.scan(step, state0, (to_chunks(xdt), to_chunks(da), to_chunks(bm), to_chunks(cm)))
    y = from_chunks(ys) + d_skip.astype(f32).reshape(G, R)[None, None, :, :, None] * xs
    y = y.reshape(b, s, SSD_D_INNER) * jax.nn.silu(z.astype(f32))
    yg = y.reshape(b, s, SSD_NORM_GROUPS, SSD_D_INNER // SSD_NORM_GROUPS)
    yg = yg * lax.rsqrt(jnp.mean(yg * yg, axis=-1, keepdims=True) + RMS_EPS)
    y = yg.reshape(b, s, SSD_D_INNER) * norm_w.astype(f32)
    return y.astype(u.dtype) @ w_out


def sq_relu_mlp(u, w_up, w_down):
    h = jax.nn.relu(u @ w_up)
    return (h * h) @ w_down


def setup_inputs(seed: int = 0) -> dict:
    key = jax.random.key(seed)
    ks = jax.random.split(key, 20)
    f32 = jnp.float32

    def nrm(k, shape, scale):
        return jax.random.normal(k, shape, f32) * scale

    def gain(k, shape):
        return 1.0 + 0.05 * jax.random.normal(k, shape, f32)

    x = jax.random.normal(ks[0], (BATCH, SEQ, D_MODEL), f32)
    norm_mix_pre = gain(ks[1], (DEPTH, D_MODEL))
    norm_mix_post = gain(ks[2], (DEPTH, D_MODEL))
    norm_ffn_pre = gain(ks[3], (DEPTH, D_MODEL))
    norm_ffn_post = gain(ks[4], (DEPTH, D_MODEL))

    ret_w_in = nrm(ks[5], (N_RET_LAYERS, D_MODEL, RET_IN), D_MODEL ** -0.5)
    ret_gn_w = gain(ks[6], (N_RET_LAYERS, RET_V))
    ret_w_out = nrm(ks[7], (N_RET_LAYERS, RET_V, D_MODEL), RET_V ** -0.5)

    ssd_w_in = nrm(ks[8], (N_SSD_LAYERS, D_MODEL, SSD_IN), D_MODEL ** -0.5)
    ssd_conv_w = nrm(ks[9], (N_SSD_LAYERS, SSD_CONV_W, SSD_CONV_DIM), SSD_CONV_W ** -0.5)
    ssd_conv_b = nrm(ks[10], (N_SSD_LAYERS, SSD_CONV_DIM), 0.02)
    dt0 = jnp.exp(jax.random.uniform(ks[11], (N_SSD_LAYERS, SSD_HEADS), f32,
                                     math.log(1e-3), math.log(1e-1)))
    ssd_dt_bias = dt0 + jnp.log(-jnp.expm1(-dt0))
    ssd_a_log = jnp.log(jax.random.uniform(ks[12], (N_SSD_LAYERS, SSD_HEADS), f32, 1.0, 16.0))
    ssd_d = gain(ks[13], (N_SSD_LAYERS, SSD_HEADS))
    ssd_norm_w = gain(ks[14], (N_SSD_LAYERS, SSD_D_INNER))
    ssd_w_out = nrm(ks[15], (N_SSD_LAYERS, SSD_D_INNER, D_MODEL), SSD_D_INNER ** -0.5)

    mlp_w_up = nrm(ks[16], (DEPTH, D_MODEL, D_FF), D_MODEL ** -0.5)
    mlp_w_down = nrm(ks[17], (DEPTH, D_FF, D_MODEL), D_FF ** -0.5)

    return {"x": x,
            "norm_mix_pre": norm_mix_pre, "norm_mix_post": norm_mix_post,
            "norm_ffn_pre": norm_ffn_pre, "norm_ffn_post": norm_ffn_post,
            "ret_w_in": ret_w_in, "ret_gn_w": ret_gn_w, "ret_w_out": ret_w_out,
            "ssd_w_in": ssd_w_in, "ssd_conv_w": ssd_conv_w, "ssd_conv_b": ssd_conv_b,
            "ssd_dt_bias": ssd_dt_bias, "ssd_a_log": ssd_a_log, "ssd_d": ssd_d,
            "ssd_norm_w": ssd_norm_w, "ssd_w_out": ssd_w_out,
            "mlp_w_up": mlp_w_up, "mlp_w_down": mlp_w_down}


def reference(x, norm_mix_pre, norm_mix_post, norm_ffn_pre, norm_ffn_post,
              ret_w_in, ret_gn_w, ret_w_out,
              ssd_w_in, ssd_conv_w, ssd_conv_b, ssd_dt_bias, ssd_a_log, ssd_d,
              ssd_norm_w, ssd_w_out, mlp_w_up, mlp_w_down):
    h = x
    for i in range(DEPTH):
        j = i // N_MIXERS
        u = rms_norm(h, norm_mix_pre[i])
        if i % N_MIXERS == 0:
            m = retention_mixer(u, ret_w_in[j], ret_gn_w[j], ret_w_out[j])
        else:
            m = ssd_mixer(u, ssd_w_in[j], ssd_conv_w[j], ssd_conv_b[j], ssd_dt_bias[j],
                          ssd_a_log[j], ssd_d[j], ssd_norm_w[j], ssd_w_out[j])
        h = h + rms_norm(m, norm_mix_post[i])
        u = rms_norm(h, norm_ffn_pre[i])
        h = h + rms_norm(sq_relu_mlp(u, mlp_w_up[i], mlp_w_down[i]), norm_ffn_post[i])
    return h
```

```cpp
#include <hip/hip_runtime.h>
#include <hip/hip_cooperative_groups.h>
#include <cstdio>
namespace cg = cooperative_groups;

#define LAS __attribute__((address_space(3)))
typedef unsigned short bf16_t;
typedef short bf16x8 __attribute__((ext_vector_type(8)));
typedef short s16x4 __attribute__((ext_vector_type(4)));
typedef float f32x4 __attribute__((ext_vector_type(4)));
typedef float f32x2 __attribute__((ext_vector_type(2)));
typedef unsigned u32x4 __attribute__((ext_vector_type(4)));
typedef unsigned u32x2 __attribute__((ext_vector_type(2)));

constexpr int T = 16384, DM = 2048, SEQ = 8192;
constexpr int RIN = 12288;
constexpr int SIN = 10304, SINP = 10496;
constexpr int DFF = 8192;
constexpr int NTHREADS = 512;
constexpr int LDS_BYTES = 131072;

constexpr size_t OFF_WA = 0;
constexpr size_t OFF_WB = 50331648;
constexpr size_t OFF_ACT = OFF_WB + 33554432;
constexpr size_t ACT_BYTES = 402653184;
constexpr size_t HID_BYTES = 268435456;
constexpr size_t OFF_R2 = OFF_ACT + ACT_BYTES;
constexpr size_t R2_BYTES = 134217728;
constexpr size_t OFF_ROT = OFF_R2 + 67108864;
constexpr size_t OFF_HALO = OFF_R2 + 67108864;
constexpr size_t OFF_DTV = OFF_R2 + 67108864 + 16777216;
constexpr size_t WS_END = OFF_R2 + R2_BYTES;

__device__ __forceinline__ unsigned f2bf(float f) { unsigned u = __float_as_uint(f); return (u + 0x7fffu + ((u >> 16) & 1u)) >> 16; }
__device__ __forceinline__ unsigned pk2(float lo, float hi) { return f2bf(lo) | (f2bf(hi) << 16); }
__device__ __forceinline__ float bflo(unsigned w) { return __uint_as_float(w << 16); }
__device__ __forceinline__ float bfhi(unsigned w) { return __uint_as_float(w & 0xffff0000u); }
__device__ __forceinline__ float bf2f(bf16_t b) { return __uint_as_float(((unsigned)b) << 16); }
__device__ __forceinline__ unsigned cvt_pk_bf16(float lo, float hi) { unsigned r; asm volatile("v_cvt_pk_bf16_f32 %0, %1, %2" : "=v"(r) : "v"(lo), "v"(hi)); return r; }
__device__ __forceinline__ float wave_sum(float v) {
#pragma unroll
    for (int o = 32; o >= 1; o >>= 1) v += __shfl_xor(v, o);
    return v;
}
__device__ __forceinline__ int otid() { int t = threadIdx.x; asm volatile("" : "+v"(t)); return t; }
__device__ __forceinline__ float silu(float x) { return x / (1.0f + __expf(-x)); }

__device__ __forceinline__ bf16x8 tr_frag(LAS unsigned char* img, int rs, int kbase, int n0, int lane) {
    const int g = lane >> 4, q = (lane & 15) >> 2, p = lane & 3;
    LAS unsigned char* a0 = img + (kbase + 8 * g + q) * rs + (n0 + 4 * p) * 2;
    s16x4 a = __builtin_amdgcn_ds_read_tr16_b64_v4i16((LAS s16x4*)a0);
    s16x4 b = __builtin_amdgcn_ds_read_tr16_b64_v4i16((LAS s16x4*)(a0 + 4 * rs));
    bf16x8 r = {a[0], a[1], a[2], a[3], b[0], b[1], b[2], b[3]};
    return r;
}

namespace pg8 {
constexpr int BM = 256, BK = 64, HALF = 128, HTB = HALF * BK * 2, STAGE_BYTES = 8 * HTB, NXCD = 8, WGM = 8;
__device__ __forceinline__ int lds_byte(int r, int c) { const int st = (r >> 4) * 2 + (c >> 5), rr = r & 15, cc = c & 31, ob = rr * 64 + cc * 2; return st * 1024 + (ob ^ (((ob >> 9) & 1) << 5)); }
__device__ __forceinline__ void stage_rc(int b, int& R, int& C) { const int st = b / 1024, sb = b % 1024, swz = sb ^ (((sb >> 9) & 1) << 5); R = (st >> 1) * 16 + swz / 64; C = (st & 1) * 32 + (swz % 64) / 2; }
__device__ __forceinline__ int perm32(int rho) { const int n = rho >> 4, i = rho & 15; return 8 * (i >> 2) + 4 * n + (i & 3); }
struct Unit { int pm, pn; };
struct Gemm { const bf16_t* A; const bf16_t* Bt; int M, N, K, lda; int kind; void* out; int ldc; const float* rot; };
struct StaticOrder {
    int nM, nN, nwg, G, c;
    __device__ void init(int M, int N, int G_, int c_) { nM = M / BM; nN = N / BM; nwg = nM * nN; G = G_; c = c_; }
    __device__ bool next(int i, Unit& u) const {
        const long L = (long)i * G + c; if (L >= nwg) return false;
        int wgid = (int)L; { const int q = nwg / NXCD, r = nwg % NXCD, xcd = wgid % NXCD, off = wgid / NXCD; wgid = (xcd < r ? xcd * (q + 1) : r * (q + 1) + (xcd - r) * q) + off; }
        const int nig = WGM * nN, gid = wgid / nig, fm = gid * WGM, gsz = (nM - fm) < WGM ? (nM - fm) : WGM;
        u.pm = fm + ((wgid % nig) % gsz); u.pn = (wgid % nig) / gsz; return true;
    }
};

template <int KIND> __device__ __forceinline__ void epilogue(const Gemm& g, const f32x4 (&acc)[2][2][4][2], const Unit& u, int wr, int wc, int fr, int fq) {
    if constexpr (KIND == 0) {
        float* C = (float*)g.out; const int ldc = g.ldc;
        const int row0 = u.pm * BM + wr * 64 + fr, col0 = u.pn * BM + wc * 32 + 4 * fq;
#pragma unroll
        for (int ai = 0; ai < 2; ++ai)
#pragma unroll
            for (int m = 0; m < 4; ++m) { float* rowp = C + (size_t)(row0 + ai * HALF + m * 16) * ldc + col0;
#pragma unroll
                for (int bj = 0; bj < 2; ++bj)
#pragma unroll
                    for (int n = 0; n < 2; ++n) *(f32x4*)(rowp + bj * HALF + n * 16) = acc[ai][bj][m][n]; }
    } else {
        bf16_t* O = (bf16_t*)g.out; const int ldc = g.ldc;
        const int row0 = u.pm * BM + wr * 64 + fr, col0 = u.pn * BM + wc * 32 + 8 * fq;
        const bool isrot = (KIND == 3) && (u.pn < 16);
        const float sc = (u.pn >= 8) ? 0.0625f : 1.0f;
        constexpr bool relu2 = (KIND == 2);
#pragma unroll
        for (int ai = 0; ai < 2; ++ai)
#pragma unroll
            for (int m = 0; m < 4; ++m) {
                const int row = row0 + ai * HALF + m * 16;
                bf16_t* rowp = O + (size_t)row * ldc + col0;
                const int pos = row & (SEQ - 1);
#pragma unroll
                for (int bj = 0; bj < 2; ++bj) {
                    f32x4 v0 = acc[ai][bj][m][0], v1 = acc[ai][bj][m][1];
                    if (relu2) {
#pragma unroll
                        for (int j = 0; j < 4; ++j) { const float a = fmaxf(v0[j], 0.f), b = fmaxf(v1[j], 0.f); v0[j] = a * a; v1[j] = b * b; }
                    }
                    if (isrot) {
                        const float* rp = g.rot + ((size_t)pos * 128 + 64 * bj + 16 * wc + 4 * fq) * 2;
                        const f32x4 c0 = *(const f32x4*)rp, c1 = *(const f32x4*)(rp + 4);
                        f32x4 r0, r1;
                        r0[0] = v0[0] * c0[0] - v0[1] * c0[1]; r0[1] = v0[0] * c0[1] + v0[1] * c0[0];
                        r0[2] = v0[2] * c0[2] - v0[3] * c0[3]; r0[3] = v0[2] * c0[3] + v0[3] * c0[2];
                        r1[0] = v1[0] * c1[0] - v1[1] * c1[1]; r1[1] = v1[0] * c1[1] + v1[1] * c1[0];
                        r1[2] = v1[2] * c1[2] - v1[3] * c1[3]; r1[3] = v1[2] * c1[3] + v1[3] * c1[2];
                        v0 = r0 * sc; v1 = r1 * sc;
                    }
                    u32x4 w; w.x = cvt_pk_bf16(v0[0], v0[1]); w.y = cvt_pk_bf16(v0[2], v0[3]); w.z = cvt_pk_bf16(v1[0], v1[1]); w.w = cvt_pk_bf16(v1[2], v1[3]);
                    *(u32x4*)(rowp + bj * HALF) = w;
                }
            }
    }
}

template <int KIND> __device__ __forceinline__ void gemm_phase(LAS unsigned char* lds, const Gemm g, const StaticOrder& S) {
    const int tid = otid(), wid = __builtin_amdgcn_readfirstlane(tid >> 6), lane = tid & 63, wr = wid >> 2, wc = wid & 3, fr = lane & 15, fq = lane >> 4;
    const int K = g.K, nt = K / BK, lda = g.lda;
    constexpr bool perm = KIND != 0;
    unsigned voffA[2], voffB[2];
#pragma unroll
    for (int i = 0; i < 2; ++i) { int R, C; stage_rc(tid * 16 + i * 8192, R, C); const int Rb = perm ? ((R & ~31) + perm32(R & 31)) : R;
        voffA[i] = (unsigned)(R * lda + C) * 2u; voffB[i] = (unsigned)(Rb * K + C) * 2u; }
    const size_t kstep = (size_t)(BK * 2);
    const size_t hstepA = (size_t)HALF * lda * 2, hstepB = (size_t)HALF * K * 2;
    const size_t tstepA = 2 * hstepA, tstepB = 2 * hstepB;
    const unsigned ldsw = (unsigned)wid * 1024u;
    const int aoff = lds_byte(wr * 64 + fr, fq * 8), boff = lds_byte(wc * 32 + fr, fq * 8);
#define PG8_SA(b, h) (((b) * 2 + (h)) * HTB)
#define PG8_SB(b, h) ((4 + (b) * 2 + (h)) * HTB)
#define PG8_STAGE(bufoff, gbase, voff) do { _Pragma("unroll") for (int _i = 0; _i < 2; ++_i) \
        __builtin_amdgcn_global_load_lds((const unsigned*)((const char*)(gbase) + (voff)[_i]), (LAS unsigned*)(lds + (bufoff) + ldsw + _i * 8192), 16, 0, 0); } while (0)
#define PG8_LDA(dst, b, h) do { _Pragma("unroll") for (int m = 0; m < 4; ++m) _Pragma("unroll") for (int k = 0; k < 2; ++k) dst[m][k] = *(const LAS bf16x8*)(lds + PG8_SA(b, h) + aoff + m * 2048 + k * 1024); } while (0)
#define PG8_LDB(dst, b, h) do { _Pragma("unroll") for (int n = 0; n < 2; ++n) _Pragma("unroll") for (int k = 0; k < 2; ++k) dst[n][k] = *(const LAS bf16x8*)(lds + PG8_SB(b, h) + boff + n * 2048 + k * 1024); } while (0)
#define PG8_MMA(ai, bj, At, Bt) do { __builtin_amdgcn_s_setprio(1); _Pragma("unroll") for (int m = 0; m < 4; ++m) _Pragma("unroll") for (int n = 0; n < 2; ++n) _Pragma("unroll") for (int k = 0; k < 2; ++k) \
        acc[ai][bj][m][n] = __builtin_amdgcn_mfma_f32_16x16x32_bf16(Bt[n][k], At[m][k], acc[ai][bj][m][n], 0, 0, 0); __builtin_amdgcn_s_setprio(0); } while (0)
#define PG8_WAIT_V(n) asm volatile("s_waitcnt vmcnt(" #n ")" ::: "memory")
#define PG8_WAIT_L(n) asm volatile("s_waitcnt lgkmcnt(" #n ")" ::: "memory")
#define PG8_BAR __builtin_amdgcn_s_barrier()
#define PG8_SCHED __builtin_amdgcn_sched_barrier(0)
    Unit cur, nxt; int ui = 0;
    if (!S.next(0, cur)) return;
    f32x4 acc[2][2][4][2];
#pragma unroll
    for (int a = 0; a < 2; ++a)
#pragma unroll
        for (int b = 0; b < 2; ++b)
#pragma unroll
            for (int m = 0; m < 4; ++m)
#pragma unroll
                for (int n = 0; n < 2; ++n) acc[a][b][m][n] = (f32x4){0.f, 0.f, 0.f, 0.f};
    bf16x8 At[4][2], B0[2][2], B1[2][2];
    const char* cA = (const char*)g.A + (size_t)cur.pm * tstepA; const char* cB = (const char*)g.Bt + (size_t)cur.pn * tstepB;
    PG8_STAGE(PG8_SB(0, 0), cB, voffB); PG8_STAGE(PG8_SA(0, 0), cA, voffA); PG8_STAGE(PG8_SB(0, 1), cB + hstepB, voffB); PG8_STAGE(PG8_SA(0, 1), cA + hstepA, voffA);
    if (wr == 1) PG8_BAR;
    PG8_WAIT_V(4); PG8_BAR;
    PG8_STAGE(PG8_SB(1, 0), cB + kstep, voffB); PG8_STAGE(PG8_SA(1, 0), cA + kstep, voffA); PG8_STAGE(PG8_SB(1, 1), cB + hstepB + kstep, voffB);
    PG8_WAIT_V(6); PG8_BAR;
    for (;;) {
        const bool has_next = S.next(ui + 1, nxt);
        const char* nA = has_next ? (const char*)g.A + (size_t)nxt.pm * tstepA : cA; const char* nB = has_next ? (const char*)g.Bt + (size_t)nxt.pn * tstepB : cB;
        for (int t = 0; t < nt; t += 2) {
            const bool last = (t == nt - 2);
            const char* a1 = cA + (size_t)(t + 1) * kstep;
            const char* a2 = last ? nA : cA + (size_t)(t + 2) * kstep; const char* b2 = last ? nB : cB + (size_t)(t + 2) * kstep;
            const char* a3 = a2 + kstep; const char* b3 = b2 + kstep;
            PG8_LDB(B0, 0, 0); PG8_SCHED; PG8_LDA(At, 0, 0); PG8_STAGE(PG8_SA(1, 1), a1 + hstepA, voffA);
            PG8_WAIT_L(8); PG8_BAR; PG8_WAIT_L(0); PG8_MMA(0, 0, At, B0); PG8_BAR; PG8_SCHED;
            PG8_LDB(B1, 0, 1); PG8_STAGE(PG8_SB(0, 0), b2, voffB);
            PG8_BAR; PG8_WAIT_L(0); PG8_MMA(0, 1, At, B1); PG8_BAR;
            PG8_LDA(At, 0, 1); PG8_STAGE(PG8_SA(0, 0), a2, voffA);
            PG8_BAR; PG8_WAIT_L(0); PG8_MMA(1, 0, At, B0); PG8_BAR; PG8_SCHED;
            PG8_STAGE(PG8_SB(0, 1), b2 + hstepB, voffB);
            PG8_WAIT_V(6); PG8_BAR; PG8_MMA(1, 1, At, B1); PG8_BAR;
            PG8_LDB(B0, 1, 0); PG8_SCHED; PG8_LDA(At, 1, 0); PG8_STAGE(PG8_SA(0, 1), a2 + hstepA, voffA);
            PG8_WAIT_L(8); PG8_BAR; PG8_WAIT_L(0); PG8_MMA(0, 0, At, B0); PG8_BAR; PG8_SCHED;
            PG8_LDB(B1, 1, 1); PG8_STAGE(PG8_SB(1, 0), b3, voffB);
            PG8_BAR; PG8_WAIT_L(0); PG8_MMA(0, 1, At, B1); PG8_BAR;
            PG8_LDA(At, 1, 1); PG8_STAGE(PG8_SA(1, 0), a3, voffA);
            PG8_BAR; PG8_WAIT_L(0); PG8_MMA(1, 0, At, B0); PG8_BAR; PG8_SCHED;
            PG8_STAGE(PG8_SB(1, 1), b3 + hstepB, voffB);
            PG8_WAIT_V(6); PG8_BAR; PG8_MMA(1, 1, At, B1); PG8_BAR;
        }
        epilogue<KIND>(g, acc, cur, wr, wc, fr, fq);
        if (!has_next) break;
#pragma unroll
        for (int a = 0; a < 2; ++a)
#pragma unroll
            for (int b = 0; b < 2; ++b)
#pragma unroll
                for (int m = 0; m < 4; ++m)
#pragma unroll
                    for (int n = 0; n < 2; ++n) acc[a][b][m][n] = (f32x4){0.f, 0.f, 0.f, 0.f};
        cur = nxt; cA = nA; cB = nB; ++ui;
    }
    PG8_WAIT_V(0);
    if (wr == 0) PG8_BAR;
    PG8_BAR;
#undef PG8_SA
#undef PG8_SB
#undef PG8_STAGE
#undef PG8_LDA
#undef PG8_LDB
#undef PG8_MMA
#undef PG8_WAIT_V
#undef PG8_WAIT_L
#undef PG8_BAR
#undef PG8_SCHED
}
}

struct ConvDesc { const float* src; bf16_t* dst; int K, Nsrc, Ndst, permq; };
__device__ __forceinline__ void convert_w(const ConvDesc& c, LAS unsigned char* lds, int wg, int G) {
    LAS float* tl = (LAS float*)lds;
    const int tid = otid();
    const int nkt = c.K / 64, nnt = c.Ndst / 64;
    for (int u = wg; u < nkt * nnt; u += G) {
        const int nt = u % nnt, kt = u / nnt, k0 = kt * 64, n0 = nt * 64;
        {
            const int n = tid & 63, nn = n0 + n;
            int sc = nn;
            if (c.permq && nn < 4096) { const int cc = nn & 255; sc = (nn & ~255) + (cc & 1) * 128 + (cc >> 1); }
            const bool ok = nn < c.Nsrc;
            const float* sp = c.src + (size_t)k0 * c.Nsrc + sc;
#pragma unroll
            for (int i = 0; i < 8; ++i) { const int k = i * 8 + (tid >> 6); tl[k * 65 + n] = ok ? sp[(size_t)k * c.Nsrc] : 0.f; }
        }
        __syncthreads();
        {
            const int n = tid >> 3, kb = tid & 7;
            float f[8];
#pragma unroll
            for (int e = 0; e < 8; ++e) f[e] = tl[(kb * 8 + e) * 65 + n];
            u32x4 w; w.x = pk2(f[0], f[1]); w.y = pk2(f[2], f[3]); w.z = pk2(f[4], f[5]); w.w = pk2(f[6], f[7]);
            *(u32x4*)(c.dst + (size_t)(n0 + n) * c.K + k0 + kb * 8) = w;
        }
        __syncthreads();
    }
}

struct NormDesc { int mode; const float* m; const float* hres; float* hout; const float* wpost; const float* wpre; bf16_t* ub; };
__device__ __forceinline__ void norm_pass(const NormDesc& d, int wg, int G) {
    const int tid_ = otid(); const int wave = tid_ >> 6, lane = tid_ & 63;
    for (int row = wg * 8 + wave; row < T; row += G * 8) {
        const size_t ro = (size_t)row * DM;
        f32x4 v[8]; float ss = 0.f;
#pragma unroll
        for (int i = 0; i < 8; ++i) { v[i] = *(const f32x4*)(d.m + ro + (i * 64 + lane) * 4); ss += v[i][0] * v[i][0] + v[i][1] * v[i][1] + v[i][2] * v[i][2] + v[i][3] * v[i][3]; }
        ss = wave_sum(ss);
        const float r = rsqrtf(ss * (1.0f / DM) + 1e-6f);
        if (d.mode == 0) {
#pragma unroll
            for (int i = 0; i < 8; ++i) { const int c = (i * 64 + lane) * 4; const f32x4 w = *(const f32x4*)(d.wpre + c);
                u32x2 o; o.x = pk2(v[i][0] * r * w[0], v[i][1] * r * w[1]); o.y = pk2(v[i][2] * r * w[2], v[i][3] * r * w[3]);
                *(u32x2*)(d.ub + ro + c) = o; }
        } else {
            float s2 = 0.f;
#pragma unroll
            for (int i = 0; i < 8; ++i) { const int c = (i * 64 + lane) * 4; const f32x4 w = *(const f32x4*)(d.wpost + c); const f32x4 h = *(const f32x4*)(d.hres + ro + c);
                f32x4 o; o[0] = h[0] + v[i][0] * r * w[0]; o[1] = h[1] + v[i][1] * r * w[1]; o[2] = h[2] + v[i][2] * r * w[2]; o[3] = h[3] + v[i][3] * r * w[3];
                v[i] = o; s2 += o[0] * o[0] + o[1] * o[1] + o[2] * o[2] + o[3] * o[3];
                *(f32x4*)(d.hout + ro + c) = o; }
            if (d.mode == 1) {
                s2 = wave_sum(s2);
                const float r2 = rsqrtf(s2 * (1.0f / DM) + 1e-6f);
#pragma unroll
                for (int i = 0; i < 8; ++i) { const int c = (i * 64 + lane) * 4; const f32x4 w = *(const f32x4*)(d.wpre + c);
                    u32x2 o; o.x = pk2(v[i][0] * r2 * w[0], v[i][1] * r2 * w[1]); o.y = pk2(v[i][2] * r2 * w[2], v[i][3] * r2 * w[3]);
                    *(u32x2*)(d.ub + ro + c) = o; }
            }
        }
    }
}

__device__ __forceinline__ void rot_table(float* rot, int wg, int G) {
    for (int e = wg * NTHREADS + otid(); e < SEQ * 128; e += G * NTHREADS) {
        const int pos = e >> 7, jf = e & 127;
        const float inv = exp2f(-(float)jf * (13.287712379549449f / 128.0f));
        const float ang = (float)pos * inv;
        const double a = (double)ang; const double k = rint(a * 0.15915494309189535); const float rf = (float)(a - k * 6.283185307179586);
        f32x2 cs; cs.x = cosf(rf); cs.y = sinf(rf);
        *(f32x2*)(rot + 2 * (size_t)e) = cs;
    }
}

__device__ __forceinline__ void ret_scan(bf16_t* proj, LAS unsigned char* lds, int wg, int G) {
    const int tid = otid(), lane = tid & 63, wid = __builtin_amdgcn_readfirstlane(tid >> 6), fr = lane & 15, fq = lane >> 4;
    constexpr int QS = 528, VS = 80, PS = 144;
    LAS unsigned char* Qs = lds; LAS unsigned char* Ks = lds + 33792; LAS unsigned char* Vs = lds + 67584; LAS unsigned char* Vz = lds + 72704;
    LAS unsigned char* Ps = lds + 77824; LAS unsigned char* St = lds + 87040;
    const int lm = wid >> 1, c2 = wid & 1;
    for (int unit = wg; unit < 256; unit += G) {
        const int xc = unit & 7, ii = unit >> 3, bh = xc * 2 + (ii >> 4), vs = ii & 15, b = bh >> 3, h = bh & 7;
        const float lg = log1pf(-exp2f(-5.0f - (float)h));
        float dm[2][4], xi[4];
#pragma unroll
        for (int j = 0; j < 4; ++j) { const int l = lm * 16 + fq * 4 + j; xi[j] = expf((float)(l + 1) * lg);
#pragma unroll
            for (int t = 0; t < 2; ++t) { const int m = (c2 * 2 + t) * 16 + fr; const int dd = l > m ? l - m : m - l; dm[t][j] = expf((float)dd * lg); } }
        const float cdecay = expf(64.0f * lg);
        const int vrow = (tid & 255) >> 2, vch = tid & 3;
        const float zeta = expf((float)(63 - vrow) * lg);
        f32x4 accS[2][2];
#pragma unroll
        for (int a = 0; a < 2; ++a)
#pragma unroll
            for (int c = 0; c < 2; ++c) accS[a][c] = (f32x4){0.f, 0.f, 0.f, 0.f};
        for (int i = tid; i < 16896 / 4; i += NTHREADS) ((LAS unsigned*)St)[i] = 0u;
        const bf16_t* qb = proj + (size_t)(b * SEQ) * RIN + h * 256;
        const bf16_t* kb = qb + 2048;
        bf16_t* vb = proj + (size_t)(b * SEQ) * RIN + 4096 + h * 512 + vs * 32;
        u32x4 rq[4], rk[4], rv;
#pragma unroll
        for (int i = 0; i < 4; ++i) { const int idx = i * 512 + tid, row = idx >> 5, ch = idx & 31; rq[i] = *(const u32x4*)(qb + (size_t)row * RIN + ch * 8); rk[i] = *(const u32x4*)(kb + (size_t)row * RIN + ch * 8); }
        rv = (u32x4){0u, 0u, 0u, 0u};
        if (tid < 256) rv = *(const u32x4*)(vb + (size_t)vrow * RIN + vch * 8);
        for (int c = 0; c < 128; ++c) {
#pragma unroll
            for (int i = 0; i < 4; ++i) { const int idx = i * 512 + tid, row = idx >> 5, ch = idx & 31; *(LAS u32x4*)(Qs + row * QS + ch * 16) = rq[i]; *(LAS u32x4*)(Ks + row * QS + ch * 16) = rk[i]; }
            if (tid < 256) {
                *(LAS u32x4*)(Vs + vrow * VS + vch * 16) = rv;
                u32x4 z; z.x = pk2(bflo(rv.x) * zeta, bfhi(rv.x) * zeta); z.y = pk2(bflo(rv.y) * zeta, bfhi(rv.y) * zeta);
                z.z = pk2(bflo(rv.z) * zeta, bfhi(rv.z) * zeta); z.w = pk2(bflo(rv.w) * zeta, bfhi(rv.w) * zeta);
                *(LAS u32x4*)(Vz + vrow * VS + vch * 16) = z;
            }
            __syncthreads();
            if (c + 1 < 128) {
                const size_t ro = (size_t)(c + 1) * 64 * RIN;
#pragma unroll
                for (int i = 0; i < 4; ++i) { const int idx = i * 512 + tid, row = idx >> 5, ch = idx & 31; rq[i] = *(const u32x4*)(qb + ro + (size_t)row * RIN + ch * 8); rk[i] = *(const u32x4*)(kb + ro + (size_t)row * RIN + ch * 8); }
                if (tid < 256) rv = *(const u32x4*)(vb + ro + (size_t)vrow * RIN + vch * 8);
            }
            f32x4 aP0 = {0.f, 0.f, 0.f, 0.f}, aP1 = {0.f, 0.f, 0.f, 0.f}, aX = {0.f, 0.f, 0.f, 0.f};
#pragma unroll
            for (int ks = 0; ks < 8; ++ks) {
                const bf16x8 a = *(const LAS bf16x8*)(Qs + (lm * 16 + fr) * QS + ks * 64 + fq * 16);
                const bf16x8 b0 = *(const LAS bf16x8*)(Ks + ((c2 * 2 + 0) * 16 + fr) * QS + ks * 64 + fq * 16);
                const bf16x8 b1 = *(const LAS bf16x8*)(Ks + ((c2 * 2 + 1) * 16 + fr) * QS + ks * 64 + fq * 16);
                const bf16x8 bs = *(const LAS bf16x8*)(St + (c2 * 16 + fr) * QS + ks * 64 + fq * 16);
                aP0 = __builtin_amdgcn_mfma_f32_16x16x32_bf16(a, b0, aP0, 0, 0, 0);
                aP1 = __builtin_amdgcn_mfma_f32_16x16x32_bf16(a, b1, aP1, 0, 0, 0);
                aX = __builtin_amdgcn_mfma_f32_16x16x32_bf16(a, bs, aX, 0, 0, 0);
            }
#pragma unroll
            for (int j = 0; j < 4; ++j) { const int l = lm * 16 + fq * 4 + j;
                *(LAS bf16_t*)(Ps + l * PS + ((c2 * 2 + 0) * 16 + fr) * 2) = (bf16_t)f2bf(aP0[j] * dm[0][j]);
                *(LAS bf16_t*)(Ps + l * PS + ((c2 * 2 + 1) * 16 + fr) * 2) = (bf16_t)f2bf(aP1[j] * dm[1][j]); }
            __syncthreads();
            f32x4 aI = {0.f, 0.f, 0.f, 0.f};
#pragma unroll
            for (int ks = 0; ks < 2; ++ks) {
                const bf16x8 a = *(const LAS bf16x8*)(Ps + (lm * 16 + fr) * PS + ks * 64 + fq * 16);
                const bf16x8 bv = tr_frag(Vs, VS, ks * 32, c2 * 16, lane);
                aI = __builtin_amdgcn_mfma_f32_16x16x32_bf16(a, bv, aI, 0, 0, 0);
            }
            {
                bf16_t* ob = vb + (size_t)(c * 64) * RIN + c2 * 16 + fr;
#pragma unroll
                for (int j = 0; j < 4; ++j) { const int l = lm * 16 + fq * 4 + j; ob[(size_t)l * RIN] = (bf16_t)f2bf(aI[j] + aX[j] * xi[j]); }
            }
#pragma unroll
            for (int a = 0; a < 2; ++a)
#pragma unroll
                for (int cc = 0; cc < 2; ++cc) accS[a][cc] *= cdecay;
#pragma unroll
            for (int ks = 0; ks < 2; ++ks) {
                const bf16x8 ad0 = tr_frag(Ks, QS, ks * 32, (wid * 2 + 0) * 16, lane);
                const bf16x8 ad1 = tr_frag(Ks, QS, ks * 32, (wid * 2 + 1) * 16, lane);
                const bf16x8 bv0 = tr_frag(Vz, VS, ks * 32, 0, lane);
                const bf16x8 bv1 = tr_frag(Vz, VS, ks * 32, 16, lane);
                accS[0][0] = __builtin_amdgcn_mfma_f32_16x16x32_bf16(ad0, bv0, accS[0][0], 0, 0, 0);
                accS[0][1] = __builtin_amdgcn_mfma_f32_16x16x32_bf16(ad0, bv1, accS[0][1], 0, 0, 0);
                accS[1][0] = __builtin_amdgcn_mfma_f32_16x16x32_bf16(ad1, bv0, accS[1][0], 0, 0, 0);
                accS[1][1] = __builtin_amdgcn_mfma_f32_16x16x32_bf16(ad1, bv1, accS[1][1], 0, 0, 0);
            }
#pragma unroll
            for (int a = 0; a < 2; ++a)
#pragma unroll
                for (int cc = 0; cc < 2; ++cc) {
                    u32x2 w; w.x = pk2(accS[a][cc][0], accS[a][cc][1]); w.y = pk2(accS[a][cc][2], accS[a][cc][3]);
                    *(LAS u32x2*)(St + (cc * 16 + fr) * QS + ((wid * 2 + a) * 16 + fq * 4) * 2) = w;
                }
            __syncthreads();
        }
    }
}

__device__ __forceinline__ void ret_gn(bf16_t* proj, const float* gnw, int wg, int G) {
    const int tid_ = otid(); const int wave = tid_ >> 6, lane = tid_ & 63;
    for (int pair = wg * 8 + wave; pair < T * 8; pair += G * 8) {
        const int t = pair >> 3, h = pair & 7;
        bf16_t* op = proj + (size_t)t * RIN + 4096 + h * 512 + lane * 8;
        bf16_t* gp = op + 4096;
        const u32x4 ov = *(const u32x4*)op, gv = *(const u32x4*)gp;
        float o[8] = {bflo(ov.x), bfhi(ov.x), bflo(ov.y), bfhi(ov.y), bflo(ov.z), bfhi(ov.z), bflo(ov.w), bfhi(ov.w)};
        float g[8] = {bflo(gv.x), bfhi(gv.x), bflo(gv.y), bfhi(gv.y), bflo(gv.z), bfhi(gv.z), bflo(gv.w), bfhi(gv.w)};
        float s = 0.f;
#pragma unroll
        for (int e = 0; e < 8; ++e) s += o[e];
        const float mu = wave_sum(s) * (1.0f / 512.0f);
        float q = 0.f;
#pragma unroll
        for (int e = 0; e < 8; ++e) { o[e] -= mu; q += o[e] * o[e]; }
        const float rstd = rsqrtf(wave_sum(q) * (1.0f / 512.0f) + 1e-5f);
        const f32x4 w0 = *(const f32x4*)(gnw + h * 512 + lane * 8), w1 = *(const f32x4*)(gnw + h * 512 + lane * 8 + 4);
        float y[8];
#pragma unroll
        for (int e = 0; e < 8; ++e) y[e] = silu(g[e]) * (o[e] * rstd) * (e < 4 ? w0[e & 3] : w1[e & 3]);
        u32x4 w; w.x = pk2(y[0], y[1]); w.y = pk2(y[2], y[3]); w.z = pk2(y[4], y[5]); w.w = pk2(y[6], y[7]);
        *(u32x4*)gp = w;
    }
}

__device__ __forceinline__ void ssd_pre(const bf16_t* proj, bf16_t* halo, float* dtv, const float* dt_bias, int wg, int G) {
    const int gt = wg * NTHREADS + otid(), gs = G * NTHREADS;
    for (int e = gt; e < 256 * 3 * 768; e += gs) {
        const int oc = e % 768, r = (e / 768) % 3, ck = e / (768 * 3);
        const u32x4 v = *(const u32x4*)(proj + (size_t)(ck * 64 + 61 + r) * SINP + 4096 + oc * 8);
        *(u32x4*)(halo + ((size_t)ck * 3 + r) * 6144 + oc * 8) = v;
    }
    for (int e = gt; e < T * 64; e += gs) {
        const int t = e >> 6, hd = e & 63;
        const float x = bf2f(proj[(size_t)t * SINP + 10240 + hd]) + dt_bias[hd];
        dtv[e] = x > 20.f ? x : log1pf(expf(x));
    }
}
__device__ __forceinline__ void ssd_conv(bf16_t* proj, const bf16_t* halo, const float* cw, const float* cb, int wg, int G) {
    const int gt = wg * NTHREADS + otid(), gs = G * NTHREADS;
    for (int e = gt; e < 256 * 768; e += gs) {
        const int oc = e % 768, ck = e / 768, col = oc * 8;
        float w[4][8], bias[8];
#pragma unroll
        for (int tp = 0; tp < 4; ++tp) { const f32x4 a = *(const f32x4*)(cw + tp * 6144 + col), b = *(const f32x4*)(cw + tp * 6144 + col + 4);
#pragma unroll
            for (int i = 0; i < 4; ++i) { w[tp][i] = a[i]; w[tp][4 + i] = b[i]; } }
        { const f32x4 a = *(const f32x4*)(cb + col), b = *(const f32x4*)(cb + col + 4);
#pragma unroll
            for (int i = 0; i < 4; ++i) { bias[i] = a[i]; bias[4 + i] = b[i]; } }
        float p3[8], p2[8], p1[8];
        if ((ck & 127) == 0) {
#pragma unroll
            for (int i = 0; i < 8; ++i) { p3[i] = 0.f; p2[i] = 0.f; p1[i] = 0.f; }
        } else {
            const bf16_t* hp = halo + ((size_t)(ck - 1) * 3) * 6144 + col;
            const u32x4 a = *(const u32x4*)hp, b = *(const u32x4*)(hp + 6144), c = *(const u32x4*)(hp + 2 * 6144);
            p3[0] = bflo(a.x); p3[1] = bfhi(a.x); p3[2] = bflo(a.y); p3[3] = bfhi(a.y); p3[4] = bflo(a.z); p3[5] = bfhi(a.z); p3[6] = bflo(a.w); p3[7] = bfhi(a.w);
            p2[0] = bflo(b.x); p2[1] = bfhi(b.x); p2[2] = bflo(b.y); p2[3] = bfhi(b.y); p2[4] = bflo(b.z); p2[5] = bfhi(b.z); p2[6] = bflo(b.w); p2[7] = bfhi(b.w);
            p1[0] = bflo(c.x); p1[1] = bfhi(c.x); p1[2] = bflo(c.y); p1[3] = bfhi(c.y); p1[4] = bflo(c.z); p1[5] = bfhi(c.z); p1[6] = bflo(c.w); p1[7] = bfhi(c.w);
        }
        bf16_t* rp = proj + (size_t)(ck * 64) * SINP + 4096 + col;
        for (int r = 0; r < 64; ++r) {
            const u32x4 xv = *(const u32x4*)(rp + (size_t)r * SINP);
            float x[8] = {bflo(xv.x), bfhi(xv.x), bflo(xv.y), bfhi(xv.y), bflo(xv.z), bfhi(xv.z), bflo(xv.w), bfhi(xv.w)};
            float y[8];
#pragma unroll
            for (int i = 0; i < 8; ++i) { const float s = bias[i] + w[0][i] * p3[i] + w[1][i] * p2[i] + w[2][i] * p1[i] + w[3][i] * x[i]; y[i] = silu(s); p3[i] = p2[i]; p2[i] = p1[i]; p1[i] = x[i]; }
            u32x4 o; o.x = pk2(y[0], y[1]); o.y = pk2(y[2], y[3]); o.z = pk2(y[4], y[5]); o.w = pk2(y[6], y[7]);
            *(u32x4*)(rp + (size_t)r * SINP) = o;
        }
    }
}

__device__ __forceinline__ void ssd_scan(bf16_t* proj, const float* dtv, const float* a_log, const float* d_skip, LAS unsigned char* lds, int wg, int G) {
    const int tid = otid(), lane = tid & 63, wid = __builtin_amdgcn_readfirstlane(tid >> 6), fr = lane & 15, fq = lane >> 4;
    constexpr int CS = 272, XS = 80, WS = 144;
    LAS unsigned char* Cs = lds; LAS unsigned char* Bs = lds + 17408; LAS unsigned char* Xs = lds + 34816; LAS unsigned char* Xw = lds + 39936; LAS unsigned char* Zs = lds + 45056;
    LAS unsigned char* Ws = lds + 50176; LAS unsigned char* Sts = lds + 59392; LAS float* acum = (LAS float*)(lds + 68096); LAS float* dts = (LAS float*)(lds + 68352);
    const int lm = wid >> 1, c2 = wid & 1;
    for (int unit = wg; unit < 256; unit += G) {
        const int grp = unit & 7, ii = unit >> 3, b = ii >> 4, hd = grp * 8 + ((ii & 15) >> 1), ph = ii & 1;
        const float an = -expf(a_log[hd]), dsk = d_skip[hd];
        f32x4 accT[2];
        accT[0] = (f32x4){0.f, 0.f, 0.f, 0.f}; accT[1] = (f32x4){0.f, 0.f, 0.f, 0.f};
        for (int i = tid; i < 8704 / 4; i += NTHREADS) ((LAS unsigned*)Sts)[i] = 0u;
        const bf16_t* base = proj + (size_t)(b * SEQ) * SINP;
        const bf16_t* bb = base + 8192 + grp * 128;
        const bf16_t* cbp = base + 9216 + grp * 128;
        bf16_t* xb = (bf16_t*)base + 4096 + hd * 64 + ph * 32;
        const bf16_t* zb = base + hd * 64 + ph * 32;
        const float* dtp = dtv + (size_t)(b * SEQ) * 64 + hd;
        const int xrow = (tid & 255) >> 2, xch = tid & 3;
        u32x4 rc[2], rb[2], rxz; float rdt = 0.f;
#pragma unroll
        for (int i = 0; i < 2; ++i) { const int idx = i * 512 + tid, row = idx >> 4, ch = idx & 15; rc[i] = *(const u32x4*)(cbp + (size_t)row * SINP + ch * 8); rb[i] = *(const u32x4*)(bb + (size_t)row * SINP + ch * 8); }
        rxz = *(const u32x4*)((tid < 256 ? (const bf16_t*)xb : zb) + (size_t)xrow * SINP + xch * 8);
        if (wid == 0) rdt = dtp[(size_t)lane * 64];
        for (int c = 0; c < 128; ++c) {
#pragma unroll
            for (int i = 0; i < 2; ++i) { const int idx = i * 512 + tid, row = idx >> 4, ch = idx & 15; *(LAS u32x4*)(Cs + row * CS + ch * 16) = rc[i]; *(LAS u32x4*)(Bs + row * CS + ch * 16) = rb[i]; }
            *(LAS u32x4*)((tid < 256 ? Xs : Zs) + xrow * XS + xch * 16) = rxz;
            if (wid == 0) {
                float s = rdt * an;
#pragma unroll
                for (int o = 1; o < 64; o <<= 1) { const float tt = __shfl_up(s, o); if (lane >= o) s += tt; }
                acum[lane] = s; dts[lane] = rdt;
            }
            __syncthreads();
            if (c + 1 < 128) {
                const size_t ro = (size_t)(c + 1) * 64 * SINP;
#pragma unroll
                for (int i = 0; i < 2; ++i) { const int idx = i * 512 + tid, row = idx >> 4, ch = idx & 15; rc[i] = *(const u32x4*)(cbp + ro + (size_t)row * SINP + ch * 8); rb[i] = *(const u32x4*)(bb + ro + (size_t)row * SINP + ch * 8); }
                rxz = *(const u32x4*)((tid < 256 ? (const bf16_t*)xb : zb) + ro + (size_t)xrow * SINP + xch * 8);
                if (wid == 0) rdt = dtp[((size_t)(c + 1) * 64 + lane) * 64];
            }
            const float atot = acum[63];
            float al[4], as_[2], ds_[2];
#pragma unroll
            for (int j = 0; j < 4; ++j) al[j] = acum[lm * 16 + fq * 4 + j];
#pragma unroll
            for (int t = 0; t < 2; ++t) { as_[t] = acum[(c2 * 2 + t) * 16 + fr]; ds_[t] = dts[(c2 * 2 + t) * 16 + fr]; }
            if (tid < 256) {
                const float f = dts[xrow] * expf(atot - acum[xrow]);
                const u32x4 xv = *(const LAS u32x4*)(Xs + xrow * XS + xch * 16);
                u32x4 z; z.x = pk2(bflo(xv.x) * f, bfhi(xv.x) * f); z.y = pk2(bflo(xv.y) * f, bfhi(xv.y) * f); z.z = pk2(bflo(xv.z) * f, bfhi(xv.z) * f); z.w = pk2(bflo(xv.w) * f, bfhi(xv.w) * f);
                *(LAS u32x4*)(Xw + xrow * XS + xch * 16) = z;
            }
            f32x4 aW0 = {0.f, 0.f, 0.f, 0.f}, aW1 = {0.f, 0.f, 0.f, 0.f}, aY = {0.f, 0.f, 0.f, 0.f};
#pragma unroll
            for (int ks = 0; ks < 4; ++ks) {
                const bf16x8 a = *(const LAS bf16x8*)(Cs + (lm * 16 + fr) * CS + ks * 64 + fq * 16);
                const bf16x8 b0 = *(const LAS bf16x8*)(Bs + ((c2 * 2 + 0) * 16 + fr) * CS + ks * 64 + fq * 16);
                const bf16x8 b1 = *(const LAS bf16x8*)(Bs + ((c2 * 2 + 1) * 16 + fr) * CS + ks * 64 + fq * 16);
                const bf16x8 bs = *(const LAS bf16x8*)(Sts + (c2 * 16 + fr) * CS + ks * 64 + fq * 16);
                aW0 = __builtin_amdgcn_mfma_f32_16x16x32_bf16(a, b0, aW0, 0, 0, 0);
                aW1 = __builtin_amdgcn_mfma_f32_16x16x32_bf16(a, b1, aW1, 0, 0, 0);
                aY = __builtin_amdgcn_mfma_f32_16x16x32_bf16(a, bs, aY, 0, 0, 0);
            }
#pragma unroll
            for (int j = 0; j < 4; ++j) { const int l = lm * 16 + fq * 4 + j;
                const int s0 = (c2 * 2 + 0) * 16 + fr, s1 = (c2 * 2 + 1) * 16 + fr;
                const float w0 = (l >= s0) ? aW0[j] * expf(al[j] - as_[0]) * ds_[0] : 0.f;
                const float w1 = (l >= s1) ? aW1[j] * expf(al[j] - as_[1]) * ds_[1] : 0.f;
                *(LAS bf16_t*)(Ws + l * WS + s0 * 2) = (bf16_t)f2bf(w0);
                *(LAS bf16_t*)(Ws + l * WS + s1 * 2) = (bf16_t)f2bf(w1); }
            __syncthreads();
            f32x4 aD = {0.f, 0.f, 0.f, 0.f};
#pragma unroll
            for (int ks = 0; ks < 2; ++ks) {
                const bf16x8 a = *(const LAS bf16x8*)(Ws + (lm * 16 + fr) * WS + ks * 64 + fq * 16);
                const bf16x8 bx = tr_frag(Xs, XS, ks * 32, c2 * 16, lane);
                aD = __builtin_amdgcn_mfma_f32_16x16x32_bf16(a, bx, aD, 0, 0, 0);
            }
            {
                const int pc = c2 * 16 + fr;
                bf16_t* ob = xb + (size_t)(c * 64) * SINP + pc;
#pragma unroll
                for (int j = 0; j < 4; ++j) { const int l = lm * 16 + fq * 4 + j;
                    const float xv = bf2f(*(const LAS bf16_t*)(Xs + l * XS + pc * 2)), zv = bf2f(*(const LAS bf16_t*)(Zs + l * XS + pc * 2));
                    const float y = aD[j] + aY[j] * expf(al[j]) + dsk * xv;
                    ob[(size_t)l * SINP] = (bf16_t)f2bf(y * silu(zv)); }
            }
            const float sdec = expf(atot);
            accT[0] *= sdec; accT[1] *= sdec;
#pragma unroll
            for (int ks = 0; ks < 2; ++ks) {
                const bf16x8 an_ = tr_frag(Bs, CS, ks * 32, wid * 16, lane);
                const bf16x8 bp0 = tr_frag(Xw, XS, ks * 32, 0, lane);
                const bf16x8 bp1 = tr_frag(Xw, XS, ks * 32, 16, lane);
                accT[0] = __builtin_amdgcn_mfma_f32_16x16x32_bf16(an_, bp0, accT[0], 0, 0, 0);
                accT[1] = __builtin_amdgcn_mfma_f32_16x16x32_bf16(an_, bp1, accT[1], 0, 0, 0);
            }
#pragma unroll
            for (int pi = 0; pi < 2; ++pi) {
                u32x2 w; w.x = pk2(accT[pi][0], accT[pi][1]); w.y = pk2(accT[pi][2], accT[pi][3]);
                *(LAS u32x2*)(Sts + (pi * 16 + fr) * CS + (wid * 16 + fq * 4) * 2) = w;
            }
            __syncthreads();
        }
    }
}

__device__ __forceinline__ void ssd_norm(bf16_t* proj, const float* nw, int wg, int G) {
    const int tid_ = otid(); const int wave = tid_ >> 6, lane = tid_ & 63;
    for (int pair = wg * 8 + wave; pair < T * 8; pair += G * 8) {
        const int t = pair >> 3, gr = pair & 7;
        bf16_t* yp = proj + (size_t)t * SINP + 4096 + gr * 512 + lane * 8;
        const u32x4 yv = *(const u32x4*)yp;
        float y[8] = {bflo(yv.x), bfhi(yv.x), bflo(yv.y), bfhi(yv.y), bflo(yv.z), bfhi(yv.z), bflo(yv.w), bfhi(yv.w)};
        float q = 0.f;
#pragma unroll
        for (int e = 0; e < 8; ++e) q += y[e] * y[e];
        const float r = rsqrtf(wave_sum(q) * (1.0f / 512.0f) + 1e-6f);
        const f32x4 w0 = *(const f32x4*)(nw + gr * 512 + lane * 8), w1 = *(const f32x4*)(nw + gr * 512 + lane * 8 + 4);
        u32x4 w; w.x = pk2(y[0] * r * w0[0], y[1] * r * w0[1]); w.y = pk2(y[2] * r * w0[2], y[3] * r * w0[3]);
        w.z = pk2(y[4] * r * w1[0], y[5] * r * w1[1]); w.w = pk2(y[6] * r * w1[2], y[7] * r * w1[3]);
        *(u32x4*)yp = w;
    }
}

struct Params {
    const float* x; const float* nmp; const float* nmq; const float* nfp; const float* nfq;
    const float* ret_w_in; const float* ret_gn_w; const float* ret_w_out;
    const float* ssd_w_in; const float* conv_w; const float* conv_b; const float* dt_bias; const float* a_log; const float* d_skip; const float* ssd_norm_w; const float* ssd_w_out;
    const float* w_up; const float* w_down;
    float* out; unsigned char* ws;
};


__global__ void __launch_bounds__(NTHREADS, 2) mega(Params p) {
    extern __shared__ __attribute__((aligned(16))) unsigned char lds_raw[];
    LAS unsigned char* lds = (LAS unsigned char*)lds_raw;
    cg::grid_group grid = cg::this_grid();
    const int G = gridDim.x, wg = blockIdx.x;
    bf16_t* WA = (bf16_t*)(p.ws + OFF_WA); bf16_t* WB = (bf16_t*)(p.ws + OFF_WB);
    bf16_t* ACT = (bf16_t*)(p.ws + OFF_ACT); bf16_t* U_ACT = (bf16_t*)(p.ws + OFF_ACT + HID_BYTES); float* F_ACT = (float*)(p.ws + OFF_ACT + HID_BYTES);
    bf16_t* U_R2 = (bf16_t*)(p.ws + OFF_R2); float* MF_R2 = (float*)(p.ws + OFF_R2);
    float* ROT = (float*)(p.ws + OFF_ROT); bf16_t* HALO = (bf16_t*)(p.ws + OFF_HALO); float* DTV = (float*)(p.ws + OFF_DTV);

#define GEMM(KIND, ...) do { const pg8::Gemm gd = pg8::Gemm{__VA_ARGS__}; pg8::StaticOrder S; S.init(gd.M, gd.N, G, wg); pg8::gemm_phase<KIND>(lds, gd, S); grid.sync(); } while (0)
    norm_pass(NormDesc{0, p.x, nullptr, nullptr, nullptr, p.nmp, U_R2}, wg, G);
    convert_w(ConvDesc{p.ret_w_in, WA, 2048, RIN, RIN, 1}, lds, wg, G);
    convert_w(ConvDesc{p.ret_w_out, WB, 4096, 2048, 2048, 0}, lds, wg, G);
    rot_table(ROT, wg, G);
    grid.sync();
    GEMM(3, U_R2, WA, T, RIN, 2048, 2048, 3, ACT, RIN, ROT);
    ret_scan(ACT, lds, wg, G); grid.sync();
    ret_gn(ACT, p.ret_gn_w, wg, G); grid.sync();
    GEMM(0, ACT + 8192, WB, T, 2048, 4096, RIN, 0, MF_R2, 2048, nullptr);
    norm_pass(NormDesc{1, MF_R2, p.x, p.out, p.nmq, p.nfp, U_ACT}, wg, G);
    convert_w(ConvDesc{p.w_up, WA, 2048, DFF, DFF, 0}, lds, wg, G);
    convert_w(ConvDesc{p.w_down, WB, DFF, 2048, 2048, 0}, lds, wg, G);
    grid.sync();
    GEMM(2, U_ACT, WA, T, DFF, 2048, 2048, 2, ACT, DFF, nullptr);
    GEMM(0, ACT, WB, T, 2048, DFF, DFF, 0, F_ACT, 2048, nullptr);
    norm_pass(NormDesc{1, F_ACT, p.out, p.out, p.nfq, p.nmp + DM, U_R2}, wg, G);
    convert_w(ConvDesc{p.ssd_w_in, WA, 2048, SIN, SINP, 0}, lds, wg, G);
    convert_w(ConvDesc{p.ssd_w_out, WB, 4096, 2048, 2048, 0}, lds, wg, G);
    grid.sync();
    GEMM(1, U_R2, WA, T, SINP, 2048, 2048, 1, ACT, SINP, nullptr);
    ssd_pre(ACT, HALO, DTV, p.dt_bias, wg, G); grid.sync();
    ssd_conv(ACT, HALO, p.conv_w, p.conv_b, wg, G); grid.sync();
    ssd_scan(ACT, DTV, p.a_log, p.d_skip, lds, wg, G); grid.sync();
    ssd_norm(ACT, p.ssd_norm_w, wg, G); grid.sync();
    GEMM(0, ACT + 4096, WB, T, 2048, 4096, SINP, 0, MF_R2, 2048, nullptr);
    norm_pass(NormDesc{1, MF_R2, p.out, p.out, p.nmq + DM, p.nfp + DM, U_ACT}, wg, G);
    convert_w(ConvDesc{p.w_up + (size_t)2048 * DFF, WA, 2048, DFF, DFF, 0}, lds, wg, G);
    convert_w(ConvDesc{p.w_down + (size_t)DFF * 2048, WB, DFF, 2048, 2048, 0}, lds, wg, G);
    grid.sync();
    GEMM(2, U_ACT, WA, T, DFF, 2048, 2048, 2, ACT, DFF, nullptr);
    GEMM(0, ACT, WB, T, 2048, DFF, DFF, 0, F_ACT, 2048, nullptr);
    norm_pass(NormDesc{2, F_ACT, p.out, p.out, p.nfq + DM, nullptr, nullptr}, wg, G);
#undef GEMM
}

extern "C" void kernel_launch(void* const* d_in, const int* in_sizes, int n_in, void* d_out, int out_size, void* d_ws, size_t ws_size, hipStream_t stream) {
    static int grid_blocks = 0;
    if (!grid_blocks) {
        int dev = 0, cus = 0, per_cu = 0;
        hipGetDevice(&dev);
        hipDeviceGetAttribute(&cus, hipDeviceAttributeMultiprocessorCount, dev);
        hipFuncSetAttribute((const void*)mega, hipFuncAttributeMaxDynamicSharedMemorySize, LDS_BYTES);
        hipOccupancyMaxActiveBlocksPerMultiprocessor(&per_cu, (const void*)mega, NTHREADS, LDS_BYTES);
        if (per_cu < 1) per_cu = 1;
        grid_blocks = cus * per_cu;
        if (ws_size < WS_END) { fprintf(stderr, "kernel_launch: workspace too small: %zu < %zu\n", ws_size, (size_t)WS_END); grid_blocks = -1; }
    }
    if (grid_blocks < 0) return;
    Params p{};
    p.x = (const float*)d_in[0]; p.nmp = (const float*)d_in[1]; p.nmq = (const float*)d_in[2]; p.nfp = (const float*)d_in[3]; p.nfq = (const float*)d_in[4];
    p.ret_w_in = (const float*)d_in[5]; p.ret_gn_w = (const float*)d_in[6]; p.ret_w_out = (const float*)d_in[7];
    p.ssd_w_in = (const float*)d_in[8]; p.conv_w = (const float*)d_in[9]; p.conv_b = (const float*)d_in[10]; p.dt_bias = (const float*)d_in[11];
    p.a_log = (const float*)d_in[12]; p.d_skip = (const float*)d_in[13]; p.ssd_norm_w = (const float*)d_in[14]; p.ssd_w_out = (const float*)d_in[15];
    p.w_up = (const float*)d_in[16]; p.w_down = (const float*)d_in[17];
    p.out = (float*)d_out; p.ws = (unsigned char*)d_ws;
    void* args[] = {&p};
    hipError_t e = hipLaunchCooperativeKernel((const void*)mega, dim3(grid_blocks), dim3(NTHREADS), args, LDS_BYTES, stream);
    if (e != hipSuccess) fprintf(stderr, "cooperative launch failed: %s (grid %d)\n", hipGetErrorString(e), grid_blocks);
}
```

```cpp
#include <hip/hip_runtime.h>
#include <hip/hip_cooperative_groups.h>
#include <cstdio>
namespace cg = cooperative_groups;

#define LAS __attribute__((address_space(3)))
typedef unsigned short bf16_t;
typedef short bf16x8 __attribute__((ext_vector_type(8)));
typedef short s16x4 __attribute__((ext_vector_type(4)));
typedef float f32x4 __attribute__((ext_vector_type(4)));
typedef float f32x2 __attribute__((ext_vector_type(2)));
typedef unsigned u32x4 __attribute__((ext_vector_type(4)));
typedef unsigned u32x2 __attribute__((ext_vector_type(2)));

constexpr int T = 16384, DM = 2048, SEQ = 8192;
constexpr int RIN = 12288;
constexpr int SIN = 10304, SINP = 10496;
constexpr int DFF = 8192;
constexpr int NTHREADS = 512;
constexpr int LDS_BYTES = 131072;

constexpr size_t OFF_WA = 0;
constexpr size_t OFF_WB = 50331648;
constexpr size_t OFF_ACT = OFF_WB + 33554432;
constexpr size_t ACT_BYTES = 402653184;
constexpr size_t HID_BYTES = 268435456;
constexpr size_t OFF_R2 = OFF_ACT + ACT_BYTES;
constexpr size_t R2_BYTES = 134217728;
constexpr size_t OFF_ROT = OFF_R2 + 67108864;
constexpr size_t OFF_HALO = OFF_R2 + 67108864;
constexpr size_t OFF_DTV = OFF_R2 + 67108864 + 16777216;
constexpr size_t WS_END = OFF_R2 + R2_BYTES;

__device__ __forceinline__ unsigned f2bf(float f) { unsigned u = __float_as_uint(f); return (u + 0x7fffu + ((u >> 16) & 1u)) >> 16; }
__device__ __forceinline__ unsigned pk2(float lo, float hi) { return f2bf(lo) | (f2bf(hi) << 16); }
__device__ __forceinline__ float bflo(unsigned w) { return __uint_as_float(w << 16); }
__device__ __forceinline__ float bfhi(unsigned w) { return __uint_as_float(w & 0xffff0000u); }
__device__ __forceinline__ float bf2f(bf16_t b) { return __uint_as_float(((unsigned)b) << 16); }
__device__ __forceinline__ unsigned cvt_pk_bf16(float lo, float hi) { unsigned r; asm volatile("v_cvt_pk_bf16_f32 %0, %1, %2" : "=v"(r) : "v"(lo), "v"(hi)); return r; }
__device__ __forceinline__ float wave_sum(float v) {
#pragma unroll
    for (int o = 32; o >= 1; o >>= 1) v += __shfl_xor(v, o);
    return v;
}
__device__ __forceinline__ int otid() { int t = threadIdx.x; asm volatile("" : "+v"(t)); return t; }
__device__ __forceinline__ float silu(float x) { return x / (1.0f + __expf(-x)); }

__device__ __forceinline__ bf16x8 tr_frag(LAS unsigned char* img, int rs, int kbase, int n0, int lane) {
    const int g = lane >> 4, q = (lane & 15) >> 2, p = lane & 3;
    LAS unsigned char* a0 = img + (kbase + 8 * g + q) * rs + (n0 + 4 * p) * 2;
    s16x4 a = __builtin_amdgcn_ds_read_tr16_b64_v4i16((LAS s16x4*)a0);
    s16x4 b = __builtin_amdgcn_ds_read_tr16_b64_v4i16((LAS s16x4*)(a0 + 4 * rs));
    bf16x8 r = {a[0], a[1], a[2], a[3], b[0], b[1], b[2], b[3]};
    return r;
}

namespace pg8 {
constexpr int BM = 256, BK = 64, HALF = 128, HTB = HALF * BK * 2, STAGE_BYTES = 8 * HTB, NXCD = 8, WGM = 8;
__device__ __forceinline__ int lds_byte(int r, int c) { const int st = (r >> 4) * 2 + (c >> 5), rr = r & 15, cc = c & 31, ob = rr * 64 + cc * 2; return st * 1024 + (ob ^ (((ob >> 9) & 1) << 5)); }
__device__ __forceinline__ void stage_rc(int b, int& R, int& C) { const int st = b / 1024, sb = b % 1024, swz = sb ^ (((sb >> 9) & 1) << 5); R = (st >> 1) * 16 + swz / 64; C = (st & 1) * 32 + (swz % 64) / 2; }
__device__ __forceinline__ int perm32(int rho) { const int n = rho >> 4, i = rho & 15; return 8 * (i >> 2) + 4 * n + (i & 3); }
struct Unit { int pm, pn; };
struct Gemm { const bf16_t* A; const bf16_t* Bt; int M, N, K, lda; int kind; void* out; int ldc; const float* rot; };
struct StaticOrder {
    int nM, nN, nwg, G, c;
    __device__ void init(int M, int N, int G_, int c_) { nM = M / BM; nN = N / BM; nwg = nM * nN; G = G_; c = c_; }
    __device__ bool next(int i, Unit& u) const {
        const long L = (long)i * G + c; if (L >= nwg) return false;
        int wgid = (int)L; { const int q = nwg / NXCD, r = nwg % NXCD, xcd = wgid % NXCD, off = wgid / NXCD; wgid = (xcd < r ? xcd * (q + 1) : r * (q + 1) + (xcd - r) * q) + off; }
        const int nig = WGM * nN, gid = wgid / nig, fm = gid * WGM, gsz = (nM - fm) < WGM ? (nM - fm) : WGM;
        u.pm = fm + ((wgid % nig) % gsz); u.pn = (wgid % nig) / gsz; return true;
    }
};

template <int KIND> __device__ __forceinline__ void epilogue(const Gemm& g, const f32x4 (&acc)[2][2][4][2], const Unit& u, int wr, int wc, int fr, int fq) {
    if constexpr (KIND == 0) {
        float* C = (float*)g.out; const int ldc = g.ldc;
        const int row0 = u.pm * BM + wr * 64 + fr, col0 = u.pn * BM + wc * 32 + 4 * fq;
#pragma unroll
        for (int ai = 0; ai < 2; ++ai)
#pragma unroll
            for (int m = 0; m < 4; ++m) { float* rowp = C + (size_t)(row0 + ai * HALF + m * 16) * ldc + col0;
#pragma unroll
                for (int bj = 0; bj < 2; ++bj)
#pragma unroll
                    for (int n = 0; n < 2; ++n) *(f32x4*)(rowp + bj * HALF + n * 16) = acc[ai][bj][m][n]; }
    } else {
        bf16_t* O = (bf16_t*)g.out; const int ldc = g.ldc;
        const int row0 = u.pm * BM + wr * 64 + fr, col0 = u.pn * BM + wc * 32 + 8 * fq;
        const bool isrot = (KIND == 3) && (u.pn < 16);
        const float sc = (u.pn >= 8) ? 0.0625f : 1.0f;
        constexpr bool relu2 = (KIND == 2);
#pragma unroll
        for (int ai = 0; ai < 2; ++ai)
#pragma unroll
            for (int m = 0; m < 4; ++m) {
                const int row = row0 + ai * HALF + m * 16;
                bf16_t* rowp = O + (size_t)row * ldc + col0;
                const int pos = row & (SEQ - 1);
#pragma unroll
                for (int bj = 0; bj < 2; ++bj) {
                    f32x4 v0 = acc[ai][bj][m][0], v1 = acc[ai][bj][m][1];
                    if (relu2) {
#pragma unroll
                        for (int j = 0; j < 4; ++j) { const float a = fmaxf(v0[j], 0.f), b = fmaxf(v1[j], 0.f); v0[j] = a * a; v1[j] = b * b; }
                    }
                    if (isrot) {
                        const float* rp = g.rot + ((size_t)pos * 128 + 64 * bj + 16 * wc + 4 * fq) * 2;
                        const f32x4 c0 = *(const f32x4*)rp, c1 = *(const f32x4*)(rp + 4);
                        f32x4 r0, r1;
                        r0[0] = v0[0] * c0[0] - v0[1] * c0[1]; r0[1] = v0[0] * c0[1] + v0[1] * c0[0];
                        r0[2] = v0[2] * c0[2] - v0[3] * c0[3]; r0[3] = v0[2] * c0[3] + v0[3] * c0[2];
                        r1[0] = v1[0] * c1[0] - v1[1] * c1[1]; r1[1] = v1[0] * c1[1] + v1[1] * c1[0];
                        r1[2] = v1[2] * c1[2] - v1[3] * c1[3]; r1[3] = v1[2] * c1[3] + v1[3] * c1[2];
                        v0 = r0 * sc; v1 = r1 * sc;
                    }
                    u32x4 w; w.x = cvt_pk_bf16(v0[0], v0[1]); w.y = cvt_pk_bf16(v0[2], v0[3]); w.z = cvt_pk_bf16(v1[0], v1[1]); w.w = cvt_pk_bf16(v1[2], v1[3]);
                    *(u32x4*)(rowp + bj * HALF) = w;
                }
            }
    }
}

template <int KIND> __device__ __forceinline__ void gemm_phase(LAS unsigned char* lds, const Gemm g, const StaticOrder& S) {
    const int tid = otid(), wid = __builtin_amdgcn_readfirstlane(tid >> 6), lane = tid & 63, wr = wid >> 2, wc = wid & 3, fr = lane & 15, fq = lane >> 4;
    const int K = g.K, nt = K / BK, lda = g.lda;
    constexpr bool perm = KIND != 0;
    unsigned voffA[2], voffB[2];
#pragma unroll
    for (int i = 0; i < 2; ++i) { int R, C; stage_rc(tid * 16 + i * 8192, R, C); const int Rb = perm ? ((R & ~31) + perm32(R & 31)) : R;
        voffA[i] = (unsigned)(R * lda + C) * 2u; voffB[i] = (unsigned)(Rb * K + C) * 2u; }
    const size_t kstep = (size_t)(BK * 2);
    const size_t hstepA = (size_t)HALF * lda * 2, hstepB = (size_t)HALF * K * 2;
    const size_t tstepA = 2 * hstepA, tstepB = 2 * hstepB;
    const unsigned ldsw = (unsigned)wid * 1024u;
    const int aoff = lds_byte(wr * 64 + fr, fq * 8), boff = lds_byte(wc * 32 + fr, fq * 8);
#define PG8_SA(b, h) (((b) * 2 + (h)) * HTB)
#define PG8_SB(b, h) ((4 + (b) * 2 + (h)) * HTB)
#define PG8_STAGE(bufoff, gbase, voff) do { _Pragma("unroll") for (int _i = 0; _i < 2; ++_i) \
        __builtin_amdgcn_global_load_lds((const unsigned*)((const char*)(gbase) + (voff)[_i]), (LAS unsigned*)(lds + (bufoff) + ldsw + _i * 8192), 16, 0, 0); } while (0)
#define PG8_LDA(dst, b, h) do { _Pragma("unroll") for (int m = 0; m < 4; ++m) _Pragma("unroll") for (int k = 0; k < 2; ++k) dst[m][k] = *(const LAS bf16x8*)(lds + PG8_SA(b, h) + aoff + m * 2048 + k * 1024); } while (0)
#define PG8_LDB(dst, b, h) do { _Pragma("unroll") for (int n = 0; n < 2; ++n) _Pragma("unroll") for (int k = 0; k < 2; ++k) dst[n][k] = *(const LAS bf16x8*)(lds + PG8_SB(b, h) + boff + n * 2048 + k * 1024); } while (0)
#define PG8_MMA(ai, bj, At, Bt) do { __builtin_amdgcn_s_setprio(1); _Pragma("unroll") for (int m = 0; m < 4; ++m) _Pragma("unroll") for (int n = 0; n < 2; ++n) _Pragma("unroll") for (int k = 0; k < 2; ++k) \
        acc[ai][bj][m][n] = __builtin_amdgcn_mfma_f32_16x16x32_bf16(Bt[n][k], At[m][k], acc[ai][bj][m][n], 0, 0, 0); __builtin_amdgcn_s_setprio(0); } while (0)
#define PG8_WAIT_V(n) asm volatile("s_waitcnt vmcnt(" #n ")" ::: "memory")
#define PG8_WAIT_L(n) asm volatile("s_waitcnt lgkmcnt(" #n ")" ::: "memory")
#define PG8_BAR __builtin_amdgcn_s_barrier()
#define PG8_SCHED __builtin_amdgcn_sched_barrier(0)
    Unit cur, nxt; int ui = 0;
    if (!S.next(0, cur)) return;
    f32x4 acc[2][2][4][2];
#pragma unroll
    for (int a = 0; a < 2; ++a)
#pragma unroll
        for (int b = 0; b < 2; ++b)
#pragma unroll
            for (int m = 0; m < 4; ++m)
#pragma unroll
                for (int n = 0; n < 2; ++n) acc[a][b][m][n] = (f32x4){0.f, 0.f, 0.f, 0.f};
    bf16x8 At[4][2], B0[2][2], B1[2][2];
    const char* cA = (const char*)g.A + (size_t)cur.pm * tstepA; const char* cB = (const char*)g.Bt + (size_t)cur.pn * tstepB;
    PG8_STAGE(PG8_SB(0, 0), cB, voffB); PG8_STAGE(PG8_SA(0, 0), cA, voffA); PG8_STAGE(PG8_SB(0, 1), cB + hstepB, voffB); PG8_STAGE(PG8_SA(0, 1), cA + hstepA, voffA);
    if (wr == 1) PG8_BAR;
    PG8_WAIT_V(4); PG8_BAR;
    PG8_STAGE(PG8_SB(1, 0), cB + kstep, voffB); PG8_STAGE(PG8_SA(1, 0), cA + kstep, voffA); PG8_STAGE(PG8_SB(1, 1), cB + hstepB + kstep, voffB);
    PG8_WAIT_V(6); PG8_BAR;
    for (;;) {
        const bool has_next = S.next(ui + 1, nxt);
        const char* nA = has_next ? (const char*)g.A + (size_t)nxt.pm * tstepA : cA; const char* nB = has_next ? (const char*)g.Bt + (size_t)nxt.pn * tstepB : cB;
        for (int t = 0; t < nt; t += 2) {
            const bool last = (t == nt - 2);
            const char* a1 = cA + (size_t)(t + 1) * kstep;
            const char* a2 = last ? nA : cA + (size_t)(t + 2) * kstep; const char* b2 = last ? nB : cB + (size_t)(t + 2) * kstep;
            const char* a3 = a2 + kstep; const char* b3 = b2 + kstep;
            PG8_LDB(B0, 0, 0); PG8_SCHED; PG8_LDA(At, 0, 0); PG8_STAGE(PG8_SA(1, 1), a1 + hstepA, voffA);
            PG8_WAIT_L(8); PG8_BAR; PG8_WAIT_L(0); PG8_MMA(0, 0, At, B0); PG8_BAR; PG8_SCHED;
            PG8_LDB(B1, 0, 1); PG8_STAGE(PG8_SB(0, 0), b2, voffB);
            PG8_BAR; PG8_WAIT_L(0); PG8_MMA(0, 1, At, B1); PG8_BAR;
            PG8_LDA(At, 0, 1); PG8_STAGE(PG8_SA(0, 0), a2, voffA);
            PG8_BAR; PG8_WAIT_L(0); PG8_MMA(1, 0, At, B0); PG8_BAR; PG8_SCHED;
            PG8_STAGE(PG8_SB(0, 1), b2 + hstepB, voffB);
            PG8_WAIT_V(6); PG8_BAR; PG8_MMA(1, 1, At, B1); PG8_BAR;
            PG8_LDB(B0, 1, 0); PG8_SCHED; PG8_LDA(At, 1, 0); PG8_STAGE(PG8_SA(0, 1), a2 + hstepA, voffA);
            PG8_WAIT_L(8); PG8_BAR; PG8_WAIT_L(0); PG8_MMA(0, 0, At, B0); PG8_BAR; PG8_SCHED;
            PG8_LDB(B1, 1, 1); PG8_STAGE(PG8_SB(1, 0), b3, voffB);
            PG8_BAR; PG8_WAIT_L(0); PG8_MMA(0, 1, At, B1); PG8_BAR;
            PG8_LDA(At, 1, 1); PG8_STAGE(PG8_SA(1, 0), a3, voffA);
            PG8_BAR; PG8_WAIT_L(0); PG8_MMA(1, 0, At, B0); PG8_BAR; PG8_SCHED;
            PG8_STAGE(PG8_SB(1, 1), b3 + hstepB, voffB);
            PG8_WAIT_V(6); PG8_BAR; PG8_MMA(1, 1, At, B1); PG8_BAR;
        }
        epilogue<KIND>(g, acc, cur, wr, wc, fr, fq);
        if (!has_next) break;
#pragma unroll
        for (int a = 0; a < 2; ++a)
#pragma unroll
            for (int b = 0; b < 2; ++b)
#pragma unroll
                for (int m = 0; m < 4; ++m)
#pragma unroll
                    for (int n = 0; n < 2; ++n) acc[a][b][m][n] = (f32x4){0.f, 0.f, 0.f, 0.f};
        cur = nxt; cA = nA; cB = nB; ++ui;
    }
    PG8_WAIT_V(0);
    if (wr == 0) PG8_BAR;
    PG8_BAR;
#undef PG8_SA
#undef PG8_SB
#undef PG8_STAGE
#undef PG8_LDA
#undef PG8_LDB
#undef PG8_MMA
#undef PG8_WAIT_V
#undef PG8_WAIT_L
#undef PG8_BAR
#undef PG8_SCHED
}
}

struct ConvDesc { const float* src; bf16_t* dst; int K, Nsrc, Ndst, permq; };
__device__ __forceinline__ void convert_w(const ConvDesc& c, LAS unsigned char* lds, int wg, int G) {
    const int tid = otid();
    constexpr int RS = 144;
    const int nnt = c.Ndst / 128, ntile = (c.K / 64) * nnt;
    const int c4 = tid & 31, kq = tid >> 5;
    f32x4 r[4];
#define CW_LOAD(u_) do { const int nt_ = (u_) % nnt, kt_ = (u_) / nnt; const int col_ = nt_ * 128 + c4 * 4; \
        const float* sp_ = c.src + (size_t)(kt_ * 64 + kq * 4) * c.Nsrc + col_; const bool ok_ = col_ < c.Nsrc; \
        _Pragma("unroll") for (int i_ = 0; i_ < 4; ++i_) r[i_] = ok_ ? *(const f32x4*)(sp_ + (size_t)i_ * c.Nsrc) : (f32x4){0.f, 0.f, 0.f, 0.f}; } while (0)
    int u = wg;
    if (u < ntile) CW_LOAD(u);
    while (u < ntile) {
#pragma unroll
        for (int e = 0; e < 4; ++e) { u32x2 w; w.x = pk2(r[0][e], r[1][e]); w.y = pk2(r[2][e], r[3][e]); *(LAS u32x2*)(lds + (c4 * 4 + e) * RS + kq * 8) = w; }
        const int un = u + G;
        if (un < ntile) CW_LOAD(un);
        __syncthreads();
        {
            const int nt = u % nnt, kt = u / nnt, n0 = nt * 128;
            const bool pm = c.permq && n0 < 4096;
#pragma unroll
            for (int i = 0; i < 2; ++i) { const int idx = i * 512 + tid, row = idx >> 3, kb = idx & 7;
                const u32x4 v = *(const LAS u32x4*)(lds + row * RS + kb * 16);
                const int drow = pm ? ((n0 & ~255) + 2 * row + ((n0 >> 7) & 1)) : (n0 + row);
                *(u32x4*)(c.dst + (size_t)drow * c.K + kt * 64 + kb * 8) = v; }
        }
        __syncthreads();
        u = un;
    }
#undef CW_LOAD
}

struct NormDesc { int mode; const void* m; const float* hres; float* hout; const float* wpost; const float* wpre; bf16_t* ub; };
__device__ __forceinline__ void norm_pass(const NormDesc& d, int wg, int G) {
    const int tid_ = otid(); const int wave = tid_ >> 6, lane = tid_ & 63;
    for (int row = wg * 8 + wave; row < T; row += G * 8) {
        const size_t ro = (size_t)row * DM;
        float v[4][8]; float ss = 0.f;
        if (d.mode == 0) {
#pragma unroll
            for (int i = 0; i < 4; ++i) { const int c = (i * 64 + lane) * 8; const f32x4 a = *(const f32x4*)((const float*)d.m + ro + c), b = *(const f32x4*)((const float*)d.m + ro + c + 4);
#pragma unroll
                for (int e = 0; e < 4; ++e) { v[i][e] = a[e]; v[i][4 + e] = b[e]; } }
        } else {
#pragma unroll
            for (int i = 0; i < 4; ++i) { const int c = (i * 64 + lane) * 8; const u32x4 a = *(const u32x4*)((const bf16_t*)d.m + ro + c);
                v[i][0] = bflo(a.x); v[i][1] = bfhi(a.x); v[i][2] = bflo(a.y); v[i][3] = bfhi(a.y); v[i][4] = bflo(a.z); v[i][5] = bfhi(a.z); v[i][6] = bflo(a.w); v[i][7] = bfhi(a.w); }
        }
#pragma unroll
        for (int i = 0; i < 4; ++i)
#pragma unroll
            for (int e = 0; e < 8; ++e) ss += v[i][e] * v[i][e];
        ss = wave_sum(ss);
        const float r = rsqrtf(ss * (1.0f / DM) + 1e-6f);
        float r2 = r;
        if (d.mode != 0) {
            float s2 = 0.f;
#pragma unroll
            for (int i = 0; i < 4; ++i) { const int c = (i * 64 + lane) * 8;
                const f32x4 w0 = *(const f32x4*)(d.wpost + c), w1 = *(const f32x4*)(d.wpost + c + 4);
                const f32x4 h0 = *(const f32x4*)(d.hres + ro + c), h1 = *(const f32x4*)(d.hres + ro + c + 4);
                f32x4 o0, o1;
#pragma unroll
                for (int e = 0; e < 4; ++e) { o0[e] = h0[e] + v[i][e] * r * w0[e]; o1[e] = h1[e] + v[i][4 + e] * r * w1[e]; v[i][e] = o0[e]; v[i][4 + e] = o1[e]; s2 += o0[e] * o0[e] + o1[e] * o1[e]; }
                *(f32x4*)(d.hout + ro + c) = o0; *(f32x4*)(d.hout + ro + c + 4) = o1; }
            if (d.mode == 1) { s2 = wave_sum(s2); r2 = rsqrtf(s2 * (1.0f / DM) + 1e-6f); }
        }
        if (d.mode != 2) {
#pragma unroll
            for (int i = 0; i < 4; ++i) { const int c = (i * 64 + lane) * 8;
                const f32x4 w0 = *(const f32x4*)(d.wpre + c), w1 = *(const f32x4*)(d.wpre + c + 4);
                u32x4 o; o.x = pk2(v[i][0] * r2 * w0[0], v[i][1] * r2 * w0[1]); o.y = pk2(v[i][2] * r2 * w0[2], v[i][3] * r2 * w0[3]);
                o.z = pk2(v[i][4] * r2 * w1[0], v[i][5] * r2 * w1[1]); o.w = pk2(v[i][6] * r2 * w1[2], v[i][7] * r2 * w1[3]);
                *(u32x4*)(d.ub + ro + c) = o; }
        }
    }
}

__device__ __forceinline__ void rot_table(float* rot, int wg, int G) {
    for (int e = wg * NTHREADS + otid(); e < SEQ * 128; e += G * NTHREADS) {
        const int pos = e >> 7, jf = e & 127;
        const float inv = exp2f(-(float)jf * (13.287712379549449f / 128.0f));
        const float ang = (float)pos * inv;
        const double a = (double)ang; const double k = rint(a * 0.15915494309189535); const float rf = (float)(a - k * 6.283185307179586);
        f32x2 cs; cs.x = cosf(rf); cs.y = sinf(rf);
        *(f32x2*)(rot + 2 * (size_t)e) = cs;
    }
}

__device__ __forceinline__ void ret_scan(bf16_t* proj, LAS unsigned char* lds, int wg, int G) {
    const int tid = otid(), lane = tid & 63, wid = __builtin_amdgcn_readfirstlane(tid >> 6), fr = lane & 15, fq = lane >> 4;
    constexpr int QS = 528, VS = 80, PS = 144;
    LAS unsigned char* Qs = lds; LAS unsigned char* Ks = lds + 33792; LAS unsigned char* Vs = lds + 67584; LAS unsigned char* Vz = lds + 72704;
    LAS unsigned char* Ps = lds + 77824; LAS unsigned char* St = lds + 87040;
    const int lm = wid >> 1, c2 = wid & 1;
    for (int unit = wg; unit < 256; unit += G) {
        const int xc = unit & 7, ii = unit >> 3, bh = xc * 2 + (ii >> 4), vs = ii & 15, b = bh >> 3, h = bh & 7;
        const float lg = log1pf(-exp2f(-5.0f - (float)h));
        float dm[2][4], xi[4];
#pragma unroll
        for (int j = 0; j < 4; ++j) { const int l = lm * 16 + fq * 4 + j; xi[j] = expf((float)(l + 1) * lg);
#pragma unroll
            for (int t = 0; t < 2; ++t) { const int m = (c2 * 2 + t) * 16 + fr; const int dd = l > m ? l - m : m - l; dm[t][j] = expf((float)dd * lg); } }
        const float cdecay = expf(64.0f * lg);
        const int vrow = (tid & 255) >> 2, vch = tid & 3;
        const float zeta = expf((float)(63 - vrow) * lg);
        f32x4 accS[2][2];
#pragma unroll
        for (int a = 0; a < 2; ++a)
#pragma unroll
            for (int c = 0; c < 2; ++c) accS[a][c] = (f32x4){0.f, 0.f, 0.f, 0.f};
        for (int i = tid; i < 16896 / 4; i += NTHREADS) ((LAS unsigned*)St)[i] = 0u;
        const bf16_t* qb = proj + (size_t)(b * SEQ) * RIN + h * 256;
        const bf16_t* kb = qb + 2048;
        bf16_t* vb = proj + (size_t)(b * SEQ) * RIN + 4096 + h * 512 + vs * 32;
        u32x4 rq[4], rk[4], rv;
#pragma unroll
        for (int i = 0; i < 4; ++i) { const int idx = i * 512 + tid, row = idx >> 5, ch = idx & 31; rq[i] = *(const u32x4*)(qb + (size_t)row * RIN + ch * 8); rk[i] = *(const u32x4*)(kb + (size_t)row * RIN + ch * 8); }
        rv = (u32x4){0u, 0u, 0u, 0u};
        if (tid < 256) rv = *(const u32x4*)(vb + (size_t)vrow * RIN + vch * 8);
        for (int c = 0; c < 128; ++c) {
#pragma unroll
            for (int i = 0; i < 4; ++i) { const int idx = i * 512 + tid, row = idx >> 5, ch = idx & 31; *(LAS u32x4*)(Qs + row * QS + ch * 16) = rq[i]; *(LAS u32x4*)(Ks + row * QS + ch * 16) = rk[i]; }
            if (tid < 256) {
                *(LAS u32x4*)(Vs + vrow * VS + vch * 16) = rv;
                u32x4 z; z.x = pk2(bflo(rv.x) * zeta, bfhi(rv.x) * zeta); z.y = pk2(bflo(rv.y) * zeta, bfhi(rv.y) * zeta);
                z.z = pk2(bflo(rv.z) * zeta, bfhi(rv.z) * zeta); z.w = pk2(bflo(rv.w) * zeta, bfhi(rv.w) * zeta);
                *(LAS u32x4*)(Vz + vrow * VS + vch * 16) = z;
            }
            __syncthreads();
            if (c + 1 < 128) {
                const size_t ro = (size_t)(c + 1) * 64 * RIN;
#pragma unroll
                for (int i = 0; i < 4; ++i) { const int idx = i * 512 + tid, row = idx >> 5, ch = idx & 31; rq[i] = *(const u32x4*)(qb + ro + (size_t)row * RIN + ch * 8); rk[i] = *(const u32x4*)(kb + ro + (size_t)row * RIN + ch * 8); }
                if (tid < 256) rv = *(const u32x4*)(vb + ro + (size_t)vrow * RIN + vch * 8);
            }
            f32x4 aP0 = {0.f, 0.f, 0.f, 0.f}, aP1 = {0.f, 0.f, 0.f, 0.f}, aX = {0.f, 0.f, 0.f, 0.f};
#pragma unroll
            for (int ks = 0; ks < 8; ++ks) {
                const bf16x8 a = *(const LAS bf16x8*)(Qs + (lm * 16 + fr) * QS + ks * 64 + fq * 16);
                const bf16x8 b0 = *(const LAS bf16x8*)(Ks + ((c2 * 2 + 0) * 16 + fr) * QS + ks * 64 + fq * 16);
                const bf16x8 b1 = *(const LAS bf16x8*)(Ks + ((c2 * 2 + 1) * 16 + fr) * QS + ks * 64 + fq * 16);
                const bf16x8 bs = *(const LAS bf16x8*)(St + (c2 * 16 + fr) * QS + ks * 64 + fq * 16);
                aP0 = __builtin_amdgcn_mfma_f32_16x16x32_bf16(a, b0, aP0, 0, 0, 0);
                aP1 = __builtin_amdgcn_mfma_f32_16x16x32_bf16(a, b1, aP1, 0, 0, 0);
                aX = __builtin_amdgcn_mfma_f32_16x16x32_bf16(a, bs, aX, 0, 0, 0);
            }
#pragma unroll
            for (int j = 0; j < 4; ++j) { const int l = lm * 16 + fq * 4 + j;
                *(LAS bf16_t*)(Ps + l * PS + ((c2 * 2 + 0) * 16 + fr) * 2) = (bf16_t)f2bf(aP0[j] * dm[0][j]);
                *(LAS bf16_t*)(Ps + l * PS + ((c2 * 2 + 1) * 16 + fr) * 2) = (bf16_t)f2bf(aP1[j] * dm[1][j]); }
            __syncthreads();
            f32x4 aI = {0.f, 0.f, 0.f, 0.f};
#pragma unroll
            for (int ks = 0; ks < 2; ++ks) {
                const bf16x8 a = *(const LAS bf16x8*)(Ps + (lm * 16 + fr) * PS + ks * 64 + fq * 16);
                const bf16x8 bv = tr_frag(Vs, VS, ks * 32, c2 * 16, lane);
                aI = __builtin_amdgcn_mfma_f32_16x16x32_bf16(a, bv, aI, 0, 0, 0);
            }
            {
                bf16_t* ob = vb + (size_t)(c * 64) * RIN + c2 * 16 + fr;
#pragma unroll
                for (int j = 0; j < 4; ++j) { const int l = lm * 16 + fq * 4 + j; ob[(size_t)l * RIN] = (bf16_t)f2bf(aI[j] + aX[j] * xi[j]); }
            }
#pragma unroll
            for (int a = 0; a < 2; ++a)
#pragma unroll
                for (int cc = 0; cc < 2; ++cc) accS[a][cc] *= cdecay;
#pragma unroll
            for (int ks = 0; ks < 2; ++ks) {
                const bf16x8 ad0 = tr_frag(Ks, QS, ks * 32, (wid * 2 + 0) * 16, lane);
                const bf16x8 ad1 = tr_frag(Ks, QS, ks * 32, (wid * 2 + 1) * 16, lane);
                const bf16x8 bv0 = tr_frag(Vz, VS, ks * 32, 0, lane);
                const bf16x8 bv1 = tr_frag(Vz, VS, ks * 32, 16, lane);
                accS[0][0] = __builtin_amdgcn_mfma_f32_16x16x32_bf16(ad0, bv0, accS[0][0], 0, 0, 0);
                accS[0][1] = __builtin_amdgcn_mfma_f32_16x16x32_bf16(ad0, bv1, accS[0][1], 0, 0, 0);
                accS[1][0] = __builtin_amdgcn_mfma_f32_16x16x32_bf16(ad1, bv0, accS[1][0], 0, 0, 0);
                accS[1][1] = __builtin_amdgcn_mfma_f32_16x16x32_bf16(ad1, bv1, accS[1][1], 0, 0, 0);
            }
#pragma unroll
            for (int a = 0; a < 2; ++a)
#pragma unroll
                for (int cc = 0; cc < 2; ++cc) {
                    u32x2 w; w.x = pk2(accS[a][cc][0], accS[a][cc][1]); w.y = pk2(accS[a][cc][2], accS[a][cc][3]);
                    *(LAS u32x2*)(St + (cc * 16 + fr) * QS + ((wid * 2 + a) * 16 + fq * 4) * 2) = w;
                }
            __syncthreads();
        }
    }
}

__device__ __forceinline__ void ret_gn(bf16_t* proj, const float* gnw, int wg, int G) {
    const int tid_ = otid(); const int wave = tid_ >> 6, lane = tid_ & 63;
    for (int pair = wg * 8 + wave; pair < T * 8; pair += G * 8) {
        const int t = pair >> 3, h = pair & 7;
        bf16_t* op = proj + (size_t)t * RIN + 4096 + h * 512 + lane * 8;
        bf16_t* gp = op + 4096;
        const u32x4 ov = *(const u32x4*)op, gv = *(const u32x4*)gp;
        float o[8] = {bflo(ov.x), bfhi(ov.x), bflo(ov.y), bfhi(ov.y), bflo(ov.z), bfhi(ov.z), bflo(ov.w), bfhi(ov.w)};
        float g[8] = {bflo(gv.x), bfhi(gv.x), bflo(gv.y), bfhi(gv.y), bflo(gv.z), bfhi(gv.z), bflo(gv.w), bfhi(gv.w)};
        float s = 0.f;
#pragma unroll
        for (int e = 0; e < 8; ++e) s += o[e];
        const float mu = wave_sum(s) * (1.0f / 512.0f);
        float q = 0.f;
#pragma unroll
        for (int e = 0; e < 8; ++e) { o[e] -= mu; q += o[e] * o[e]; }
        const float rstd = rsqrtf(wave_sum(q) * (1.0f / 512.0f) + 1e-5f);
        const f32x4 w0 = *(const f32x4*)(gnw + h * 512 + lane * 8), w1 = *(const f32x4*)(gnw + h * 512 + lane * 8 + 4);
        float y[8];
#pragma unroll
        for (int e = 0; e < 8; ++e) y[e] = silu(g[e]) * (o[e] * rstd) * (e < 4 ? w0[e & 3] : w1[e & 3]);
        u32x4 w; w.x = pk2(y[0], y[1]); w.y = pk2(y[2], y[3]); w.z = pk2(y[4], y[5]); w.w = pk2(y[6], y[7]);
        *(u32x4*)gp = w;
    }
}

__device__ __forceinline__ void ssd_pre(const bf16_t* proj, bf16_t* halo, float* dtv, const float* dt_bias, int wg, int G) {
    const int gt = wg * NTHREADS + otid(), gs = G * NTHREADS;
    for (int e = gt; e < 256 * 3 * 768; e += gs) {
        const int oc = e % 768, r = (e / 768) % 3, ck = e / (768 * 3);
        const u32x4 v = *(const u32x4*)(proj + (size_t)(ck * 64 + 61 + r) * SINP + 4096 + oc * 8);
        *(u32x4*)(halo + ((size_t)ck * 3 + r) * 6144 + oc * 8) = v;
    }
    for (int e = gt; e < T * 64; e += gs) {
        const int t = e >> 6, hd = e & 63;
        const float x = bf2f(proj[(size_t)t * SINP + 10240 + hd]) + dt_bias[hd];
        dtv[e] = x > 20.f ? x : log1pf(expf(x));
    }
}
__device__ __forceinline__ void ssd_conv(bf16_t* proj, const bf16_t* halo, const float* cw, const float* cb, int wg, int G) {
    const int gt = wg * NTHREADS + otid(), gs = G * NTHREADS;
    for (int e = gt; e < 256 * 768; e += gs) {
        const int oc = e % 768, ck = e / 768, col = oc * 8;
        float w[4][8], bias[8];
#pragma unroll
        for (int tp = 0; tp < 4; ++tp) { const f32x4 a = *(const f32x4*)(cw + tp * 6144 + col), b = *(const f32x4*)(cw + tp * 6144 + col + 4);
#pragma unroll
            for (int i = 0; i < 4; ++i) { w[tp][i] = a[i]; w[tp][4 + i] = b[i]; } }
        { const f32x4 a = *(const f32x4*)(cb + col), b = *(const f32x4*)(cb + col + 4);
#pragma unroll
            for (int i = 0; i < 4; ++i) { bias[i] = a[i]; bias[4 + i] = b[i]; } }
        float p3[8], p2[8], p1[8];
        if ((ck & 127) == 0) {
#pragma unroll
            for (int i = 0; i < 8; ++i) { p3[i] = 0.f; p2[i] = 0.f; p1[i] = 0.f; }
        } else {
            const bf16_t* hp = halo + ((size_t)(ck - 1) * 3) * 6144 + col;
            const u32x4 a = *(const u32x4*)hp, b = *(const u32x4*)(hp + 6144), c = *(const u32x4*)(hp + 2 * 6144);
            p3[0] = bflo(a.x); p3[1] = bfhi(a.x); p3[2] = bflo(a.y); p3[3] = bfhi(a.y); p3[4] = bflo(a.z); p3[5] = bfhi(a.z); p3[6] = bflo(a.w); p3[7] = bfhi(a.w);
            p2[0] = bflo(b.x); p2[1] = bfhi(b.x); p2[2] = bflo(b.y); p2[3] = bfhi(b.y); p2[4] = bflo(b.z); p2[5] = bfhi(b.z); p2[6] = bflo(b.w); p2[7] = bfhi(b.w);
            p1[0] = bflo(c.x); p1[1] = bfhi(c.x); p1[2] = bflo(c.y); p1[3] = bfhi(c.y); p1[4] = bflo(c.z); p1[5] = bfhi(c.z); p1[6] = bflo(c.w); p1[7] = bfhi(c.w);
        }
        bf16_t* rp = proj + (size_t)(ck * 64) * SINP + 4096 + col;
        for (int r = 0; r < 64; ++r) {
            const u32x4 xv = *(const u32x4*)(rp + (size_t)r * SINP);
            float x[8] = {bflo(xv.x), bfhi(xv.x), bflo(xv.y), bfhi(xv.y), bflo(xv.z), bfhi(xv.z), bflo(xv.w), bfhi(xv.w)};
            float y[8];
#pragma unroll
            for (int i = 0; i < 8; ++i) { const float s = bias[i] + w[0][i] * p3[i] + w[1][i] * p2[i] + w[2][i] * p1[i] + w[3][i] * x[i]; y[i] = silu(s); p3[i] = p2[i]; p2[i] = p1[i]; p1[i] = x[i]; }
            u32x4 o; o.x = pk2(y[0], y[1]); o.y = pk2(y[2], y[3]); o.z = pk2(y[4], y[5]); o.w = pk2(y[6], y[7]);
            *(u32x4*)(rp + (size_t)r * SINP) = o;
        }
    }
}

__device__ __forceinline__ void ssd_scan(bf16_t* proj, const float* dtv, const float* a_log, const float* d_skip, LAS unsigned char* lds, int wg, int G) {
    const int tid = otid(), lane = tid & 63, wid = __builtin_amdgcn_readfirstlane(tid >> 6), fr = lane & 15, fq = lane >> 4;
    constexpr int CS = 272, XS = 80, WS = 144;
    LAS unsigned char* Cs = lds; LAS unsigned char* Bs = lds + 17408; LAS unsigned char* Xs = lds + 34816; LAS unsigned char* Xw = lds + 39936; LAS unsigned char* Zs = lds + 45056;
    LAS unsigned char* Ws = lds + 50176; LAS unsigned char* Sts = lds + 59392; LAS float* acum = (LAS float*)(lds + 68096); LAS float* dts = (LAS float*)(lds + 68352);
    const int lm = wid >> 1, c2 = wid & 1;
    for (int unit = wg; unit < 256; unit += G) {
        const int grp = unit & 7, ii = unit >> 3, b = ii >> 4, hd = grp * 8 + ((ii & 15) >> 1), ph = ii & 1;
        const float an = -expf(a_log[hd]), dsk = d_skip[hd];
        f32x4 accT[2];
        accT[0] = (f32x4){0.f, 0.f, 0.f, 0.f}; accT[1] = (f32x4){0.f, 0.f, 0.f, 0.f};
        for (int i = tid; i < 8704 / 4; i += NTHREADS) ((LAS unsigned*)Sts)[i] = 0u;
        const bf16_t* base = proj + (size_t)(b * SEQ) * SINP;
        const bf16_t* bb = base + 8192 + grp * 128;
        const bf16_t* cbp = base + 9216 + grp * 128;
        bf16_t* xb = (bf16_t*)base + 4096 + hd * 64 + ph * 32;
        const bf16_t* zb = base + hd * 64 + ph * 32;
        const float* dtp = dtv + (size_t)(b * SEQ) * 64 + hd;
        const int xrow = (tid & 255) >> 2, xch = tid & 3;
        u32x4 rc[2], rb[2], rxz; float rdt = 0.f;
#pragma unroll
        for (int i = 0; i < 2; ++i) { const int idx = i * 512 + tid, row = idx >> 4, ch = idx & 15; rc[i] = *(const u32x4*)(cbp + (size_t)row * SINP + ch * 8); rb[i] = *(const u32x4*)(bb + (size_t)row * SINP + ch * 8); }
        rxz = *(const u32x4*)((tid < 256 ? (const bf16_t*)xb : zb) + (size_t)xrow * SINP + xch * 8);
        if (wid == 0) rdt = dtp[(size_t)lane * 64];
        for (int c = 0; c < 128; ++c) {
#pragma unroll
            for (int i = 0; i < 2; ++i) { const int idx = i * 512 + tid, row = idx >> 4, ch = idx & 15; *(LAS u32x4*)(Cs + row * CS + ch * 16) = rc[i]; *(LAS u32x4*)(Bs + row * CS + ch * 16) = rb[i]; }
            *(LAS u32x4*)((tid < 256 ? Xs : Zs) + xrow * XS + xch * 16) = rxz;
            if (wid == 0) {
                float s = rdt * an;
#pragma unroll
                for (int o = 1; o < 64; o <<= 1) { const float tt = __shfl_up(s, o); if (lane >= o) s += tt; }
                acum[lane] = s; dts[lane] = rdt;
            }
            __syncthreads();
            if (c + 1 < 128) {
                const size_t ro = (size_t)(c + 1) * 64 * SINP;
#pragma unroll
                for (int i = 0; i < 2; ++i) { const int idx = i * 512 + tid, row = idx >> 4, ch = idx & 15; rc[i] = *(const u32x4*)(cbp + ro + (size_t)row * SINP + ch * 8); rb[i] = *(const u32x4*)(bb + ro + (size_t)row * SINP + ch * 8); }
                rxz = *(const u32x4*)((tid < 256 ? (const bf16_t*)xb : zb) + ro + (size_t)xrow * SINP + xch * 8);
                if (wid == 0) rdt = dtp[((size_t)(c + 1) * 64 + lane) * 64];
            }
            const float atot = acum[63];
            float al[4], as_[2], ds_[2];
#pragma unroll
            for (int j = 0; j < 4; ++j) al[j] = acum[lm * 16 + fq * 4 + j];
#pragma unroll
            for (int t = 0; t < 2; ++t) { as_[t] = acum[(c2 * 2 + t) * 16 + fr]; ds_[t] = dts[(c2 * 2 + t) * 16 + fr]; }
            if (tid < 256) {
                const float f = dts[xrow] * expf(atot - acum[xrow]);
                const u32x4 xv = *(const LAS u32x4*)(Xs + xrow * XS + xch * 16);
                u32x4 z; z.x = pk2(bflo(xv.x) * f, bfhi(xv.x) * f); z.y = pk2(bflo(xv.y) * f, bfhi(xv.y) * f); z.z = pk2(bflo(xv.z) * f, bfhi(xv.z) * f); z.w = pk2(bflo(xv.w) * f, bfhi(xv.w) * f);
                *(LAS u32x4*)(Xw + xrow * XS + xch * 16) = z;
            }
            f32x4 aW0 = {0.f, 0.f, 0.f, 0.f}, aW1 = {0.f, 0.f, 0.f, 0.f}, aY = {0.f, 0.f, 0.f, 0.f};
#pragma unroll
            for (int ks = 0; ks < 4; ++ks) {
                const bf16x8 a = *(const LAS bf16x8*)(Cs + (lm * 16 + fr) * CS + ks * 64 + fq * 16);
                const bf16x8 b0 = *(const LAS bf16x8*)(Bs + ((c2 * 2 + 0) * 16 + fr) * CS + ks * 64 + fq * 16);
                const bf16x8 b1 = *(const LAS bf16x8*)(Bs + ((c2 * 2 + 1) * 16 + fr) * CS + ks * 64 + fq * 16);
                const bf16x8 bs = *(const LAS bf16x8*)(Sts + (c2 * 16 + fr) * CS + ks * 64 + fq * 16);
                aW0 = __builtin_amdgcn_mfma_f32_16x16x32_bf16(a, b0, aW0, 0, 0, 0);
                aW1 = __builtin_amdgcn_mfma_f32_16x16x32_bf16(a, b1, aW1, 0, 0, 0);
                aY = __builtin_amdgcn_mfma_f32_16x16x32_bf16(a, bs, aY, 0, 0, 0);
            }
#pragma unroll
            for (int j = 0; j < 4; ++j) { const int l = lm * 16 + fq * 4 + j;
                const int s0 = (c2 * 2 + 0) * 16 + fr, s1 = (c2 * 2 + 1) * 16 + fr;
                const float w0 = (l >= s0) ? aW0[j] * expf(al[j] - as_[0]) * ds_[0] : 0.f;
                const float w1 = (l >= s1) ? aW1[j] * expf(al[j] - as_[1]) * ds_[1] : 0.f;
                *(LAS bf16_t*)(Ws + l * WS + s0 * 2) = (bf16_t)f2bf(w0);
                *(LAS bf16_t*)(Ws + l * WS + s1 * 2) = (bf16_t)f2bf(w1); }
            __syncthreads();
            f32x4 aD = {0.f, 0.f, 0.f, 0.f};
#pragma unroll
            for (int ks = 0; ks < 2; ++ks) {
                const bf16x8 a = *(const LAS bf16x8*)(Ws + (lm * 16 + fr) * WS + ks * 64 + fq * 16);
                const bf16x8 bx = tr_frag(Xs, XS, ks * 32, c2 * 16, lane);
                aD = __builtin_amdgcn_mfma_f32_16x16x32_bf16(a, bx, aD, 0, 0, 0);
            }
            {
                const int pc = c2 * 16 + fr;
                bf16_t* ob = xb + (size_t)(c * 64) * SINP + pc;
#pragma unroll
                for (int j = 0; j < 4; ++j) { const int l = lm * 16 + fq * 4 + j;
                    const float xv = bf2f(*(const LAS bf16_t*)(Xs + l * XS + pc * 2)), zv = bf2f(*(const LAS bf16_t*)(Zs + l * XS + pc * 2));
                    const float y = aD[j] + aY[j] * expf(al[j]) + dsk * xv;
                    ob[(size_t)l * SINP] = (bf16_t)f2bf(y * silu(zv)); }
            }
            const float sdec = expf(atot);
            accT[0] *= sdec; accT[1] *= sdec;
#pragma unroll
            for (int ks = 0; ks < 2; ++ks) {
                const bf16x8 an_ = tr_frag(Bs, CS, ks * 32, wid * 16, lane);
                const bf16x8 bp0 = tr_frag(Xw, XS, ks * 32, 0, lane);
                const bf16x8 bp1 = tr_frag(Xw, XS, ks * 32, 16, lane);
                accT[0] = __builtin_amdgcn_mfma_f32_16x16x32_bf16(an_, bp0, accT[0], 0, 0, 0);
                accT[1] = __builtin_amdgcn_mfma_f32_16x16x32_bf16(an_, bp1, accT[1], 0, 0, 0);
            }
#pragma unroll
            for (int pi = 0; pi < 2; ++pi) {
                u32x2 w; w.x = pk2(accT[pi][0], accT[pi][1]); w.y = pk2(accT[pi][2], accT[pi][3]);
                *(LAS u32x2*)(Sts + (pi * 16 + fr) * CS + (wid * 16 + fq * 4) * 2) = w;
            }
            __syncthreads();
        }
    }
}

__device__ __forceinline__ void ssd_norm(bf16_t* proj, const float* nw, int wg, int G) {
    const int tid_ = otid(); const int wave = tid_ >> 6, lane = tid_ & 63;
    for (int pair = wg * 8 + wave; pair < T * 8; pair += G * 8) {
        const int t = pair >> 3, gr = pair & 7;
        bf16_t* yp = proj + (size_t)t * SINP + 4096 + gr * 512 + lane * 8;
        const u32x4 yv = *(const u32x4*)yp;
        float y[8] = {bflo(yv.x), bfhi(yv.x), bflo(yv.y), bfhi(yv.y), bflo(yv.z), bfhi(yv.z), bflo(yv.w), bfhi(yv.w)};
        float q = 0.f;
#pragma unroll
        for (int e = 0; e < 8; ++e) q += y[e] * y[e];
        const float r = rsqrtf(wave_sum(q) * (1.0f / 512.0f) + 1e-6f);
        const f32x4 w0 = *(const f32x4*)(nw + gr * 512 + lane * 8), w1 = *(const f32x4*)(nw + gr * 512 + lane * 8 + 4);
        u32x4 w; w.x = pk2(y[0] * r * w0[0], y[1] * r * w0[1]); w.y = pk2(y[2] * r * w0[2], y[3] * r * w0[3]);
        w.z = pk2(y[4] * r * w1[0], y[5] * r * w1[1]); w.w = pk2(y[6] * r * w1[2], y[7] * r * w1[3]);
        *(u32x4*)yp = w;
    }
}

struct Params {
    const float* x; const float* nmp; const float* nmq; const float* nfp; const float* nfq;
    const float* ret_w_in; const float* ret_gn_w; const float* ret_w_out;
    const float* ssd_w_in; const float* conv_w; const float* conv_b; const float* dt_bias; const float* a_log; const float* d_skip; const float* ssd_norm_w; const float* ssd_w_out;
    const float* w_up; const float* w_down;
    float* out; unsigned char* ws;
};


__global__ void __launch_bounds__(NTHREADS, 2) mega(Params p) {
    extern __shared__ __attribute__((aligned(16))) unsigned char lds_raw[];
    LAS unsigned char* lds = (LAS unsigned char*)lds_raw;
    cg::grid_group grid = cg::this_grid();
    const int G = gridDim.x, wg = blockIdx.x;
    bf16_t* WA = (bf16_t*)(p.ws + OFF_WA); bf16_t* WB = (bf16_t*)(p.ws + OFF_WB);
    bf16_t* ACT = (bf16_t*)(p.ws + OFF_ACT); bf16_t* U_ACT = (bf16_t*)(p.ws + OFF_ACT + HID_BYTES); bf16_t* F_ACT = (bf16_t*)(p.ws + OFF_ACT + HID_BYTES);
    bf16_t* U_R2 = (bf16_t*)(p.ws + OFF_R2); bf16_t* MF_R2 = (bf16_t*)(p.ws + OFF_R2);
    float* ROT = (float*)(p.ws + OFF_ROT); bf16_t* HALO = (bf16_t*)(p.ws + OFF_HALO); float* DTV = (float*)(p.ws + OFF_DTV);

#define GEMM(KIND, ...) do { const pg8::Gemm gd = pg8::Gemm{__VA_ARGS__}; pg8::StaticOrder S; S.init(gd.M, gd.N, G, wg); pg8::gemm_phase<KIND>(lds, gd, S); grid.sync(); } while (0)
    norm_pass(NormDesc{0, p.x, nullptr, nullptr, nullptr, p.nmp, U_R2}, wg, G);
    convert_w(ConvDesc{p.ret_w_in, WA, 2048, RIN, RIN, 1}, lds, wg, G);
    convert_w(ConvDesc{p.ret_w_out, WB, 4096, 2048, 2048, 0}, lds, wg, G);
    rot_table(ROT, wg, G);
    grid.sync();
    GEMM(3, U_R2, WA, T, RIN, 2048, 2048, 3, ACT, RIN, ROT);
    ret_scan(ACT, lds, wg, G); grid.sync();
    ret_gn(ACT, p.ret_gn_w, wg, G); grid.sync();
    GEMM(1, ACT + 8192, WB, T, 2048, 4096, RIN, 1, MF_R2, 2048, nullptr);
    norm_pass(NormDesc{1, MF_R2, p.x, p.out, p.nmq, p.nfp, U_ACT}, wg, G);
    convert_w(ConvDesc{p.w_up, WA, 2048, DFF, DFF, 0}, lds, wg, G);
    convert_w(ConvDesc{p.w_down, WB, DFF, 2048, 2048, 0}, lds, wg, G);
    grid.sync();
    GEMM(2, U_ACT, WA, T, DFF, 2048, 2048, 2, ACT, DFF, nullptr);
    GEMM(1, ACT, WB, T, 2048, DFF, DFF, 1, F_ACT, 2048, nullptr);
    norm_pass(NormDesc{1, F_ACT, p.out, p.out, p.nfq, p.nmp + DM, U_R2}, wg, G);
    convert_w(ConvDesc{p.ssd_w_in, WA, 2048, SIN, SINP, 0}, lds, wg, G);
    convert_w(ConvDesc{p.ssd_w_out, WB, 4096, 2048, 2048, 0}, lds, wg, G);
    grid.sync();
    GEMM(1, U_R2, WA, T, SINP, 2048, 2048, 1, ACT, SINP, nullptr);
    ssd_pre(ACT, HALO, DTV, p.dt_bias, wg, G); grid.sync();
    ssd_conv(ACT, HALO, p.conv_w, p.conv_b, wg, G); grid.sync();
    ssd_scan(ACT, DTV, p.a_log, p.d_skip, lds, wg, G); grid.sync();
    ssd_norm(ACT, p.ssd_norm_w, wg, G); grid.sync();
    GEMM(1, ACT + 4096, WB, T, 2048, 4096, SINP, 1, MF_R2, 2048, nullptr);
    norm_pass(NormDesc{1, MF_R2, p.out, p.out, p.nmq + DM, p.nfp + DM, U_ACT}, wg, G);
    convert_w(ConvDesc{p.w_up + (size_t)2048 * DFF, WA, 2048, DFF, DFF, 0}, lds, wg, G);
    convert_w(ConvDesc{p.w_down + (size_t)DFF * 2048, WB, DFF, 2048, 2048, 0}, lds, wg, G);
    grid.sync();
    GEMM(2, U_ACT, WA, T, DFF, 2048, 2048, 2, ACT, DFF, nullptr);
    GEMM(1, ACT, WB, T, 2048, DFF, DFF, 1, F_ACT, 2048, nullptr);
    norm_pass(NormDesc{2, F_ACT, p.out, p.out, p.nfq + DM, nullptr, nullptr}, wg, G);
#undef GEMM
}

extern "C" void kernel_launch(void* const* d_in, const int* in_sizes, int n_in, void* d_out, int out_size, void* d_ws, size_t ws_size, hipStream_t stream) {
    static int grid_blocks = 0;
    if (!grid_blocks) {
        int dev = 0, cus = 0, per_cu = 0;
        hipGetDevice(&dev);
        hipDeviceGetAttribute(&cus, hipDeviceAttributeMultiprocessorCount, dev);
        hipFuncSetAttribute((const void*)mega, hipFuncAttributeMaxDynamicSharedMemorySize, LDS_BYTES);
        hipOccupancyMaxActiveBlocksPerMultiprocessor(&per_cu, (const void*)mega, NTHREADS, LDS_BYTES);
        if (per_cu < 1) per_cu = 1;
        grid_blocks = cus * per_cu;
        if (ws_size < WS_END) { fprintf(stderr, "kernel_launch: workspace too small: %zu < %zu\n", ws_size, (size_t)WS_END); grid_blocks = -1; }
    }
    if (grid_blocks < 0) return;
    Params p{};
    p.x = (const float*)d_in[0]; p.nmp = (const float*)d_in[1]; p.nmq = (const float*)d_in[2]; p.nfp = (const float*)d_in[3]; p.nfq = (const float*)d_in[4];
    p.ret_w_in = (const float*)d_in[5]; p.ret_gn_w = (const float*)d_in[6]; p.ret_w_out = (const float*)d_in[7];
    p.ssd_w_in = (const float*)d_in[8]; p.conv_w = (const float*)d_in[9]; p.conv_b = (const float*)d_in[10]; p.dt_bias = (const float*)d_in[11];
    p.a_log = (const float*)d_in[12]; p.d_skip = (const float*)d_in[13]; p.ssd_norm_w = (const float*)d_in[14]; p.ssd_w_out = (const float*)d_in[15];
    p.w_up = (const float*)d_in[16]; p.w_down = (const float*)d_in[17];
    p.out = (float*)d_out; p.ws = (unsigned char*)d_ws;
    void* args[] = {&p};
    hipError_t e = hipLaunchCooperativeKernel((const void*)mega, dim3(grid_blocks), dim3(NTHREADS), args, LDS_BYTES, stream);
    if (e != hipSuccess) fprintf(stderr, "cooperative launch failed: %s (grid %d)\n", hipGetErrorString(e), grid_blocks);
}
```

```cpp
#include <hip/hip_runtime.h>
#include <hip/hip_cooperative_groups.h>
#include <cstdio>
namespace cg = cooperative_groups;

#define LAS __attribute__((address_space(3)))
typedef unsigned short bf16_t;
typedef short bf16x8 __attribute__((ext_vector_type(8)));
typedef short s16x4 __attribute__((ext_vector_type(4)));
typedef float f32x4 __attribute__((ext_vector_type(4)));
typedef float f32x2 __attribute__((ext_vector_type(2)));
typedef unsigned u32x4 __attribute__((ext_vector_type(4)));
typedef unsigned u32x2 __attribute__((ext_vector_type(2)));

constexpr int T = 16384, DM = 2048, SEQ = 8192;
constexpr int RIN = 12288;
constexpr int SIN = 10304, SINP = 10496;
constexpr int DFF = 8192;
constexpr int NTHREADS = 512;
constexpr int LDS_STAGE = 131072;
constexpr int LDS_BYTES = LDS_STAGE + 16;

constexpr size_t OFF_WA = 0;
constexpr size_t OFF_WB = 50331648;
constexpr size_t OFF_ACT = OFF_WB + 33554432;
constexpr size_t ACT_BYTES = 402653184;
constexpr size_t HID_BYTES = 268435456;
constexpr size_t OFF_R2 = OFF_ACT + ACT_BYTES;
constexpr size_t R2_BYTES = 134217728;
constexpr size_t OFF_ROT = OFF_R2 + 67108864;
constexpr size_t OFF_HALO = OFF_R2 + 67108864;
constexpr size_t OFF_DTV = OFF_R2 + 67108864 + 16777216;
constexpr size_t OFF_BAR = OFF_R2 + 100663296;
constexpr size_t WS_END = OFF_R2 + R2_BYTES;

__device__ __forceinline__ unsigned f2bf(float f) { unsigned u = __float_as_uint(f); return (u + 0x7fffu + ((u >> 16) & 1u)) >> 16; }
__device__ __forceinline__ unsigned pk2(float lo, float hi) { return f2bf(lo) | (f2bf(hi) << 16); }
__device__ __forceinline__ float bflo(unsigned w) { return __uint_as_float(w << 16); }
__device__ __forceinline__ float bfhi(unsigned w) { return __uint_as_float(w & 0xffff0000u); }
__device__ __forceinline__ float bf2f(bf16_t b) { return __uint_as_float(((unsigned)b) << 16); }
__device__ __forceinline__ unsigned cvt_pk_bf16(float lo, float hi) { unsigned r; asm volatile("v_cvt_pk_bf16_f32 %0, %1, %2" : "=v"(r) : "v"(lo), "v"(hi)); return r; }
__device__ __forceinline__ float wave_sum(float v) {
#pragma unroll
    for (int o = 32; o >= 1; o >>= 1) v += __shfl_xor(v, o);
    return v;
}
__device__ __forceinline__ int otid() { int t = threadIdx.x; asm volatile("" : "+v"(t)); return t; }
__device__ __forceinline__ float silu(float x) { return x / (1.0f + __expf(-x)); }

__device__ __forceinline__ bf16x8 tr_frag(LAS unsigned char* img, int rs, int kbase, int n0, int lane) {
    const int g = lane >> 4, q = (lane & 15) >> 2, p = lane & 3;
    LAS unsigned char* a0 = img + (kbase + 8 * g + q) * rs + (n0 + 4 * p) * 2;
    s16x4 a = __builtin_amdgcn_ds_read_tr16_b64_v4i16((LAS s16x4*)a0);
    s16x4 b = __builtin_amdgcn_ds_read_tr16_b64_v4i16((LAS s16x4*)(a0 + 4 * rs));
    bf16x8 r = {a[0], a[1], a[2], a[3], b[0], b[1], b[2], b[3]};
    return r;
}

namespace pg8 {
constexpr int BM = 256, BK = 64, HALF = 128, HTB = HALF * BK * 2, STAGE_BYTES = 8 * HTB, NXCD = 8, WGM = 8;
__device__ __forceinline__ int lds_byte(int r, int c) { const int st = (r >> 4) * 2 + (c >> 5), rr = r & 15, cc = c & 31, ob = rr * 64 + cc * 2; return st * 1024 + (ob ^ (((ob >> 9) & 1) << 5)); }
__device__ __forceinline__ void stage_rc(int b, int& R, int& C) { const int st = b / 1024, sb = b % 1024, swz = sb ^ (((sb >> 9) & 1) << 5); R = (st >> 1) * 16 + swz / 64; C = (st & 1) * 32 + (swz % 64) / 2; }
__device__ __forceinline__ int perm32(int rho) { const int n = rho >> 4, i = rho & 15; return 8 * (i >> 2) + 4 * n + (i & 3); }
struct Unit { int pm, pn; };
struct Gemm { const bf16_t* A; const bf16_t* Bt; int M, N, K, lda; int kind; void* out; int ldc; const float* rot; };
struct StaticOrder {
    int nM, nN, nwg, G, c;
    __device__ void init(int M, int N, int G_, int c_) { nM = M / BM; nN = N / BM; nwg = nM * nN; G = G_; c = c_; }
    __device__ bool next(int i, Unit& u) const {
        const long L = (long)i * G + c; if (L >= nwg) return false;
        int wgid = (int)L; { const int q = nwg / NXCD, r = nwg % NXCD, xcd = wgid % NXCD, off = wgid / NXCD; wgid = (xcd < r ? xcd * (q + 1) : r * (q + 1) + (xcd - r) * q) + off; }
        const int nig = WGM * nN, gid = wgid / nig, fm = gid * WGM, gsz = (nM - fm) < WGM ? (nM - fm) : WGM;
        u.pm = fm + ((wgid % nig) % gsz); u.pn = (wgid % nig) / gsz; return true;
    }
};

template <int KIND> __device__ __forceinline__ void epilogue(const Gemm& g, const f32x4 (&acc)[2][2][4][2], const Unit& u, int wr, int wc, int fr, int fq) {
    if constexpr (KIND == 0) {
        float* C = (float*)g.out; const int ldc = g.ldc;
        const int row0 = u.pm * BM + wr * 64 + fr, col0 = u.pn * BM + wc * 32 + 4 * fq;
#pragma unroll
        for (int ai = 0; ai < 2; ++ai)
#pragma unroll
            for (int m = 0; m < 4; ++m) { float* rowp = C + (size_t)(row0 + ai * HALF + m * 16) * ldc + col0;
#pragma unroll
                for (int bj = 0; bj < 2; ++bj)
#pragma unroll
                    for (int n = 0; n < 2; ++n) *(f32x4*)(rowp + bj * HALF + n * 16) = acc[ai][bj][m][n]; }
    } else {
        bf16_t* O = (bf16_t*)g.out; const int ldc = g.ldc;
        const int row0 = u.pm * BM + wr * 64 + fr, col0 = u.pn * BM + wc * 32 + 8 * fq;
        const bool isrot = (KIND == 3) && (u.pn < 16);
        const float sc = (u.pn >= 8) ? 0.0625f : 1.0f;
        constexpr bool relu2 = (KIND == 2);
#pragma unroll
        for (int ai = 0; ai < 2; ++ai)
#pragma unroll
            for (int m = 0; m < 4; ++m) {
                const int row = row0 + ai * HALF + m * 16;
                bf16_t* rowp = O + (size_t)row * ldc + col0;
                const int pos = row & (SEQ - 1);
#pragma unroll
                for (int bj = 0; bj < 2; ++bj) {
                    f32x4 v0 = acc[ai][bj][m][0], v1 = acc[ai][bj][m][1];
                    if (relu2) {
#pragma unroll
                        for (int j = 0; j < 4; ++j) { const float a = fmaxf(v0[j], 0.f), b = fmaxf(v1[j], 0.f); v0[j] = a * a; v1[j] = b * b; }
                    }
                    if (isrot) {
                        const float* rp = g.rot + ((size_t)pos * 128 + 64 * bj + 16 * wc + 4 * fq) * 2;
                        const f32x4 c0 = *(const f32x4*)rp, c1 = *(const f32x4*)(rp + 4);
                        f32x4 r0, r1;
                        r0[0] = v0[0] * c0[0] - v0[1] * c0[1]; r0[1] = v0[0] * c0[1] + v0[1] * c0[0];
                        r0[2] = v0[2] * c0[2] - v0[3] * c0[3]; r0[3] = v0[2] * c0[3] + v0[3] * c0[2];
                        r1[0] = v1[0] * c1[0] - v1[1] * c1[1]; r1[1] = v1[0] * c1[1] + v1[1] * c1[0];
                        r1[2] = v1[2] * c1[2] - v1[3] * c1[3]; r1[3] = v1[2] * c1[3] + v1[3] * c1[2];
                        v0 = r0 * sc; v1 = r1 * sc;
                    }
                    u32x4 w; w.x = cvt_pk_bf16(v0[0], v0[1]); w.y = cvt_pk_bf16(v0[2], v0[3]); w.z = cvt_pk_bf16(v1[0], v1[1]); w.w = cvt_pk_bf16(v1[2], v1[3]);
                    *(u32x4*)(rowp + bj * HALF) = w;
                }
            }
    }
}

template <int KIND> __device__ __forceinline__ void gemm_phase(LAS unsigned char* lds, const Gemm g, const StaticOrder& S) {
    const int tid = otid(), wid = __builtin_amdgcn_readfirstlane(tid >> 6), lane = tid & 63, wr = wid >> 2, wc = wid & 3, fr = lane & 15, fq = lane >> 4;
    const int K = g.K, nt = K / BK, lda = g.lda;
    constexpr bool perm = KIND != 0;
    unsigned voffA[2], voffB[2];
#pragma unroll
    for (int i = 0; i < 2; ++i) { int R, C; stage_rc(tid * 16 + i * 8192, R, C); const int Rb = perm ? ((R & ~31) + perm32(R & 31)) : R;
        voffA[i] = (unsigned)(R * lda + C) * 2u; voffB[i] = (unsigned)(Rb * K + C) * 2u; }
    const size_t kstep = (size_t)(BK * 2);
    const size_t hstepA = (size_t)HALF * lda * 2, hstepB = (size_t)HALF * K * 2;
    const size_t tstepA = 2 * hstepA, tstepB = 2 * hstepB;
    const unsigned ldsw = (unsigned)wid * 1024u;
    const int aoff = lds_byte(wr * 64 + fr, fq * 8), boff = lds_byte(wc * 32 + fr, fq * 8);
#define PG8_SA(b, h) (((b) * 2 + (h)) * HTB)
#define PG8_SB(b, h) ((4 + (b) * 2 + (h)) * HTB)
#define PG8_STAGE(bufoff, gbase, voff) do { _Pragma("unroll") for (int _i = 0; _i < 2; ++_i) \
        __builtin_amdgcn_global_load_lds((const unsigned*)((const char*)(gbase) + (voff)[_i]), (LAS unsigned*)(lds + (bufoff) + ldsw + _i * 8192), 16, 0, 0); } while (0)
#define PG8_LDA(dst, b, h) do { _Pragma("unroll") for (int m = 0; m < 4; ++m) _Pragma("unroll") for (int k = 0; k < 2; ++k) dst[m][k] = *(const LAS bf16x8*)(lds + PG8_SA(b, h) + aoff + m * 2048 + k * 1024); } while (0)
#define PG8_LDB(dst, b, h) do { _Pragma("unroll") for (int n = 0; n < 2; ++n) _Pragma("unroll") for (int k = 0; k < 2; ++k) dst[n][k] = *(const LAS bf16x8*)(lds + PG8_SB(b, h) + boff + n * 2048 + k * 1024); } while (0)
#define PG8_MMA(ai, bj, At, Bt) do { __builtin_amdgcn_s_setprio(1); _Pragma("unroll") for (int m = 0; m < 4; ++m) _Pragma("unroll") for (int n = 0; n < 2; ++n) _Pragma("unroll") for (int k = 0; k < 2; ++k) \
        acc[ai][bj][m][n] = __builtin_amdgcn_mfma_f32_16x16x32_bf16(Bt[n][k], At[m][k], acc[ai][bj][m][n], 0, 0, 0); __builtin_amdgcn_s_setprio(0); } while (0)
#define PG8_WAIT_V(n) asm volatile("s_waitcnt vmcnt(" #n ")" ::: "memory")
#define PG8_WAIT_L(n) asm volatile("s_waitcnt lgkmcnt(" #n ")" ::: "memory")
#define PG8_BAR __builtin_amdgcn_s_barrier()
#define PG8_SCHED __builtin_amdgcn_sched_barrier(0)
    Unit cur, nxt; int ui = 0;
    if (!S.next(0, cur)) return;
    f32x4 acc[2][2][4][2];
#pragma unroll
    for (int a = 0; a < 2; ++a)
#pragma unroll
        for (int b = 0; b < 2; ++b)
#pragma unroll
            for (int m = 0; m < 4; ++m)
#pragma unroll
                for (int n = 0; n < 2; ++n) acc[a][b][m][n] = (f32x4){0.f, 0.f, 0.f, 0.f};
    bf16x8 At[4][2], B0[2][2], B1[2][2];
    const char* cA = (const char*)g.A + (size_t)cur.pm * tstepA; const char* cB = (const char*)g.Bt + (size_t)cur.pn * tstepB;
    PG8_STAGE(PG8_SB(0, 0), cB, voffB); PG8_STAGE(PG8_SA(0, 0), cA, voffA); PG8_STAGE(PG8_SB(0, 1), cB + hstepB, voffB); PG8_STAGE(PG8_SA(0, 1), cA + hstepA, voffA);
    if (wr == 1) PG8_BAR;
    PG8_WAIT_V(4); PG8_BAR;
    PG8_STAGE(PG8_SB(1, 0), cB + kstep, voffB); PG8_STAGE(PG8_SA(1, 0), cA + kstep, voffA); PG8_STAGE(PG8_SB(1, 1), cB + hstepB + kstep, voffB);
    PG8_WAIT_V(6); PG8_BAR;
    for (;;) {
        const bool has_next = S.next(ui + 1, nxt);
        const char* nA = has_next ? (const char*)g.A + (size_t)nxt.pm * tstepA : cA; const char* nB = has_next ? (const char*)g.Bt + (size_t)nxt.pn * tstepB : cB;
        for (int t = 0; t < nt; t += 2) {
            const bool last = (t == nt - 2);
            const char* a1 = cA + (size_t)(t + 1) * kstep;
            const char* a2 = last ? nA : cA + (size_t)(t + 2) * kstep; const char* b2 = last ? nB : cB + (size_t)(t + 2) * kstep;
            const char* a3 = a2 + kstep; const char* b3 = b2 + kstep;
            PG8_LDB(B0, 0, 0); PG8_SCHED; PG8_LDA(At, 0, 0); PG8_STAGE(PG8_SA(1, 1), a1 + hstepA, voffA);
            PG8_WAIT_L(8); PG8_BAR; PG8_WAIT_L(0); PG8_MMA(0, 0, At, B0); PG8_BAR; PG8_SCHED;
            PG8_LDB(B1, 0, 1); PG8_STAGE(PG8_SB(0, 0), b2, voffB);
            PG8_BAR; PG8_WAIT_L(0); PG8_MMA(0, 1, At, B1); PG8_BAR;
            PG8_LDA(At, 0, 1); PG8_STAGE(PG8_SA(0, 0), a2, voffA);
            PG8_BAR; PG8_WAIT_L(0); PG8_MMA(1, 0, At, B0); PG8_BAR; PG8_SCHED;
            PG8_STAGE(PG8_SB(0, 1), b2 + hstepB, voffB);
            PG8_WAIT_V(6); PG8_BAR; PG8_MMA(1, 1, At, B1); PG8_BAR;
            PG8_LDB(B0, 1, 0); PG8_SCHED; PG8_LDA(At, 1, 0); PG8_STAGE(PG8_SA(0, 1), a2 + hstepA, voffA);
            PG8_WAIT_L(8); PG8_BAR; PG8_WAIT_L(0); PG8_MMA(0, 0, At, B0); PG8_BAR; PG8_SCHED;
            PG8_LDB(B1, 1, 1); PG8_STAGE(PG8_SB(1, 0), b3, voffB);
            PG8_BAR; PG8_WAIT_L(0); PG8_MMA(0, 1, At, B1); PG8_BAR;
            PG8_LDA(At, 1, 1); PG8_STAGE(PG8_SA(1, 0), a3, voffA);
            PG8_BAR; PG8_WAIT_L(0); PG8_MMA(1, 0, At, B0); PG8_BAR; PG8_SCHED;
            PG8_STAGE(PG8_SB(1, 1), b3 + hstepB, voffB);
            PG8_WAIT_V(6); PG8_BAR; PG8_MMA(1, 1, At, B1); PG8_BAR;
        }
        epilogue<KIND>(g, acc, cur, wr, wc, fr, fq);
        if (!has_next) break;
#pragma unroll
        for (int a = 0; a < 2; ++a)
#pragma unroll
            for (int b = 0; b < 2; ++b)
#pragma unroll
                for (int m = 0; m < 4; ++m)
#pragma unroll
                    for (int n = 0; n < 2; ++n) acc[a][b][m][n] = (f32x4){0.f, 0.f, 0.f, 0.f};
        cur = nxt; cA = nA; cB = nB; ++ui;
    }
    PG8_WAIT_V(0);
    if (wr == 0) PG8_BAR;
    PG8_BAR;
#undef PG8_SA
#undef PG8_SB
#undef PG8_STAGE
#undef PG8_LDA
#undef PG8_LDB
#undef PG8_MMA
#undef PG8_WAIT_V
#undef PG8_WAIT_L
#undef PG8_BAR
#undef PG8_SCHED
}
}

struct ConvDesc { const float* src; bf16_t* dst; int K, Nsrc, Ndst, permq; };
__device__ __forceinline__ void convert_w(const ConvDesc& c, LAS unsigned char* lds, int wg, int G) {
    const int tid = otid();
    constexpr int RS = 144;
    const int nnt = c.Ndst / 128, ntile = (c.K / 64) * nnt;
    const int c4 = tid & 31, kq = tid >> 5;
    f32x4 r[4];
#define CW_LOAD(u_) do { const int nt_ = (u_) % nnt, kt_ = (u_) / nnt; const int col_ = nt_ * 128 + c4 * 4; \
        const float* sp_ = c.src + (size_t)(kt_ * 64 + kq * 4) * c.Nsrc + col_; const bool ok_ = col_ < c.Nsrc; \
        _Pragma("unroll") for (int i_ = 0; i_ < 4; ++i_) r[i_] = ok_ ? *(const f32x4*)(sp_ + (size_t)i_ * c.Nsrc) : (f32x4){0.f, 0.f, 0.f, 0.f}; } while (0)
    int u = wg;
    if (u < ntile) CW_LOAD(u);
    while (u < ntile) {
#pragma unroll
        for (int e = 0; e < 4; ++e) { u32x2 w; w.x = pk2(r[0][e], r[1][e]); w.y = pk2(r[2][e], r[3][e]); *(LAS u32x2*)(lds + (c4 * 4 + e) * RS + kq * 8) = w; }
        const int un = u + G;
        if (un < ntile) CW_LOAD(un);
        __syncthreads();
        {
            const int nt = u % nnt, kt = u / nnt, n0 = nt * 128;
            const bool pm = c.permq && n0 < 4096;
#pragma unroll
            for (int i = 0; i < 2; ++i) { const int idx = i * 512 + tid, row = idx >> 3, kb = idx & 7;
                const u32x4 v = *(const LAS u32x4*)(lds + row * RS + kb * 16);
                const int drow = pm ? ((n0 & ~255) + 2 * row + ((n0 >> 7) & 1)) : (n0 + row);
                *(u32x4*)(c.dst + (size_t)drow * c.K + kt * 64 + kb * 8) = v; }
        }
        __syncthreads();
        u = un;
    }
#undef CW_LOAD
}

struct NormDesc { int mode; const void* m; const float* hres; float* hout; const float* wpost; const float* wpre; bf16_t* ub; };
__device__ __forceinline__ void norm_pass(const NormDesc& d, int wg, int G) {
    const int tid_ = otid(); const int wave = tid_ >> 6, lane = tid_ & 63;
    for (int row = wg * 8 + wave; row < T; row += G * 8) {
        const size_t ro = (size_t)row * DM;
        float v[4][8]; float ss = 0.f;
        if (d.mode == 0) {
#pragma unroll
            for (int i = 0; i < 4; ++i) { const int c = (i * 64 + lane) * 8; const f32x4 a = *(const f32x4*)((const float*)d.m + ro + c), b = *(const f32x4*)((const float*)d.m + ro + c + 4);
#pragma unroll
                for (int e = 0; e < 4; ++e) { v[i][e] = a[e]; v[i][4 + e] = b[e]; } }
        } else {
#pragma unroll
            for (int i = 0; i < 4; ++i) { const int c = (i * 64 + lane) * 8; const u32x4 a = *(const u32x4*)((const bf16_t*)d.m + ro + c);
                v[i][0] = bflo(a.x); v[i][1] = bfhi(a.x); v[i][2] = bflo(a.y); v[i][3] = bfhi(a.y); v[i][4] = bflo(a.z); v[i][5] = bfhi(a.z); v[i][6] = bflo(a.w); v[i][7] = bfhi(a.w); }
        }
#pragma unroll
        for (int i = 0; i < 4; ++i)
#pragma unroll
            for (int e = 0; e < 8; ++e) ss += v[i][e] * v[i][e];
        ss = wave_sum(ss);
        const float r = rsqrtf(ss * (1.0f / DM) + 1e-6f);
        float r2 = r;
        if (d.mode != 0) {
            float s2 = 0.f;
#pragma unroll
            for (int i = 0; i < 4; ++i) { const int c = (i * 64 + lane) * 8;
                const f32x4 w0 = *(const f32x4*)(d.wpost + c), w1 = *(const f32x4*)(d.wpost + c + 4);
                const f32x4 h0 = *(const f32x4*)(d.hres + ro + c), h1 = *(const f32x4*)(d.hres + ro + c + 4);
                f32x4 o0, o1;
#pragma unroll
                for (int e = 0; e < 4; ++e) { o0[e] = h0[e] + v[i][e] * r * w0[e]; o1[e] = h1[e] + v[i][4 + e] * r * w1[e]; v[i][e] = o0[e]; v[i][4 + e] = o1[e]; s2 += o0[e] * o0[e] + o1[e] * o1[e]; }
                *(f32x4*)(d.hout + ro + c) = o0; *(f32x4*)(d.hout + ro + c + 4) = o1; }
            if (d.mode == 1) { s2 = wave_sum(s2); r2 = rsqrtf(s2 * (1.0f / DM) + 1e-6f); }
        }
        if (d.mode != 2) {
#pragma unroll
            for (int i = 0; i < 4; ++i) { const int c = (i * 64 + lane) * 8;
                const f32x4 w0 = *(const f32x4*)(d.wpre + c), w1 = *(const f32x4*)(d.wpre + c + 4);
                u32x4 o; o.x = pk2(v[i][0] * r2 * w0[0], v[i][1] * r2 * w0[1]); o.y = pk2(v[i][2] * r2 * w0[2], v[i][3] * r2 * w0[3]);
                o.z = pk2(v[i][4] * r2 * w1[0], v[i][5] * r2 * w1[1]); o.w = pk2(v[i][6] * r2 * w1[2], v[i][7] * r2 * w1[3]);
                *(u32x4*)(d.ub + ro + c) = o; }
        }
    }
}

__device__ __forceinline__ void rot_table(float* rot, int wg, int G) {
    for (int e = wg * NTHREADS + otid(); e < SEQ * 128; e += G * NTHREADS) {
        const int pos = e >> 7, jf = e & 127;
        const float inv = exp2f(-(float)jf * (13.287712379549449f / 128.0f));
        const float ang = (float)pos * inv;
        const double a = (double)ang; const double k = rint(a * 0.15915494309189535); const float rf = (float)(a - k * 6.283185307179586);
        f32x2 cs; cs.x = cosf(rf); cs.y = sinf(rf);
        *(f32x2*)(rot + 2 * (size_t)e) = cs;
    }
}

__device__ __forceinline__ void ret_scan(bf16_t* proj, LAS unsigned char* lds, int wg, int G) {
    const int tid = otid(), lane = tid & 63, wid = __builtin_amdgcn_readfirstlane(tid >> 6), fr = lane & 15, fq = lane >> 4;
    constexpr int QS = 528, VS = 80, PS = 144;
    LAS unsigned char* Qs = lds; LAS unsigned char* Ks = lds + 33792; LAS unsigned char* Vs = lds + 67584; LAS unsigned char* Vz = lds + 72704;
    LAS unsigned char* Ps = lds + 77824; LAS unsigned char* St = lds + 87040;
    const int lm = wid >> 1, c2 = wid & 1;
    for (int unit = wg; unit < 256; unit += G) {
        const int xc = unit & 7, ii = unit >> 3, bh = xc * 2 + (ii >> 4), vs = ii & 15, b = bh >> 3, h = bh & 7;
        const float lg = log1pf(-exp2f(-5.0f - (float)h));
        float dm[2][4], xi[4];
#pragma unroll
        for (int j = 0; j < 4; ++j) { const int l = lm * 16 + fq * 4 + j; xi[j] = expf((float)(l + 1) * lg);
#pragma unroll
            for (int t = 0; t < 2; ++t) { const int m = (c2 * 2 + t) * 16 + fr; const int dd = l > m ? l - m : m - l; dm[t][j] = expf((float)dd * lg); } }
        const float cdecay = expf(64.0f * lg);
        const int vrow = (tid & 255) >> 2, vch = tid & 3;
        const float zeta = expf((float)(63 - vrow) * lg);
        f32x4 accS[2][2];
#pragma unroll
        for (int a = 0; a < 2; ++a)
#pragma unroll
            for (int c = 0; c < 2; ++c) accS[a][c] = (f32x4){0.f, 0.f, 0.f, 0.f};
        for (int i = tid; i < 16896 / 4; i += NTHREADS) ((LAS unsigned*)St)[i] = 0u;
        const bf16_t* qb = proj + (size_t)(b * SEQ) * RIN + h * 256;
        const bf16_t* kb = qb + 2048;
        bf16_t* vb = proj + (size_t)(b * SEQ) * RIN + 4096 + h * 512 + vs * 32;
        u32x4 rq[4], rk[4], rv;
#pragma unroll
        for (int i = 0; i < 4; ++i) { const int idx = i * 512 + tid, row = idx >> 5, ch = idx & 31; rq[i] = *(const u32x4*)(qb + (size_t)row * RIN + ch * 8); rk[i] = *(const u32x4*)(kb + (size_t)row * RIN + ch * 8); }
        rv = (u32x4){0u, 0u, 0u, 0u};
        if (tid < 256) rv = *(const u32x4*)(vb + (size_t)vrow * RIN + vch * 8);
        for (int c = 0; c < 128; ++c) {
#pragma unroll
            for (int i = 0; i < 4; ++i) { const int idx = i * 512 + tid, row = idx >> 5, ch = idx & 31; *(LAS u32x4*)(Qs + row * QS + ch * 16) = rq[i]; *(LAS u32x4*)(Ks + row * QS + ch * 16) = rk[i]; }
            if (tid < 256) {
                *(LAS u32x4*)(Vs + vrow * VS + vch * 16) = rv;
                u32x4 z; z.x = pk2(bflo(rv.x) * zeta, bfhi(rv.x) * zeta); z.y = pk2(bflo(rv.y) * zeta, bfhi(rv.y) * zeta);
                z.z = pk2(bflo(rv.z) * zeta, bfhi(rv.z) * zeta); z.w = pk2(bflo(rv.w) * zeta, bfhi(rv.w) * zeta);
                *(LAS u32x4*)(Vz + vrow * VS + vch * 16) = z;
            }
            __syncthreads();
            if (c + 1 < 128) {
                const size_t ro = (size_t)(c + 1) * 64 * RIN;
#pragma unroll
                for (int i = 0; i < 4; ++i) { const int idx = i * 512 + tid, row = idx >> 5, ch = idx & 31; rq[i] = *(const u32x4*)(qb + ro + (size_t)row * RIN + ch * 8); rk[i] = *(const u32x4*)(kb + ro + (size_t)row * RIN + ch * 8); }
                if (tid < 256) rv = *(const u32x4*)(vb + ro + (size_t)vrow * RIN + vch * 8);
            }
            f32x4 aP0 = {0.f, 0.f, 0.f, 0.f}, aP1 = {0.f, 0.f, 0.f, 0.f}, aX = {0.f, 0.f, 0.f, 0.f};
#pragma unroll
            for (int ks = 0; ks < 8; ++ks) {
                const bf16x8 a = *(const LAS bf16x8*)(Qs + (lm * 16 + fr) * QS + ks * 64 + fq * 16);
                const bf16x8 b0 = *(const LAS bf16x8*)(Ks + ((c2 * 2 + 0) * 16 + fr) * QS + ks * 64 + fq * 16);
                const bf16x8 b1 = *(const LAS bf16x8*)(Ks + ((c2 * 2 + 1) * 16 + fr) * QS + ks * 64 + fq * 16);
                const bf16x8 bs = *(const LAS bf16x8*)(St + (c2 * 16 + fr) * QS + ks * 64 + fq * 16);
                aP0 = __builtin_amdgcn_mfma_f32_16x16x32_bf16(a, b0, aP0, 0, 0, 0);
                aP1 = __builtin_amdgcn_mfma_f32_16x16x32_bf16(a, b1, aP1, 0, 0, 0);
                aX = __builtin_amdgcn_mfma_f32_16x16x32_bf16(a, bs, aX, 0, 0, 0);
            }
#pragma unroll
            for (int j = 0; j < 4; ++j) { const int l = lm * 16 + fq * 4 + j;
                *(LAS bf16_t*)(Ps + l * PS + ((c2 * 2 + 0) * 16 + fr) * 2) = (bf16_t)f2bf(aP0[j] * dm[0][j]);
                *(LAS bf16_t*)(Ps + l * PS + ((c2 * 2 + 1) * 16 + fr) * 2) = (bf16_t)f2bf(aP1[j] * dm[1][j]); }
            __syncthreads();
            f32x4 aI = {0.f, 0.f, 0.f, 0.f};
#pragma unroll
            for (int ks = 0; ks < 2; ++ks) {
                const bf16x8 a = *(const LAS bf16x8*)(Ps + (lm * 16 + fr) * PS + ks * 64 + fq * 16);
                const bf16x8 bv = tr_frag(Vs, VS, ks * 32, c2 * 16, lane);
                aI = __builtin_amdgcn_mfma_f32_16x16x32_bf16(a, bv, aI, 0, 0, 0);
            }
            {
                bf16_t* ob = vb + (size_t)(c * 64) * RIN + c2 * 16 + fr;
#pragma unroll
                for (int j = 0; j < 4; ++j) { const int l = lm * 16 + fq * 4 + j; ob[(size_t)l * RIN] = (bf16_t)f2bf(aI[j] + aX[j] * xi[j]); }
            }
#pragma unroll
            for (int a = 0; a < 2; ++a)
#pragma unroll
                for (int cc = 0; cc < 2; ++cc) accS[a][cc] *= cdecay;
#pragma unroll
            for (int ks = 0; ks < 2; ++ks) {
                const bf16x8 ad0 = tr_frag(Ks, QS, ks * 32, (wid * 2 + 0) * 16, lane);
                const bf16x8 ad1 = tr_frag(Ks, QS, ks * 32, (wid * 2 + 1) * 16, lane);
                const bf16x8 bv0 = tr_frag(Vz, VS, ks * 32, 0, lane);
                const bf16x8 bv1 = tr_frag(Vz, VS, ks * 32, 16, lane);
                accS[0][0] = __builtin_amdgcn_mfma_f32_16x16x32_bf16(ad0, bv0, accS[0][0], 0, 0, 0);
                accS[0][1] = __builtin_amdgcn_mfma_f32_16x16x32_bf16(ad0, bv1, accS[0][1], 0, 0, 0);
                accS[1][0] = __builtin_amdgcn_mfma_f32_16x16x32_bf16(ad1, bv0, accS[1][0], 0, 0, 0);
                accS[1][1] = __builtin_amdgcn_mfma_f32_16x16x32_bf16(ad1, bv1, accS[1][1], 0, 0, 0);
            }
#pragma unroll
            for (int a = 0; a < 2; ++a)
#pragma unroll
                for (int cc = 0; cc < 2; ++cc) {
                    u32x2 w; w.x = pk2(accS[a][cc][0], accS[a][cc][1]); w.y = pk2(accS[a][cc][2], accS[a][cc][3]);
                    *(LAS u32x2*)(St + (cc * 16 + fr) * QS + ((wid * 2 + a) * 16 + fq * 4) * 2) = w;
                }
            __syncthreads();
        }
    }
}

__device__ __forceinline__ void ret_gn(bf16_t* proj, const float* gnw, int wg, int G) {
    const int tid_ = otid(); const int wave = tid_ >> 6, lane = tid_ & 63;
    for (int pair = wg * 8 + wave; pair < T * 8; pair += G * 8) {
        const int t = pair >> 3, h = pair & 7;
        bf16_t* op = proj + (size_t)t * RIN + 4096 + h * 512 + lane * 8;
        bf16_t* gp = op + 4096;
        const u32x4 ov = *(const u32x4*)op, gv = *(const u32x4*)gp;
        float o[8] = {bflo(ov.x), bfhi(ov.x), bflo(ov.y), bfhi(ov.y), bflo(ov.z), bfhi(ov.z), bflo(ov.w), bfhi(ov.w)};
        float g[8] = {bflo(gv.x), bfhi(gv.x), bflo(gv.y), bfhi(gv.y), bflo(gv.z), bfhi(gv.z), bflo(gv.w), bfhi(gv.w)};
        float s = 0.f;
#pragma unroll
        for (int e = 0; e < 8; ++e) s += o[e];
        const float mu = wave_sum(s) * (1.0f / 512.0f);
        float q = 0.f;
#pragma unroll
        for (int e = 0; e < 8; ++e) { o[e] -= mu; q += o[e] * o[e]; }
        const float rstd = rsqrtf(wave_sum(q) * (1.0f / 512.0f) + 1e-5f);
        const f32x4 w0 = *(const f32x4*)(gnw + h * 512 + lane * 8), w1 = *(const f32x4*)(gnw + h * 512 + lane * 8 + 4);
        float y[8];
#pragma unroll
        for (int e = 0; e < 8; ++e) y[e] = silu(g[e]) * (o[e] * rstd) * (e < 4 ? w0[e & 3] : w1[e & 3]);
        u32x4 w; w.x = pk2(y[0], y[1]); w.y = pk2(y[2], y[3]); w.z = pk2(y[4], y[5]); w.w = pk2(y[6], y[7]);
        *(u32x4*)gp = w;
    }
}

__device__ __forceinline__ void ssd_pre(const bf16_t* proj, bf16_t* halo, float* dtv, const float* dt_bias, int wg, int G) {
    const int gt = wg * NTHREADS + otid(), gs = G * NTHREADS;
    for (int e = gt; e < 256 * 3 * 768; e += gs) {
        const int oc = e % 768, r = (e / 768) % 3, ck = e / (768 * 3);
        const u32x4 v = *(const u32x4*)(proj + (size_t)(ck * 64 + 61 + r) * SINP + 4096 + oc * 8);
        *(u32x4*)(halo + ((size_t)ck * 3 + r) * 6144 + oc * 8) = v;
    }
    for (int e = gt; e < T * 64; e += gs) {
        const int t = e >> 6, hd = e & 63;
        const float x = bf2f(proj[(size_t)t * SINP + 10240 + hd]) + dt_bias[hd];
        dtv[e] = x > 20.f ? x : log1pf(expf(x));
    }
}
__device__ __forceinline__ void ssd_conv(bf16_t* proj, const bf16_t* halo, const float* cw, const float* cb, int wg, int G) {
    const int gt = wg * NTHREADS + otid(), gs = G * NTHREADS;
    for (int e = gt; e < 256 * 768; e += gs) {
        const int oc = e % 768, ck = e / 768, col = oc * 8;
        float w[4][8], bias[8];
#pragma unroll
        for (int tp = 0; tp < 4; ++tp) { const f32x4 a = *(const f32x4*)(cw + tp * 6144 + col), b = *(const f32x4*)(cw + tp * 6144 + col + 4);
#pragma unroll
            for (int i = 0; i < 4; ++i) { w[tp][i] = a[i]; w[tp][4 + i] = b[i]; } }
        { const f32x4 a = *(const f32x4*)(cb + col), b = *(const f32x4*)(cb + col + 4);
#pragma unroll
            for (int i = 0; i < 4; ++i) { bias[i] = a[i]; bias[4 + i] = b[i]; } }
        float p3[8], p2[8], p1[8];
        if ((ck & 127) == 0) {
#pragma unroll
            for (int i = 0; i < 8; ++i) { p3[i] = 0.f; p2[i] = 0.f; p1[i] = 0.f; }
        } else {
            const bf16_t* hp = halo + ((size_t)(ck - 1) * 3) * 6144 + col;
            const u32x4 a = *(const u32x4*)hp, b = *(const u32x4*)(hp + 6144), c = *(const u32x4*)(hp + 2 * 6144);
            p3[0] = bflo(a.x); p3[1] = bfhi(a.x); p3[2] = bflo(a.y); p3[3] = bfhi(a.y); p3[4] = bflo(a.z); p3[5] = bfhi(a.z); p3[6] = bflo(a.w); p3[7] = bfhi(a.w);
            p2[0] = bflo(b.x); p2[1] = bfhi(b.x); p2[2] = bflo(b.y); p2[3] = bfhi(b.y); p2[4] = bflo(b.z); p2[5] = bfhi(b.z); p2[6] = bflo(b.w); p2[7] = bfhi(b.w);
            p1[0] = bflo(c.x); p1[1] = bfhi(c.x); p1[2] = bflo(c.y); p1[3] = bfhi(c.y); p1[4] = bflo(c.z); p1[5] = bfhi(c.z); p1[6] = bflo(c.w); p1[7] = bfhi(c.w);
        }
        bf16_t* rp = proj + (size_t)(ck * 64) * SINP + 4096 + col;
        for (int r = 0; r < 64; ++r) {
            const u32x4 xv = *(const u32x4*)(rp + (size_t)r * SINP);
            float x[8] = {bflo(xv.x), bfhi(xv.x), bflo(xv.y), bfhi(xv.y), bflo(xv.z), bfhi(xv.z), bflo(xv.w), bfhi(xv.w)};
            float y[8];
#pragma unroll
            for (int i = 0; i < 8; ++i) { const float s = bias[i] + w[0][i] * p3[i] + w[1][i] * p2[i] + w[2][i] * p1[i] + w[3][i] * x[i]; y[i] = silu(s); p3[i] = p2[i]; p2[i] = p1[i]; p1[i] = x[i]; }
            u32x4 o; o.x = pk2(y[0], y[1]); o.y = pk2(y[2], y[3]); o.z = pk2(y[4], y[5]); o.w = pk2(y[6], y[7]);
            *(u32x4*)(rp + (size_t)r * SINP) = o;
        }
    }
}

__device__ __forceinline__ void ssd_scan(bf16_t* proj, const float* dtv, const float* a_log, const float* d_skip, LAS unsigned char* lds, int wg, int G) {
    const int tid = otid(), lane = tid & 63, wid = __builtin_amdgcn_readfirstlane(tid >> 6), fr = lane & 15, fq = lane >> 4;
    constexpr int CS = 272, XS = 80, WS = 144;
    LAS unsigned char* Cs = lds; LAS unsigned char* Bs = lds + 17408; LAS unsigned char* Xs = lds + 34816; LAS unsigned char* Xw = lds + 39936; LAS unsigned char* Zs = lds + 45056;
    LAS unsigned char* Ws = lds + 50176; LAS unsigned char* Sts = lds + 59392; LAS float* acum = (LAS float*)(lds + 68096); LAS float* dts = (LAS float*)(lds + 68352);
    const int lm = wid >> 1, c2 = wid & 1;
    for (int unit = wg; unit < 256; unit += G) {
        const int grp = unit & 7, ii = unit >> 3, b = ii >> 4, hd = grp * 8 + ((ii & 15) >> 1), ph = ii & 1;
        const float an = -expf(a_log[hd]), dsk = d_skip[hd];
        f32x4 accT[2];
        accT[0] = (f32x4){0.f, 0.f, 0.f, 0.f}; accT[1] = (f32x4){0.f, 0.f, 0.f, 0.f};
        for (int i = tid; i < 8704 / 4; i += NTHREADS) ((LAS unsigned*)Sts)[i] = 0u;
        const bf16_t* base = proj + (size_t)(b * SEQ) * SINP;
        const bf16_t* bb = base + 8192 + grp * 128;
        const bf16_t* cbp = base + 9216 + grp * 128;
        bf16_t* xb = (bf16_t*)base + 4096 + hd * 64 + ph * 32;
        const bf16_t* zb = base + hd * 64 + ph * 32;
        const float* dtp = dtv + (size_t)(b * SEQ) * 64 + hd;
        const int xrow = (tid & 255) >> 2, xch = tid & 3;
        u32x4 rc[2], rb[2], rxz; float rdt = 0.f;
#pragma unroll
        for (int i = 0; i < 2; ++i) { const int idx = i * 512 + tid, row = idx >> 4, ch = idx & 15; rc[i] = *(const u32x4*)(cbp + (size_t)row * SINP + ch * 8); rb[i] = *(const u32x4*)(bb + (size_t)row * SINP + ch * 8); }
        rxz = *(const u32x4*)((tid < 256 ? (const bf16_t*)xb : zb) + (size_t)xrow * SINP + xch * 8);
        if (wid == 0) rdt = dtp[(size_t)lane * 64];
        for (int c = 0; c < 128; ++c) {
#pragma unroll
            for (int i = 0; i < 2; ++i) { const int idx = i * 512 + tid, row = idx >> 4, ch = idx & 15; *(LAS u32x4*)(Cs + row * CS + ch * 16) = rc[i]; *(LAS u32x4*)(Bs + row * CS + ch * 16) = rb[i]; }
            *(LAS u32x4*)((tid < 256 ? Xs : Zs) + xrow * XS + xch * 16) = rxz;
            if (wid == 0) {
                float s = rdt * an;
#pragma unroll
                for (int o = 1; o < 64; o <<= 1) { const float tt = __shfl_up(s, o); if (lane >= o) s += tt; }
                acum[lane] = s; dts[lane] = rdt;
            }
            __syncthreads();
            if (c + 1 < 128) {
                const size_t ro = (size_t)(c + 1) * 64 * SINP;
#pragma unroll
                for (int i = 0; i < 2; ++i) { const int idx = i * 512 + tid, row = idx >> 4, ch = idx & 15; rc[i] = *(const u32x4*)(cbp + ro + (size_t)row * SINP + ch * 8); rb[i] = *(const u32x4*)(bb + ro + (size_t)row * SINP + ch * 8); }
                rxz = *(const u32x4*)((tid < 256 ? (const bf16_t*)xb : zb) + ro + (size_t)xrow * SINP + xch * 8);
                if (wid == 0) rdt = dtp[((size_t)(c + 1) * 64 + lane) * 64];
            }
            const float atot = acum[63];
            float al[4], as_[2], ds_[2];
#pragma unroll
            for (int j = 0; j < 4; ++j) al[j] = acum[lm * 16 + fq * 4 + j];
#pragma unroll
            for (int t = 0; t < 2; ++t) { as_[t] = acum[(c2 * 2 + t) * 16 + fr]; ds_[t] = dts[(c2 * 2 + t) * 16 + fr]; }
            if (tid < 256) {
                const float f = dts[xrow] * expf(atot - acum[xrow]);
                const u32x4 xv = *(const LAS u32x4*)(Xs + xrow * XS + xch * 16);
                u32x4 z; z.x = pk2(bflo(xv.x) * f, bfhi(xv.x) * f); z.y = pk2(bflo(xv.y) * f, bfhi(xv.y) * f); z.z = pk2(bflo(xv.z) * f, bfhi(xv.z) * f); z.w = pk2(bflo(xv.w) * f, bfhi(xv.w) * f);
                *(LAS u32x4*)(Xw + xrow * XS + xch * 16) = z;
            }
            f32x4 aW0 = {0.f, 0.f, 0.f, 0.f}, aW1 = {0.f, 0.f, 0.f, 0.f}, aY = {0.f, 0.f, 0.f, 0.f};
#pragma unroll
            for (int ks = 0; ks < 4; ++ks) {
                const bf16x8 a = *(const LAS bf16x8*)(Cs + (lm * 16 + fr) * CS + ks * 64 + fq * 16);
                const bf16x8 b0 = *(const LAS bf16x8*)(Bs + ((c2 * 2 + 0) * 16 + fr) * CS + ks * 64 + fq * 16);
                const bf16x8 b1 = *(const LAS bf16x8*)(Bs + ((c2 * 2 + 1) * 16 + fr) * CS + ks * 64 + fq * 16);
                const bf16x8 bs = *(const LAS bf16x8*)(Sts + (c2 * 16 + fr) * CS + ks * 64 + fq * 16);
                aW0 = __builtin_amdgcn_mfma_f32_16x16x32_bf16(a, b0, aW0, 0, 0, 0);
                aW1 = __builtin_amdgcn_mfma_f32_16x16x32_bf16(a, b1, aW1, 0, 0, 0);
                aY = __builtin_amdgcn_mfma_f32_16x16x32_bf16(a, bs, aY, 0, 0, 0);
            }
#pragma unroll
            for (int j = 0; j < 4; ++j) { const int l = lm * 16 + fq * 4 + j;
                const int s0 = (c2 * 2 + 0) * 16 + fr, s1 = (c2 * 2 + 1) * 16 + fr;
                const float w0 = (l >= s0) ? aW0[j] * expf(al[j] - as_[0]) * ds_[0] : 0.f;
                const float w1 = (l >= s1) ? aW1[j] * expf(al[j] - as_[1]) * ds_[1] : 0.f;
                *(LAS bf16_t*)(Ws + l * WS + s0 * 2) = (bf16_t)f2bf(w0);
                *(LAS bf16_t*)(Ws + l * WS + s1 * 2) = (bf16_t)f2bf(w1); }
            __syncthreads();
            f32x4 aD = {0.f, 0.f, 0.f, 0.f};
#pragma unroll
            for (int ks = 0; ks < 2; ++ks) {
                const bf16x8 a = *(const LAS bf16x8*)(Ws + (lm * 16 + fr) * WS + ks * 64 + fq * 16);
                const bf16x8 bx = tr_frag(Xs, XS, ks * 32, c2 * 16, lane);
                aD = __builtin_amdgcn_mfma_f32_16x16x32_bf16(a, bx, aD, 0, 0, 0);
            }
            {
                const int pc = c2 * 16 + fr;
                bf16_t* ob = xb + (size_t)(c * 64) * SINP + pc;
#pragma unroll
                for (int j = 0; j < 4; ++j) { const int l = lm * 16 + fq * 4 + j;
                    const float xv = bf2f(*(const LAS bf16_t*)(Xs + l * XS + pc * 2)), zv = bf2f(*(const LAS bf16_t*)(Zs + l * XS + pc * 2));
                    const float y = aD[j] + aY[j] * expf(al[j]) + dsk * xv;
                    ob[(size_t)l * SINP] = (bf16_t)f2bf(y * silu(zv)); }
            }
            const float sdec = expf(atot);
            accT[0] *= sdec; accT[1] *= sdec;
#pragma unroll
            for (int ks = 0; ks < 2; ++ks) {
                const bf16x8 an_ = tr_frag(Bs, CS, ks * 32, wid * 16, lane);
                const bf16x8 bp0 = tr_frag(Xw, XS, ks * 32, 0, lane);
                const bf16x8 bp1 = tr_frag(Xw, XS, ks * 32, 16, lane);
                accT[0] = __builtin_amdgcn_mfma_f32_16x16x32_bf16(an_, bp0, accT[0], 0, 0, 0);
                accT[1] = __builtin_amdgcn_mfma_f32_16x16x32_bf16(an_, bp1, accT[1], 0, 0, 0);
            }
#pragma unroll
            for (int pi = 0; pi < 2; ++pi) {
                u32x2 w; w.x = pk2(accT[pi][0], accT[pi][1]); w.y = pk2(accT[pi][2], accT[pi][3]);
                *(LAS u32x2*)(Sts + (pi * 16 + fr) * CS + (wid * 16 + fq * 4) * 2) = w;
            }
            __syncthreads();
        }
    }
}

__device__ __forceinline__ void ssd_norm(bf16_t* proj, const float* nw, int wg, int G) {
    const int tid_ = otid(); const int wave = tid_ >> 6, lane = tid_ & 63;
    for (int pair = wg * 8 + wave; pair < T * 8; pair += G * 8) {
        const int t = pair >> 3, gr = pair & 7;
        bf16_t* yp = proj + (size_t)t * SINP + 4096 + gr * 512 + lane * 8;
        const u32x4 yv = *(const u32x4*)yp;
        float y[8] = {bflo(yv.x), bfhi(yv.x), bflo(yv.y), bfhi(yv.y), bflo(yv.z), bfhi(yv.z), bflo(yv.w), bfhi(yv.w)};
        float q = 0.f;
#pragma unroll
        for (int e = 0; e < 8; ++e) q += y[e] * y[e];
        const float r = rsqrtf(wave_sum(q) * (1.0f / 512.0f) + 1e-6f);
        const f32x4 w0 = *(const f32x4*)(nw + gr * 512 + lane * 8), w1 = *(const f32x4*)(nw + gr * 512 + lane * 8 + 4);
        u32x4 w; w.x = pk2(y[0] * r * w0[0], y[1] * r * w0[1]); w.y = pk2(y[2] * r * w0[2], y[3] * r * w0[3]);
        w.z = pk2(y[4] * r * w1[0], y[5] * r * w1[1]); w.w = pk2(y[6] * r * w1[2], y[7] * r * w1[3]);
        *(u32x4*)yp = w;
    }
}


#define XB_TMO      128
#define XB_XCNT(j)  (256  + 64 * (j))
#define XB_XSUB(j)  (1280 + 64 * (j))
#define XB_XGEN(j)  (2304 + 64 * (j))
#define XB_TOP      3328
#define XB_TOPGEN   3392
#define XCD_BAR_WORDS 3456
#define XB_SPIN_CAP (1u << 18)
__device__ __forceinline__ unsigned xb_ld(unsigned* p)              { return __hip_atomic_load(p, __ATOMIC_RELAXED, __HIP_MEMORY_SCOPE_AGENT); }
__device__ __forceinline__ unsigned xb_add(unsigned* p, unsigned v) { return __hip_atomic_fetch_add(p, v, __ATOMIC_RELAXED, __HIP_MEMORY_SCOPE_AGENT); }
__device__ __forceinline__ unsigned xb_xcc_id() { return (unsigned)__builtin_amdgcn_s_getreg((3 << 11) | 20) & 0xFu; }
#define XB_SPIN(cond, bar) do { unsigned _sp = 0; while (cond) { __builtin_amdgcn_s_sleep(1); \
    if ((++_sp & 255u) == 0u) { if (xb_ld(&(bar)[XB_TMO])) break; if (_sp > XB_SPIN_CAP) { atomicAdd(&(bar)[XB_TMO], 1u); break; } } } } while (0)
struct XcdBarrier { unsigned* bar; unsigned x; volatile LAS unsigned* st; };
__device__ __forceinline__ XcdBarrier xcd_barrier_post(unsigned* bar, volatile LAS unsigned* st) {
    XcdBarrier b; b.bar = bar; b.x = xb_xcc_id(); b.st = st;
    if (threadIdx.x == 0) (void)xb_add(&bar[XB_XCNT(b.x)], 1u);
    return b;
}
__device__ __forceinline__ void xcd_barrier_complete(unsigned* bar, unsigned x, unsigned& nloc, unsigned& nx) {
    const unsigned G = gridDim.x * gridDim.y * gridDim.z;
    unsigned sum, cnt, mine, sp = 0u;
    for (;;) {
        sum = 0u; cnt = 0u; mine = 0u;
#pragma unroll
        for (unsigned j = 0; j < 16; ++j) { const unsigned c = xb_ld(&bar[XB_XCNT(j)]); sum += c; cnt += (c > 0u) ? 1u : 0u; mine = (j == x) ? c : mine; }
        if (sum == G) break;
        __builtin_amdgcn_s_sleep(1);
        if ((++sp & 255u) == 0u) { if (xb_ld(&bar[XB_TMO])) break; if (sp > XB_SPIN_CAP) { atomicAdd(&bar[XB_TMO], 1u); break; } }
    }
    nloc = mine > 0u ? mine : 1u; nx = cnt > 0u ? cnt : 1u;
}
__device__ __forceinline__ void xcd_barrier(const XcdBarrier& b) {
    asm volatile("s_waitcnt vmcnt(0)" ::: "memory");
    __syncthreads();
    if (threadIdx.x == 0) {
        unsigned* bar = b.bar;
        __builtin_amdgcn_s_waitcnt(0);
        unsigned nloc = b.st[0], nx = b.st[1];
        if (nloc == 0u) { xcd_barrier_complete(bar, b.x, nloc, nx); b.st[0] = nloc; b.st[1] = nx; }
        const unsigned old = xb_add(&bar[XB_XSUB(b.x)], 1u);
        const unsigned gen = old / nloc;
        if (old + 1u == (gen + 1u) * nloc) {
            __builtin_amdgcn_fence(__ATOMIC_RELEASE, "agent");
            asm volatile("s_waitcnt vmcnt(0)" ::: "memory");
            const unsigned og = xb_add(&bar[XB_TOP], 1u);
            const unsigned tg = og / nx;
            if (og + 1u == (tg + 1u) * nx) xb_add(&bar[XB_TOPGEN], 1u);
            else XB_SPIN(xb_ld(&bar[XB_TOPGEN]) == tg, bar);
            __builtin_amdgcn_fence(__ATOMIC_ACQUIRE, "agent");
            xb_add(&bar[XB_XGEN(b.x)], 1u);
            asm volatile("s_waitcnt vmcnt(0)" ::: "memory");
        } else {
            XB_SPIN(xb_ld(&bar[XB_XGEN(b.x)]) == gen, bar);
            __builtin_amdgcn_fence(__ATOMIC_ACQUIRE, "agent");
            asm volatile("s_waitcnt vmcnt(0)" ::: "memory");
        }
    }
    __syncthreads();
}

struct Params {
    const float* x; const float* nmp; const float* nmq; const float* nfp; const float* nfq;
    const float* ret_w_in; const float* ret_gn_w; const float* ret_w_out;
    const float* ssd_w_in; const float* conv_w; const float* conv_b; const float* dt_bias; const float* a_log; const float* d_skip; const float* ssd_norm_w; const float* ssd_w_out;
    const float* w_up; const float* w_down;
    float* out; unsigned char* ws;
};


__global__ void __launch_bounds__(NTHREADS, 2) mega(Params p) {
    extern __shared__ __attribute__((aligned(16))) unsigned char lds_raw[];
    LAS unsigned char* lds = (LAS unsigned char*)lds_raw;
    cg::grid_group grid = cg::this_grid();
    const int G = gridDim.x, wg = blockIdx.x;
    bf16_t* WA = (bf16_t*)(p.ws + OFF_WA); bf16_t* WB = (bf16_t*)(p.ws + OFF_WB);
    bf16_t* ACT = (bf16_t*)(p.ws + OFF_ACT); bf16_t* U_ACT = (bf16_t*)(p.ws + OFF_ACT + HID_BYTES); bf16_t* F_ACT = (bf16_t*)(p.ws + OFF_ACT + HID_BYTES);
    bf16_t* U_R2 = (bf16_t*)(p.ws + OFF_R2); bf16_t* MF_R2 = (bf16_t*)(p.ws + OFF_R2);
    float* ROT = (float*)(p.ws + OFF_ROT); bf16_t* HALO = (bf16_t*)(p.ws + OFF_HALO); float* DTV = (float*)(p.ws + OFF_DTV);

#define GEMM(KIND, ...) do { const pg8::Gemm gd = pg8::Gemm{__VA_ARGS__}; pg8::StaticOrder S; S.init(gd.M, gd.N, G, wg); pg8::gemm_phase<KIND>(lds, gd, S); GSYNC(); } while (0)
    unsigned* barw = (unsigned*)(p.ws + OFF_BAR);
    volatile LAS unsigned* bst = (volatile LAS unsigned*)(lds + LDS_STAGE);
    if (wg == 0) for (int i = threadIdx.x; i < XCD_BAR_WORDS; i += NTHREADS) barw[i] = 0u;
    if (threadIdx.x < 2) bst[threadIdx.x] = 0u;
    norm_pass(NormDesc{0, p.x, nullptr, nullptr, nullptr, p.nmp, U_R2}, wg, G);
    convert_w(ConvDesc{p.ret_w_in, WA, 2048, RIN, RIN, 1}, lds, wg, G);
    convert_w(ConvDesc{p.ret_w_out, WB, 4096, 2048, 2048, 0}, lds, wg, G);
    rot_table(ROT, wg, G);
    grid.sync();
    const XcdBarrier xb = xcd_barrier_post(barw, bst);
#define GSYNC() xcd_barrier(xb)
    GEMM(3, U_R2, WA, T, RIN, 2048, 2048, 3, ACT, RIN, ROT);
    ret_scan(ACT, lds, wg, G); GSYNC();
    ret_gn(ACT, p.ret_gn_w, wg, G); GSYNC();
    GEMM(1, ACT + 8192, WB, T, 2048, 4096, RIN, 1, MF_R2, 2048, nullptr);
    norm_pass(NormDesc{1, MF_R2, p.x, p.out, p.nmq, p.nfp, U_ACT}, wg, G);
    convert_w(ConvDesc{p.w_up, WA, 2048, DFF, DFF, 0}, lds, wg, G);
    convert_w(ConvDesc{p.w_down, WB, DFF, 2048, 2048, 0}, lds, wg, G);
    GSYNC();
    GEMM(2, U_ACT, WA, T, DFF, 2048, 2048, 2, ACT, DFF, nullptr);
    GEMM(1, ACT, WB, T, 2048, DFF, DFF, 1, F_ACT, 2048, nullptr);
    norm_pass(NormDesc{1, F_ACT, p.out, p.out, p.nfq, p.nmp + DM, U_R2}, wg, G);
    convert_w(ConvDesc{p.ssd_w_in, WA, 2048, SIN, SINP, 0}, lds, wg, G);
    convert_w(ConvDesc{p.ssd_w_out, WB, 4096, 2048, 2048, 0}, lds, wg, G);
    GSYNC();
    GEMM(1, U_R2, WA, T, SINP, 2048, 2048, 1, ACT, SINP, nullptr);
    ssd_pre(ACT, HALO, DTV, p.dt_bias, wg, G); GSYNC();
    ssd_conv(ACT, HALO, p.conv_w, p.conv_b, wg, G); GSYNC();
    ssd_scan(ACT, DTV, p.a_log, p.d_skip, lds, wg, G); GSYNC();
    ssd_norm(ACT, p.ssd_norm_w, wg, G); GSYNC();
    GEMM(1, ACT + 4096, WB, T, 2048, 4096, SINP, 1, MF_R2, 2048, nullptr);
    norm_pass(NormDesc{1, MF_R2, p.out, p.out, p.nmq + DM, p.nfp + DM, U_ACT}, wg, G);
    convert_w(ConvDesc{p.w_up + (size_t)2048 * DFF, WA, 2048, DFF, DFF, 0}, lds, wg, G);
    convert_w(ConvDesc{p.w_down + (size_t)DFF * 2048, WB, DFF, 2048, 2048, 0}, lds, wg, G);
    GSYNC();
    GEMM(2, U_ACT, WA, T, DFF, 2048, 2048, 2, ACT, DFF, nullptr);
    GEMM(1, ACT, WB, T, 2048, DFF, DFF, 1, F_ACT, 2048, nullptr);
    norm_pass(NormDesc{2, F_ACT, p.out, p.out, p.nfq + DM, nullptr, nullptr}, wg, G);
#undef GEMM
#undef GSYNC
}

extern "C" void kernel_launch(void* const* d_in, const int* in_sizes, int n_in, void* d_out, int out_size, void* d_ws, size_t ws_size, hipStream_t stream) {
    static int grid_blocks = 0;
    if (!grid_blocks) {
        int dev = 0, cus = 0, per_cu = 0;
        hipGetDevice(&dev);
        hipDeviceGetAttribute(&cus, hipDeviceAttributeMultiprocessorCount, dev);
        hipFuncSetAttribute((const void*)mega, hipFuncAttributeMaxDynamicSharedMemorySize, LDS_BYTES);
        hipOccupancyMaxActiveBlocksPerMultiprocessor(&per_cu, (const void*)mega, NTHREADS, LDS_BYTES);
        if (per_cu < 1) per_cu = 1;
        grid_blocks = cus * per_cu;
        if (ws_size < WS_END) { fprintf(stderr, "kernel_launch: workspace too small: %zu < %zu\n", ws_size, (size_t)WS_END); grid_blocks = -1; }
    }
    if (grid_blocks < 0) return;
    Params p{};
    p.x = (const float*)d_in[0]; p.nmp = (const float*)d_in[1]; p.nmq = (const float*)d_in[2]; p.nfp = (const float*)d_in[3]; p.nfq = (const float*)d_in[4];
    p.ret_w_in = (const float*)d_in[5]; p.ret_gn_w = (const float*)d_in[6]; p.ret_w_out = (const float*)d_in[7];
    p.ssd_w_in = (const float*)d_in[8]; p.conv_w = (const float*)d_in[9]; p.conv_b = (const float*)d_in[10]; p.dt_bias = (const float*)d_in[11];
    p.a_log = (const float*)d_in[12]; p.d_skip = (const float*)d_in[13]; p.ssd_norm_w = (const float*)d_in[14]; p.ssd_w_out = (const float*)d_in[15];
    p.w_up = (const float*)d_in[16]; p.w_down = (const float*)d_in[17];
    p.out = (float*)d_out; p.ws = (unsigned char*)d_ws;
    void* args[] = {&p};
    hipError_t e = hipLaunchCooperativeKernel((const void*)mega, dim3(grid_blocks), dim3(NTHREADS), args, LDS_BYTES, stream);
    if (e != hipSuccess) fprintf(stderr, "cooperative launch failed: %s (grid %d)\n", hipGetErrorString(e), grid_blocks);
}
```

```cpp
#include <hip/hip_runtime.h>
#include <hip/hip_cooperative_groups.h>
#include <cstdio>
namespace cg = cooperative_groups;

#define LAS __attribute__((address_space(3)))
typedef unsigned short bf16_t;
typedef short bf16x8 __attribute__((ext_vector_type(8)));
typedef short s16x4 __attribute__((ext_vector_type(4)));
typedef float f32x4 __attribute__((ext_vector_type(4)));
typedef float f32x2 __attribute__((ext_vector_type(2)));
typedef unsigned u32x4 __attribute__((ext_vector_type(4)));
typedef unsigned u32x2 __attribute__((ext_vector_type(2)));

constexpr int T = 16384, DM = 2048, SEQ = 8192;
constexpr int RIN = 12288;
constexpr int SIN = 10304, SINP = 10496;
constexpr int DFF = 8192;
constexpr int NTHREADS = 512;
constexpr int LDS_STAGE = 131072;
constexpr int LDS_BYTES = LDS_STAGE + 16;

constexpr size_t OFF_WA = 0;
constexpr size_t OFF_WB = 50331648;
constexpr size_t OFF_ACT = OFF_WB + 33554432;
constexpr size_t ACT_BYTES = 402653184;
constexpr size_t HID_BYTES = 268435456;
constexpr size_t OFF_R2 = OFF_ACT + ACT_BYTES;
constexpr size_t R2_BYTES = 134217728;
constexpr size_t OFF_ROT = OFF_R2 + 67108864;
constexpr size_t OFF_HALO = OFF_R2 + 67108864;
constexpr size_t OFF_DTV = OFF_R2 + 67108864 + 16777216;
constexpr size_t OFF_ACV = OFF_DTV + 4194304;
constexpr size_t OFF_CBG = OFF_R2;
constexpr size_t OFF_BAR = OFF_R2 + 100663296;
constexpr size_t WS_END = OFF_R2 + R2_BYTES;

__device__ __forceinline__ unsigned f2bf(float f) { unsigned u = __float_as_uint(f); return (u + 0x7fffu + ((u >> 16) & 1u)) >> 16; }
__device__ __forceinline__ unsigned pk2(float lo, float hi) { return f2bf(lo) | (f2bf(hi) << 16); }
__device__ __forceinline__ float bflo(unsigned w) { return __uint_as_float(w << 16); }
__device__ __forceinline__ float bfhi(unsigned w) { return __uint_as_float(w & 0xffff0000u); }
__device__ __forceinline__ float bf2f(bf16_t b) { return __uint_as_float(((unsigned)b) << 16); }
__device__ __forceinline__ unsigned cvt_pk_bf16(float lo, float hi) { unsigned r; asm volatile("v_cvt_pk_bf16_f32 %0, %1, %2" : "=v"(r) : "v"(lo), "v"(hi)); return r; }
__device__ __forceinline__ float wave_sum(float v) {
#pragma unroll
    for (int o = 32; o >= 1; o >>= 1) v += __shfl_xor(v, o);
    return v;
}
__device__ __forceinline__ int otid() { int t = threadIdx.x; asm volatile("" : "+v"(t)); return t; }
#define LDS_BARRIER() do { asm volatile("s_waitcnt lgkmcnt(0)" ::: "memory"); __builtin_amdgcn_s_barrier(); asm volatile("" ::: "memory"); } while (0)
__device__ __forceinline__ float silu(float x) { return x / (1.0f + __expf(-x)); }

__device__ __forceinline__ bf16x8 tr_frag(LAS unsigned char* img, int rs, int kbase, int n0, int lane) {
    const int g = lane >> 4, q = (lane & 15) >> 2, p = lane & 3;
    LAS unsigned char* a0 = img + (kbase + 8 * g + q) * rs + (n0 + 4 * p) * 2;
    s16x4 a = __builtin_amdgcn_ds_read_tr16_b64_v4i16((LAS s16x4*)a0);
    s16x4 b = __builtin_amdgcn_ds_read_tr16_b64_v4i16((LAS s16x4*)(a0 + 4 * rs));
    bf16x8 r = {a[0], a[1], a[2], a[3], b[0], b[1], b[2], b[3]};
    return r;
}

namespace pg8 {
constexpr int BM = 256, BK = 64, HALF = 128, HTB = HALF * BK * 2, STAGE_BYTES = 8 * HTB, NXCD = 8, WGM = 8;
__device__ __forceinline__ int lds_byte(int r, int c) { const int st = (r >> 4) * 2 + (c >> 5), rr = r & 15, cc = c & 31, ob = rr * 64 + cc * 2; return st * 1024 + (ob ^ (((ob >> 9) & 1) << 5)); }
__device__ __forceinline__ void stage_rc(int b, int& R, int& C) { const int st = b / 1024, sb = b % 1024, swz = sb ^ (((sb >> 9) & 1) << 5); R = (st >> 1) * 16 + swz / 64; C = (st & 1) * 32 + (swz % 64) / 2; }
__device__ __forceinline__ int perm32(int rho) { const int n = rho >> 4, i = rho & 15; return 8 * (i >> 2) + 4 * n + (i & 3); }
struct Unit { int pm, pn; };
struct Gemm { const bf16_t* A; const bf16_t* Bt; int M, N, K, lda; int kind; void* out; int ldc; const float* rot; };
struct StaticOrder {
    int nM, nN, nwg, G, c;
    __device__ void init(int M, int N, int G_, int c_) { nM = M / BM; nN = N / BM; nwg = nM * nN; G = G_; c = c_; }
    __device__ bool next(int i, Unit& u) const {
        const long L = (long)i * G + c; if (L >= nwg) return false;
        int wgid = (int)L; { const int q = nwg / NXCD, r = nwg % NXCD, xcd = wgid % NXCD, off = wgid / NXCD; wgid = (xcd < r ? xcd * (q + 1) : r * (q + 1) + (xcd - r) * q) + off; }
        const int nig = WGM * nN, gid = wgid / nig, fm = gid * WGM, gsz = (nM - fm) < WGM ? (nM - fm) : WGM;
        u.pm = fm + ((wgid % nig) % gsz); u.pn = (wgid % nig) / gsz; return true;
    }
};

template <int KIND> __device__ __forceinline__ void epilogue(const Gemm& g, const f32x4 (&acc)[2][2][4][2], const Unit& u, int wr, int wc, int fr, int fq) {
    if constexpr (KIND == 0) {
        float* C = (float*)g.out; const int ldc = g.ldc;
        const int row0 = u.pm * BM + wr * 64 + fr, col0 = u.pn * BM + wc * 32 + 4 * fq;
#pragma unroll
        for (int ai = 0; ai < 2; ++ai)
#pragma unroll
            for (int m = 0; m < 4; ++m) { float* rowp = C + (size_t)(row0 + ai * HALF + m * 16) * ldc + col0;
#pragma unroll
                for (int bj = 0; bj < 2; ++bj)
#pragma unroll
                    for (int n = 0; n < 2; ++n) *(f32x4*)(rowp + bj * HALF + n * 16) = acc[ai][bj][m][n]; }
    } else {
        bf16_t* O = (bf16_t*)g.out; const int ldc = g.ldc;
        const int row0 = u.pm * BM + wr * 64 + fr, col0 = u.pn * BM + wc * 32 + 8 * fq;
        const bool isrot = (KIND == 3) && (u.pn < 16);
        const float sc = (u.pn >= 8) ? 0.0625f : 1.0f;
        constexpr bool relu2 = (KIND == 2);
#pragma unroll
        for (int ai = 0; ai < 2; ++ai)
#pragma unroll
            for (int m = 0; m < 4; ++m) {
                const int row = row0 + ai * HALF + m * 16;
                bf16_t* rowp = O + (size_t)row * ldc + col0;
                const int pos = row & (SEQ - 1);
#pragma unroll
                for (int bj = 0; bj < 2; ++bj) {
                    f32x4 v0 = acc[ai][bj][m][0], v1 = acc[ai][bj][m][1];
                    if (relu2) {
#pragma unroll
                        for (int j = 0; j < 4; ++j) { const float a = fmaxf(v0[j], 0.f), b = fmaxf(v1[j], 0.f); v0[j] = a * a; v1[j] = b * b; }
                    }
                    if (isrot) {
                        const float* rp = g.rot + ((size_t)pos * 128 + 64 * bj + 16 * wc + 4 * fq) * 2;
                        const f32x4 c0 = *(const f32x4*)rp, c1 = *(const f32x4*)(rp + 4);
                        f32x4 r0, r1;
                        r0[0] = v0[0] * c0[0] - v0[1] * c0[1]; r0[1] = v0[0] * c0[1] + v0[1] * c0[0];
                        r0[2] = v0[2] * c0[2] - v0[3] * c0[3]; r0[3] = v0[2] * c0[3] + v0[3] * c0[2];
                        r1[0] = v1[0] * c1[0] - v1[1] * c1[1]; r1[1] = v1[0] * c1[1] + v1[1] * c1[0];
                        r1[2] = v1[2] * c1[2] - v1[3] * c1[3]; r1[3] = v1[2] * c1[3] + v1[3] * c1[2];
                        v0 = r0 * sc; v1 = r1 * sc;
                    }
                    u32x4 w; w.x = cvt_pk_bf16(v0[0], v0[1]); w.y = cvt_pk_bf16(v0[2], v0[3]); w.z = cvt_pk_bf16(v1[0], v1[1]); w.w = cvt_pk_bf16(v1[2], v1[3]);
                    *(u32x4*)(rowp + bj * HALF) = w;
                }
            }
    }
}

template <int KIND> __device__ __forceinline__ void gemm_phase(LAS unsigned char* lds, const Gemm g, const StaticOrder& S) {
    const int tid = otid(), wid = __builtin_amdgcn_readfirstlane(tid >> 6), lane = tid & 63, wr = wid >> 2, wc = wid & 3, fr = lane & 15, fq = lane >> 4;
    const int K = g.K, nt = K / BK, lda = g.lda;
    constexpr bool perm = KIND != 0;
    unsigned voffA[2], voffB[2];
#pragma unroll
    for (int i = 0; i < 2; ++i) { int R, C; stage_rc(tid * 16 + i * 8192, R, C); const int Rb = perm ? ((R & ~31) + perm32(R & 31)) : R;
        voffA[i] = (unsigned)(R * lda + C) * 2u; voffB[i] = (unsigned)(Rb * K + C) * 2u; }
    const size_t kstep = (size_t)(BK * 2);
    const size_t hstepA = (size_t)HALF * lda * 2, hstepB = (size_t)HALF * K * 2;
    const size_t tstepA = 2 * hstepA, tstepB = 2 * hstepB;
    const unsigned ldsw = (unsigned)wid * 1024u;
    const int aoff = lds_byte(wr * 64 + fr, fq * 8), boff = lds_byte(wc * 32 + fr, fq * 8);
#define PG8_SA(b, h) (((b) * 2 + (h)) * HTB)
#define PG8_SB(b, h) ((4 + (b) * 2 + (h)) * HTB)
#define PG8_STAGE(bufoff, gbase, voff) do { _Pragma("unroll") for (int _i = 0; _i < 2; ++_i) \
        __builtin_amdgcn_global_load_lds((const unsigned*)((const char*)(gbase) + (voff)[_i]), (LAS unsigned*)(lds + (bufoff) + ldsw + _i * 8192), 16, 0, 0); } while (0)
#define PG8_LDA(dst, b, h) do { _Pragma("unroll") for (int m = 0; m < 4; ++m) _Pragma("unroll") for (int k = 0; k < 2; ++k) dst[m][k] = *(const LAS bf16x8*)(lds + PG8_SA(b, h) + aoff + m * 2048 + k * 1024); } while (0)
#define PG8_LDB(dst, b, h) do { _Pragma("unroll") for (int n = 0; n < 2; ++n) _Pragma("unroll") for (int k = 0; k < 2; ++k) dst[n][k] = *(const LAS bf16x8*)(lds + PG8_SB(b, h) + boff + n * 2048 + k * 1024); } while (0)
#define PG8_MMA(ai, bj, At, Bt) do { __builtin_amdgcn_s_setprio(1); _Pragma("unroll") for (int m = 0; m < 4; ++m) _Pragma("unroll") for (int n = 0; n < 2; ++n) _Pragma("unroll") for (int k = 0; k < 2; ++k) \
        acc[ai][bj][m][n] = __builtin_amdgcn_mfma_f32_16x16x32_bf16(Bt[n][k], At[m][k], acc[ai][bj][m][n], 0, 0, 0); __builtin_amdgcn_s_setprio(0); } while (0)
#define PG8_WAIT_V(n) asm volatile("s_waitcnt vmcnt(" #n ")" ::: "memory")
#define PG8_WAIT_L(n) asm volatile("s_waitcnt lgkmcnt(" #n ")" ::: "memory")
#define PG8_BAR __builtin_amdgcn_s_barrier()
#define PG8_SCHED __builtin_amdgcn_sched_barrier(0)
    Unit cur, nxt; int ui = 0;
    if (!S.next(0, cur)) return;
    f32x4 acc[2][2][4][2];
#pragma unroll
    for (int a = 0; a < 2; ++a)
#pragma unroll
        for (int b = 0; b < 2; ++b)
#pragma unroll
            for (int m = 0; m < 4; ++m)
#pragma unroll
                for (int n = 0; n < 2; ++n) acc[a][b][m][n] = (f32x4){0.f, 0.f, 0.f, 0.f};
    bf16x8 At[4][2], B0[2][2], B1[2][2];
    const char* cA = (const char*)g.A + (size_t)cur.pm * tstepA; const char* cB = (const char*)g.Bt + (size_t)cur.pn * tstepB;
    PG8_STAGE(PG8_SB(0, 0), cB, voffB); PG8_STAGE(PG8_SA(0, 0), cA, voffA); PG8_STAGE(PG8_SB(0, 1), cB + hstepB, voffB); PG8_STAGE(PG8_SA(0, 1), cA + hstepA, voffA);
    if (wr == 1) PG8_BAR;
    PG8_WAIT_V(4); PG8_BAR;
    PG8_STAGE(PG8_SB(1, 0), cB + kstep, voffB); PG8_STAGE(PG8_SA(1, 0), cA + kstep, voffA); PG8_STAGE(PG8_SB(1, 1), cB + hstepB + kstep, voffB);
    PG8_WAIT_V(6); PG8_BAR;
    for (;;) {
        const bool has_next = S.next(ui + 1, nxt);
        const char* nA = has_next ? (const char*)g.A + (size_t)nxt.pm * tstepA : cA; const char* nB = has_next ? (const char*)g.Bt + (size_t)nxt.pn * tstepB : cB;
        for (int t = 0; t < nt; t += 2) {
            const bool last = (t == nt - 2);
            const char* a1 = cA + (size_t)(t + 1) * kstep;
            const char* a2 = last ? nA : cA + (size_t)(t + 2) * kstep; const char* b2 = last ? nB : cB + (size_t)(t + 2) * kstep;
            const char* a3 = a2 + kstep; const char* b3 = b2 + kstep;
            PG8_LDB(B0, 0, 0); PG8_SCHED; PG8_LDA(At, 0, 0); PG8_STAGE(PG8_SA(1, 1), a1 + hstepA, voffA);
            PG8_WAIT_L(8); PG8_BAR; PG8_WAIT_L(0); PG8_MMA(0, 0, At, B0); PG8_BAR; PG8_SCHED;
            PG8_LDB(B1, 0, 1); PG8_STAGE(PG8_SB(0, 0), b2, voffB);
            PG8_BAR; PG8_WAIT_L(0); PG8_MMA(0, 1, At, B1); PG8_BAR;
            PG8_LDA(At, 0, 1); PG8_STAGE(PG8_SA(0, 0), a2, voffA);
            PG8_BAR; PG8_WAIT_L(0); PG8_MMA(1, 0, At, B0); PG8_BAR; PG8_SCHED;
            PG8_STAGE(PG8_SB(0, 1), b2 + hstepB, voffB);
            PG8_WAIT_V(6); PG8_BAR; PG8_MMA(1, 1, At, B1); PG8_BAR;
            PG8_LDB(B0, 1, 0); PG8_SCHED; PG8_LDA(At, 1, 0); PG8_STAGE(PG8_SA(0, 1), a2 + hstepA, voffA);
            PG8_WAIT_L(8); PG8_BAR; PG8_WAIT_L(0); PG8_MMA(0, 0, At, B0); PG8_BAR; PG8_SCHED;
            PG8_LDB(B1, 1, 1); PG8_STAGE(PG8_SB(1, 0), b3, voffB);
            PG8_BAR; PG8_WAIT_L(0); PG8_MMA(0, 1, At, B1); PG8_BAR;
            PG8_LDA(At, 1, 1); PG8_STAGE(PG8_SA(1, 0), a3, voffA);
            PG8_BAR; PG8_WAIT_L(0); PG8_MMA(1, 0, At, B0); PG8_BAR; PG8_SCHED;
            PG8_STAGE(PG8_SB(1, 1), b3 + hstepB, voffB);
            PG8_WAIT_V(6); PG8_BAR; PG8_MMA(1, 1, At, B1); PG8_BAR;
        }
        epilogue<KIND>(g, acc, cur, wr, wc, fr, fq);
        if (!has_next) break;
#pragma unroll
        for (int a = 0; a < 2; ++a)
#pragma unroll
            for (int b = 0; b < 2; ++b)
#pragma unroll
                for (int m = 0; m < 4; ++m)
#pragma unroll
                    for (int n = 0; n < 2; ++n) acc[a][b][m][n] = (f32x4){0.f, 0.f, 0.f, 0.f};
        cur = nxt; cA = nA; cB = nB; ++ui;
    }
    PG8_WAIT_V(0);
    if (wr == 0) PG8_BAR;
    PG8_BAR;
#undef PG8_SA
#undef PG8_SB
#undef PG8_STAGE
#undef PG8_LDA
#undef PG8_LDB
#undef PG8_MMA
#undef PG8_WAIT_V
#undef PG8_WAIT_L
#undef PG8_BAR
#undef PG8_SCHED
}
}

struct ConvDesc { const float* src; bf16_t* dst; int K, Nsrc, Ndst, permq; };
__device__ __forceinline__ void convert_w(const ConvDesc& c, LAS unsigned char* lds, int wg, int G) {
    const int tid = otid();
    constexpr int RS = 144;
    const int nnt = c.Ndst / 128, ntile = (c.K / 64) * nnt;
    const int c4 = tid & 31, kq = tid >> 5;
    f32x4 r[4];
#define CW_LOAD(u_) do { const int nt_ = (u_) % nnt, kt_ = (u_) / nnt; const int col_ = nt_ * 128 + c4 * 4; \
        const float* sp_ = c.src + (size_t)(kt_ * 64 + kq * 4) * c.Nsrc + col_; const bool ok_ = col_ < c.Nsrc; \
        _Pragma("unroll") for (int i_ = 0; i_ < 4; ++i_) r[i_] = ok_ ? *(const f32x4*)(sp_ + (size_t)i_ * c.Nsrc) : (f32x4){0.f, 0.f, 0.f, 0.f}; } while (0)
    int u = wg;
    if (u < ntile) CW_LOAD(u);
    while (u < ntile) {
#pragma unroll
        for (int e = 0; e < 4; ++e) { u32x2 w; w.x = pk2(r[0][e], r[1][e]); w.y = pk2(r[2][e], r[3][e]); *(LAS u32x2*)(lds + (c4 * 4 + e) * RS + kq * 8) = w; }
        const int un = u + G;
        if (un < ntile) CW_LOAD(un);
        LDS_BARRIER();
        {
            const int nt = u % nnt, kt = u / nnt, n0 = nt * 128;
            const bool pm = c.permq && n0 < 4096;
#pragma unroll
            for (int i = 0; i < 2; ++i) { const int idx = i * 512 + tid, row = idx >> 3, kb = idx & 7;
                const u32x4 v = *(const LAS u32x4*)(lds + row * RS + kb * 16);
                const int drow = pm ? ((n0 & ~255) + 2 * row + ((n0 >> 7) & 1)) : (n0 + row);
                *(u32x4*)(c.dst + (size_t)drow * c.K + kt * 64 + kb * 8) = v; }
        }
        LDS_BARRIER();
        u = un;
    }
#undef CW_LOAD
}

struct NormDesc { int mode; const void* m; const void* hres; void* hout; const float* wpost; const float* wpre; bf16_t* ub; int hin_bf16, hout_bf16; };
__device__ __forceinline__ void norm_pass(const NormDesc& d, int wg, int G) {
    const int tid_ = otid(); const int wave = tid_ >> 6, lane = tid_ & 63;
    for (int row = wg * 8 + wave; row < T; row += G * 8) {
        const size_t ro = (size_t)row * DM;
        float v[4][8]; float ss = 0.f;
        if (d.mode == 0) {
#pragma unroll
            for (int i = 0; i < 4; ++i) { const int c = (i * 64 + lane) * 8; const f32x4 a = *(const f32x4*)((const float*)d.m + ro + c), b = *(const f32x4*)((const float*)d.m + ro + c + 4);
#pragma unroll
                for (int e = 0; e < 4; ++e) { v[i][e] = a[e]; v[i][4 + e] = b[e]; } }
        } else {
#pragma unroll
            for (int i = 0; i < 4; ++i) { const int c = (i * 64 + lane) * 8; const u32x4 a = *(const u32x4*)((const bf16_t*)d.m + ro + c);
                v[i][0] = bflo(a.x); v[i][1] = bfhi(a.x); v[i][2] = bflo(a.y); v[i][3] = bfhi(a.y); v[i][4] = bflo(a.z); v[i][5] = bfhi(a.z); v[i][6] = bflo(a.w); v[i][7] = bfhi(a.w); }
        }
#pragma unroll
        for (int i = 0; i < 4; ++i)
#pragma unroll
            for (int e = 0; e < 8; ++e) ss += v[i][e] * v[i][e];
        ss = wave_sum(ss);
        const float r = rsqrtf(ss * (1.0f / DM) + 1e-6f);
        float r2 = r;
        if (d.mode != 0) {
            float s2 = 0.f;
#pragma unroll
            for (int i = 0; i < 4; ++i) { const int c = (i * 64 + lane) * 8;
                const f32x4 w0 = *(const f32x4*)(d.wpost + c), w1 = *(const f32x4*)(d.wpost + c + 4);
                f32x4 h0, h1;
                if (d.hin_bf16) { const u32x4 hv = *(const u32x4*)((const bf16_t*)d.hres + ro + c); h0[0] = bflo(hv.x); h0[1] = bfhi(hv.x); h0[2] = bflo(hv.y); h0[3] = bfhi(hv.y); h1[0] = bflo(hv.z); h1[1] = bfhi(hv.z); h1[2] = bflo(hv.w); h1[3] = bfhi(hv.w); }
                else { h0 = *(const f32x4*)((const float*)d.hres + ro + c); h1 = *(const f32x4*)((const float*)d.hres + ro + c + 4); }
                f32x4 o0, o1;
#pragma unroll
                for (int e = 0; e < 4; ++e) { o0[e] = h0[e] + v[i][e] * r * w0[e]; o1[e] = h1[e] + v[i][4 + e] * r * w1[e]; v[i][e] = o0[e]; v[i][4 + e] = o1[e]; s2 += o0[e] * o0[e] + o1[e] * o1[e]; }
                if (d.hout_bf16) { u32x4 hw; hw.x = pk2(o0[0], o0[1]); hw.y = pk2(o0[2], o0[3]); hw.z = pk2(o1[0], o1[1]); hw.w = pk2(o1[2], o1[3]); *(u32x4*)((bf16_t*)d.hout + ro + c) = hw; }
                else { *(f32x4*)((float*)d.hout + ro + c) = o0; *(f32x4*)((float*)d.hout + ro + c + 4) = o1; } }
            if (d.mode == 1) { s2 = wave_sum(s2); r2 = rsqrtf(s2 * (1.0f / DM) + 1e-6f); }
        }
        if (d.mode != 2) {
#pragma unroll
            for (int i = 0; i < 4; ++i) { const int c = (i * 64 + lane) * 8;
                const f32x4 w0 = *(const f32x4*)(d.wpre + c), w1 = *(const f32x4*)(d.wpre + c + 4);
                u32x4 o; o.x = pk2(v[i][0] * r2 * w0[0], v[i][1] * r2 * w0[1]); o.y = pk2(v[i][2] * r2 * w0[2], v[i][3] * r2 * w0[3]);
                o.z = pk2(v[i][4] * r2 * w1[0], v[i][5] * r2 * w1[1]); o.w = pk2(v[i][6] * r2 * w1[2], v[i][7] * r2 * w1[3]);
                *(u32x4*)(d.ub + ro + c) = o; }
        }
    }
}

__device__ __forceinline__ void rot_table(float* rot, int wg, int G) {
    for (int e = wg * NTHREADS + otid(); e < SEQ * 128; e += G * NTHREADS) {
        const int pos = e >> 7, jf = e & 127;
        const float inv = exp2f(-(float)jf * (13.287712379549449f / 128.0f));
        const float ang = (float)pos * inv;
        const double a = (double)ang; const double k = rint(a * 0.15915494309189535); const float rf = (float)(a - k * 6.283185307179586);
        f32x2 cs; cs.x = cosf(rf); cs.y = sinf(rf);
        *(f32x2*)(rot + 2 * (size_t)e) = cs;
    }
}

__device__ __forceinline__ void ret_pre(const bf16_t* proj, bf16_t* Pg, LAS unsigned char* lds, int wg, int G) {
    const int tid = otid(), lane = tid & 63, wid = __builtin_amdgcn_readfirstlane(tid >> 6), fr = lane & 15, fq = lane >> 4;
    constexpr int QS = 528;
    LAS unsigned char* Qs = lds; LAS unsigned char* Ks = lds + 33792;
    const int lm = wid >> 1, c2 = wid & 1;
    u32x4 rq[4], rk[4];
    int u = wg;
    if (u < 2048) {
        const bf16_t* qb = proj + (size_t)((u >> 3) * 64) * RIN + (u & 7) * 256;
#pragma unroll
        for (int i = 0; i < 4; ++i) { const int idx = i * 512 + tid, row = idx >> 5, ch = idx & 31; rq[i] = *(const u32x4*)(qb + (size_t)row * RIN + ch * 8); rk[i] = *(const u32x4*)(qb + 2048 + (size_t)row * RIN + ch * 8); }
    }
    for (; u < 2048; u += G) {
        const int h = u & 7, t0 = (u >> 3) * 64;
#pragma unroll
        for (int i = 0; i < 4; ++i) { const int idx = i * 512 + tid, row = idx >> 5, ch = idx & 31; *(LAS u32x4*)(Qs + row * QS + ch * 16) = rq[i]; *(LAS u32x4*)(Ks + row * QS + ch * 16) = rk[i]; }
        LDS_BARRIER();
        const int un = u + G;
        if (un < 2048) {
            const bf16_t* qb = proj + (size_t)((un >> 3) * 64) * RIN + (un & 7) * 256;
#pragma unroll
            for (int i = 0; i < 4; ++i) { const int idx = i * 512 + tid, row = idx >> 5, ch = idx & 31; rq[i] = *(const u32x4*)(qb + (size_t)row * RIN + ch * 8); rk[i] = *(const u32x4*)(qb + 2048 + (size_t)row * RIN + ch * 8); }
        }
        const float lg = log1pf(-exp2f(-5.0f - (float)h));
        f32x4 aP0 = {0.f, 0.f, 0.f, 0.f}, aP1 = {0.f, 0.f, 0.f, 0.f};
#pragma unroll
        for (int ks = 0; ks < 8; ++ks) {
            const bf16x8 a = *(const LAS bf16x8*)(Qs + (lm * 16 + fr) * QS + ks * 64 + fq * 16);
            const bf16x8 b0 = *(const LAS bf16x8*)(Ks + ((c2 * 2 + 0) * 16 + fr) * QS + ks * 64 + fq * 16);
            const bf16x8 b1 = *(const LAS bf16x8*)(Ks + ((c2 * 2 + 1) * 16 + fr) * QS + ks * 64 + fq * 16);
            aP0 = __builtin_amdgcn_mfma_f32_16x16x32_bf16(a, b0, aP0, 0, 0, 0);
            aP1 = __builtin_amdgcn_mfma_f32_16x16x32_bf16(a, b1, aP1, 0, 0, 0);
        }
#pragma unroll
        for (int j = 0; j < 4; ++j) { const int l = lm * 16 + fq * 4 + j;
            const int m0 = (c2 * 2 + 0) * 16 + fr, m1 = m0 + 16;
            const int d0 = l > m0 ? l - m0 : m0 - l, d1 = l > m1 ? l - m1 : m1 - l;
            bf16_t* pp = Pg + ((size_t)(t0 + l) * 8 + h) * 64;
            pp[m0] = (bf16_t)f2bf(aP0[j] * expf((float)d0 * lg));
            pp[m1] = (bf16_t)f2bf(aP1[j] * expf((float)d1 * lg)); }
        LDS_BARRIER();
    }
}

__device__ __forceinline__ void ret_scan(bf16_t* proj, const bf16_t* Pg, LAS unsigned char* lds, int wg, int G) {
    const int tid = otid(), lane = tid & 63, wid = __builtin_amdgcn_readfirstlane(tid >> 6), fr = lane & 15, fq = lane >> 4;
    constexpr int QS = 528, VS = 80, PS = 144;
    LAS unsigned char* Qs = lds; LAS unsigned char* Ks = lds + 33792; LAS unsigned char* Vs = lds + 67584; LAS unsigned char* Vz = lds + 72704;
    LAS unsigned char* Ps = lds + 77824; LAS unsigned char* St0 = lds + 87040;
    const int lm = wid >> 1, c2 = wid & 1;
    for (int unit = wg; unit < 256; unit += G) {
        const int xc = unit & 7, ii = unit >> 3, bh = xc * 2 + (ii >> 4), vs = ii & 15, b = bh >> 3, h = bh & 7;
        const float lg = log1pf(-exp2f(-5.0f - (float)h));
        float xi[4];
#pragma unroll
        for (int j = 0; j < 4; ++j) { const int l = lm * 16 + fq * 4 + j; xi[j] = expf((float)(l + 1) * lg); }
        const float cdecay = expf(64.0f * lg);
        const int vrow = (tid & 255) >> 2, vch = tid & 3;
        const float zeta = expf((float)(63 - vrow) * lg);
        const int prow = tid >> 3, pch = tid & 7;
        f32x4 accS[2][2];
#pragma unroll
        for (int a = 0; a < 2; ++a)
#pragma unroll
            for (int c = 0; c < 2; ++c) accS[a][c] = (f32x4){0.f, 0.f, 0.f, 0.f};
        for (int i = tid; i < 16896 / 4; i += NTHREADS) ((LAS unsigned*)St0)[i] = 0u;
        const bf16_t* qb = proj + (size_t)(b * SEQ) * RIN + h * 256;
        const bf16_t* kb = qb + 2048;
        bf16_t* vb = proj + (size_t)(b * SEQ) * RIN + 4096 + h * 512 + vs * 32;
        const bf16_t* pb = Pg + ((size_t)(b * SEQ + prow) * 8 + h) * 64 + pch * 8;
        u32x4 rq[2][4], rk[2][4], rv[2], rp[2];
#define RET_LOAD(S_, cc_) do { const size_t ro_ = (size_t)(cc_) * 64 * RIN; \
            _Pragma("unroll") for (int i = 0; i < 4; ++i) { const int idx = i * 512 + tid, row = idx >> 5, ch = idx & 31; rq[S_][i] = *(const u32x4*)(qb + ro_ + (size_t)row * RIN + ch * 8); rk[S_][i] = *(const u32x4*)(kb + ro_ + (size_t)row * RIN + ch * 8); } \
            if (tid < 256) rv[S_] = *(const u32x4*)(vb + ro_ + (size_t)vrow * RIN + vch * 8); \
            rp[S_] = *(const u32x4*)(pb + (size_t)(cc_) * 64 * 512); } while (0)
        rv[0] = (u32x4){0u, 0u, 0u, 0u}; rv[1] = rv[0];
        RET_LOAD(0, 0); RET_LOAD(1, 1);
        for (int c0 = 0; c0 < 128; c0 += 2) {
#pragma unroll
          for (int par = 0; par < 2; ++par) {
            const int c = c0 + par;
            LAS unsigned char* Stc = St0 + par * 16896; LAS unsigned char* Stn = St0 + (par ^ 1) * 16896;
#pragma unroll
            for (int i = 0; i < 4; ++i) { const int idx = i * 512 + tid, row = idx >> 5, ch = idx & 31; *(LAS u32x4*)(Qs + row * QS + ch * 16) = rq[par][i]; *(LAS u32x4*)(Ks + row * QS + ch * 16) = rk[par][i]; }
            if (tid < 256) {
                const u32x4 rvv = rv[par];
                *(LAS u32x4*)(Vs + vrow * VS + vch * 16) = rvv;
                u32x4 z; z.x = pk2(bflo(rvv.x) * zeta, bfhi(rvv.x) * zeta); z.y = pk2(bflo(rvv.y) * zeta, bfhi(rvv.y) * zeta);
                z.z = pk2(bflo(rvv.z) * zeta, bfhi(rvv.z) * zeta); z.w = pk2(bflo(rvv.w) * zeta, bfhi(rvv.w) * zeta);
                *(LAS u32x4*)(Vz + vrow * VS + vch * 16) = z;
            }
            *(LAS u32x4*)(Ps + prow * PS + pch * 16) = rp[par];
            LDS_BARRIER();
            if (c + 2 < 128) RET_LOAD(par, c + 2);
            f32x4 aX0 = {0.f, 0.f, 0.f, 0.f}, aX1 = {0.f, 0.f, 0.f, 0.f}, aI = {0.f, 0.f, 0.f, 0.f};
#pragma unroll
            for (int ks = 0; ks < 8; ks += 2) {
                const bf16x8 a0 = *(const LAS bf16x8*)(Qs + (lm * 16 + fr) * QS + ks * 64 + fq * 16);
                const bf16x8 s0 = *(const LAS bf16x8*)(Stc + (c2 * 16 + fr) * QS + ks * 64 + fq * 16);
                const bf16x8 a1 = *(const LAS bf16x8*)(Qs + (lm * 16 + fr) * QS + (ks + 1) * 64 + fq * 16);
                const bf16x8 s1 = *(const LAS bf16x8*)(Stc + (c2 * 16 + fr) * QS + (ks + 1) * 64 + fq * 16);
                aX0 = __builtin_amdgcn_mfma_f32_16x16x32_bf16(a0, s0, aX0, 0, 0, 0);
                aX1 = __builtin_amdgcn_mfma_f32_16x16x32_bf16(a1, s1, aX1, 0, 0, 0);
            }
#pragma unroll
            for (int ks = 0; ks < 2; ++ks) {
                const bf16x8 a = *(const LAS bf16x8*)(Ps + (lm * 16 + fr) * PS + ks * 64 + fq * 16);
                const bf16x8 bv = tr_frag(Vs, VS, ks * 32, c2 * 16, lane);
                aI = __builtin_amdgcn_mfma_f32_16x16x32_bf16(a, bv, aI, 0, 0, 0);
            }
            {
                bf16_t* ob = vb + (size_t)(c * 64) * RIN + c2 * 16 + fr;
#pragma unroll
                for (int j = 0; j < 4; ++j) { const int l = lm * 16 + fq * 4 + j; ob[(size_t)l * RIN] = (bf16_t)f2bf(aI[j] + (aX0[j] + aX1[j]) * xi[j]); }
            }
#pragma unroll
            for (int a = 0; a < 2; ++a)
#pragma unroll
                for (int cc = 0; cc < 2; ++cc) accS[a][cc] *= cdecay;
#pragma unroll
            for (int ks = 0; ks < 2; ++ks) {
                const bf16x8 ad0 = tr_frag(Ks, QS, ks * 32, (wid * 2 + 0) * 16, lane);
                const bf16x8 ad1 = tr_frag(Ks, QS, ks * 32, (wid * 2 + 1) * 16, lane);
                const bf16x8 bv0 = tr_frag(Vz, VS, ks * 32, 0, lane);
                const bf16x8 bv1 = tr_frag(Vz, VS, ks * 32, 16, lane);
                accS[0][0] = __builtin_amdgcn_mfma_f32_16x16x32_bf16(ad0, bv0, accS[0][0], 0, 0, 0);
                accS[0][1] = __builtin_amdgcn_mfma_f32_16x16x32_bf16(ad0, bv1, accS[0][1], 0, 0, 0);
                accS[1][0] = __builtin_amdgcn_mfma_f32_16x16x32_bf16(ad1, bv0, accS[1][0], 0, 0, 0);
                accS[1][1] = __builtin_amdgcn_mfma_f32_16x16x32_bf16(ad1, bv1, accS[1][1], 0, 0, 0);
            }
#pragma unroll
            for (int a = 0; a < 2; ++a)
#pragma unroll
                for (int cc = 0; cc < 2; ++cc) {
                    u32x2 w; w.x = pk2(accS[a][cc][0], accS[a][cc][1]); w.y = pk2(accS[a][cc][2], accS[a][cc][3]);
                    *(LAS u32x2*)(Stn + (cc * 16 + fr) * QS + ((wid * 2 + a) * 16 + fq * 4) * 2) = w;
                }
            LDS_BARRIER();
          }
        }
#undef RET_LOAD
    }
}

__device__ __forceinline__ void ret_gn(bf16_t* proj, const float* gnw, int wg, int G) {
    const int tid_ = otid(); const int wave = tid_ >> 6, lane = tid_ & 63;
    for (int pair = wg * 8 + wave; pair < T * 8; pair += G * 8) {
        const int t = pair >> 3, h = pair & 7;
        bf16_t* op = proj + (size_t)t * RIN + 4096 + h * 512 + lane * 8;
        bf16_t* gp = op + 4096;
        const u32x4 ov = *(const u32x4*)op, gv = *(const u32x4*)gp;
        float o[8] = {bflo(ov.x), bfhi(ov.x), bflo(ov.y), bfhi(ov.y), bflo(ov.z), bfhi(ov.z), bflo(ov.w), bfhi(ov.w)};
        float g[8] = {bflo(gv.x), bfhi(gv.x), bflo(gv.y), bfhi(gv.y), bflo(gv.z), bfhi(gv.z), bflo(gv.w), bfhi(gv.w)};
        float s = 0.f;
#pragma unroll
        for (int e = 0; e < 8; ++e) s += o[e];
        const float mu = wave_sum(s) * (1.0f / 512.0f);
        float q = 0.f;
#pragma unroll
        for (int e = 0; e < 8; ++e) { o[e] -= mu; q += o[e] * o[e]; }
        const float rstd = rsqrtf(wave_sum(q) * (1.0f / 512.0f) + 1e-5f);
        const f32x4 w0 = *(const f32x4*)(gnw + h * 512 + lane * 8), w1 = *(const f32x4*)(gnw + h * 512 + lane * 8 + 4);
        float y[8];
#pragma unroll
        for (int e = 0; e < 8; ++e) y[e] = silu(g[e]) * (o[e] * rstd) * (e < 4 ? w0[e & 3] : w1[e & 3]);
        u32x4 w; w.x = pk2(y[0], y[1]); w.y = pk2(y[2], y[3]); w.z = pk2(y[4], y[5]); w.w = pk2(y[6], y[7]);
        *(u32x4*)gp = w;
    }
}

__device__ __forceinline__ void ssd_pre(const bf16_t* proj, bf16_t* halo, float* dtv, float* acv, const float* dt_bias, const float* a_log, int wg, int G) {
    const int tid = otid();
    const int gt = wg * NTHREADS + tid, gs = G * NTHREADS;
    for (int e = gt; e < 256 * 3 * 768; e += gs) {
        const int oc = e % 768, r = (e / 768) % 3, ck = e / (768 * 3);
        const u32x4 v = *(const u32x4*)(proj + (size_t)(ck * 64 + 61 + r) * SINP + 4096 + oc * 8);
        *(u32x4*)(halo + ((size_t)ck * 3 + r) * 6144 + oc * 8) = v;
    }
    const int wave = tid >> 6, lane = tid & 63;
    for (int task = wg * 8 + wave; task < 256 * 64; task += G * 8) {
        const int ck = task >> 6, hd = task & 63;
        const float x = bf2f(proj[(size_t)(ck * 64 + lane) * SINP + 10240 + hd]) + dt_bias[hd];
        const float dt = x > 20.f ? x : log1pf(expf(x));
        float sa = dt * (-expf(a_log[hd]));
#pragma unroll
        for (int o = 1; o < 64; o <<= 1) { const float tt = __shfl_up(sa, o); if (lane >= o) sa += tt; }
        dtv[(size_t)task * 64 + lane] = dt; acv[(size_t)task * 64 + lane] = sa;
    }
}
__device__ __forceinline__ void ssd_conv(bf16_t* proj, const bf16_t* halo, const float* cw, const float* cb, int wg, int G) {
    const int gt = wg * NTHREADS + otid(), gs = G * NTHREADS;
    for (int e = gt; e < 256 * 768; e += gs) {
        const int oc = e % 768, ck = e / 768, col = oc * 8;
        float w[4][8], bias[8];
#pragma unroll
        for (int tp = 0; tp < 4; ++tp) { const f32x4 a = *(const f32x4*)(cw + tp * 6144 + col), b = *(const f32x4*)(cw + tp * 6144 + col + 4);
#pragma unroll
            for (int i = 0; i < 4; ++i) { w[tp][i] = a[i]; w[tp][4 + i] = b[i]; } }
        { const f32x4 a = *(const f32x4*)(cb + col), b = *(const f32x4*)(cb + col + 4);
#pragma unroll
            for (int i = 0; i < 4; ++i) { bias[i] = a[i]; bias[4 + i] = b[i]; } }
        float p3[8], p2[8], p1[8];
        if ((ck & 127) == 0) {
#pragma unroll
            for (int i = 0; i < 8; ++i) { p3[i] = 0.f; p2[i] = 0.f; p1[i] = 0.f; }
        } else {
            const bf16_t* hp = halo + ((size_t)(ck - 1) * 3) * 6144 + col;
            const u32x4 a = *(const u32x4*)hp, b = *(const u32x4*)(hp + 6144), c = *(const u32x4*)(hp + 2 * 6144);
            p3[0] = bflo(a.x); p3[1] = bfhi(a.x); p3[2] = bflo(a.y); p3[3] = bfhi(a.y); p3[4] = bflo(a.z); p3[5] = bfhi(a.z); p3[6] = bflo(a.w); p3[7] = bfhi(a.w);
            p2[0] = bflo(b.x); p2[1] = bfhi(b.x); p2[2] = bflo(b.y); p2[3] = bfhi(b.y); p2[4] = bflo(b.z); p2[5] = bfhi(b.z); p2[6] = bflo(b.w); p2[7] = bfhi(b.w);
            p1[0] = bflo(c.x); p1[1] = bfhi(c.x); p1[2] = bflo(c.y); p1[3] = bfhi(c.y); p1[4] = bflo(c.z); p1[5] = bfhi(c.z); p1[6] = bflo(c.w); p1[7] = bfhi(c.w);
        }
        bf16_t* rp = proj + (size_t)(ck * 64) * SINP + 4096 + col;
        for (int r = 0; r < 64; ++r) {
            const u32x4 xv = *(const u32x4*)(rp + (size_t)r * SINP);
            float x[8] = {bflo(xv.x), bfhi(xv.x), bflo(xv.y), bfhi(xv.y), bflo(xv.z), bfhi(xv.z), bflo(xv.w), bfhi(xv.w)};
            float y[8];
#pragma unroll
            for (int i = 0; i < 8; ++i) { const float s = bias[i] + w[0][i] * p3[i] + w[1][i] * p2[i] + w[2][i] * p1[i] + w[3][i] * x[i]; y[i] = silu(s); p3[i] = p2[i]; p2[i] = p1[i]; p1[i] = x[i]; }
            u32x4 o; o.x = pk2(y[0], y[1]); o.y = pk2(y[2], y[3]); o.z = pk2(y[4], y[5]); o.w = pk2(y[6], y[7]);
            *(u32x4*)(rp + (size_t)r * SINP) = o;
        }
    }
}

__device__ __forceinline__ void ssd_cb(const bf16_t* proj, bf16_t* CBg, LAS unsigned char* lds, int wg, int G) {
    const int tid = otid(), lane = tid & 63, wid = __builtin_amdgcn_readfirstlane(tid >> 6), fr = lane & 15, fq = lane >> 4;
    constexpr int CS = 272;
    LAS unsigned char* Cs = lds; LAS unsigned char* Bs = lds + 17408;
    const int lm = wid >> 1, c2 = wid & 1;
    u32x4 rc[2], rb[2];
    int u = wg;
    if (u < 2048) {
        const bf16_t* bb = proj + (size_t)((u >> 3) * 64) * SINP + 8192 + (u & 7) * 128;
#pragma unroll
        for (int i = 0; i < 2; ++i) { const int idx = i * 512 + tid, row = idx >> 4, ch = idx & 15; rb[i] = *(const u32x4*)(bb + (size_t)row * SINP + ch * 8); rc[i] = *(const u32x4*)(bb + 1024 + (size_t)row * SINP + ch * 8); }
    }
    for (; u < 2048; u += G) {
        const int g = u & 7, t0 = (u >> 3) * 64;
#pragma unroll
        for (int i = 0; i < 2; ++i) { const int idx = i * 512 + tid, row = idx >> 4, ch = idx & 15; *(LAS u32x4*)(Cs + row * CS + ch * 16) = rc[i]; *(LAS u32x4*)(Bs + row * CS + ch * 16) = rb[i]; }
        LDS_BARRIER();
        const int un = u + G;
        if (un < 2048) {
            const bf16_t* bb = proj + (size_t)((un >> 3) * 64) * SINP + 8192 + (un & 7) * 128;
#pragma unroll
            for (int i = 0; i < 2; ++i) { const int idx = i * 512 + tid, row = idx >> 4, ch = idx & 15; rb[i] = *(const u32x4*)(bb + (size_t)row * SINP + ch * 8); rc[i] = *(const u32x4*)(bb + 1024 + (size_t)row * SINP + ch * 8); }
        }
        f32x4 aW0 = {0.f, 0.f, 0.f, 0.f}, aW1 = {0.f, 0.f, 0.f, 0.f};
#pragma unroll
        for (int ks = 0; ks < 4; ++ks) {
            const bf16x8 a = *(const LAS bf16x8*)(Cs + (lm * 16 + fr) * CS + ks * 64 + fq * 16);
            const bf16x8 b0 = *(const LAS bf16x8*)(Bs + ((c2 * 2 + 0) * 16 + fr) * CS + ks * 64 + fq * 16);
            const bf16x8 b1 = *(const LAS bf16x8*)(Bs + ((c2 * 2 + 1) * 16 + fr) * CS + ks * 64 + fq * 16);
            aW0 = __builtin_amdgcn_mfma_f32_16x16x32_bf16(a, b0, aW0, 0, 0, 0);
            aW1 = __builtin_amdgcn_mfma_f32_16x16x32_bf16(a, b1, aW1, 0, 0, 0);
        }
#pragma unroll
        for (int j = 0; j < 4; ++j) { const int l = lm * 16 + fq * 4 + j;
            bf16_t* pp = CBg + ((size_t)(t0 + l) * 8 + g) * 64 + (c2 * 2) * 16 + fr;
            pp[0] = (bf16_t)f2bf(aW0[j]); pp[16] = (bf16_t)f2bf(aW1[j]); }
        LDS_BARRIER();
    }
}

__device__ __forceinline__ void ssd_scan(bf16_t* proj, const bf16_t* CBg, const float* dtv, const float* acv, const float* d_skip, LAS unsigned char* lds, int wg, int G) {
    const int tid = otid(), lane = tid & 63, wid = __builtin_amdgcn_readfirstlane(tid >> 6), fr = lane & 15, fq = lane >> 4;
    constexpr int CS = 272, XS = 80, WS = 144;
    LAS unsigned char* Cs = lds; LAS unsigned char* Bs = lds + 17408; LAS unsigned char* Xs = lds + 34816; LAS unsigned char* Xw = lds + 39936; LAS unsigned char* Zs = lds + 45056;
    LAS unsigned char* Ws = lds + 50176; LAS unsigned char* Sts0 = lds + 59392; LAS float* acum = (LAS float*)(lds + 76800);
    const int lm = wid >> 1, c2 = wid & 1;
    for (int unit = wg; unit < 256; unit += G) {
        const int grp = unit & 7, ii = unit >> 3, b = ii >> 4, hd = grp * 8 + ((ii & 15) >> 1), ph = ii & 1;
        const float dsk = d_skip[hd];
        f32x4 accT[2];
        accT[0] = (f32x4){0.f, 0.f, 0.f, 0.f}; accT[1] = (f32x4){0.f, 0.f, 0.f, 0.f};
        for (int i = tid; i < 8704 / 4; i += NTHREADS) ((LAS unsigned*)Sts0)[i] = 0u;
        const bf16_t* base = proj + (size_t)(b * SEQ) * SINP;
        const bf16_t* bb = base + 8192 + grp * 128;
        const bf16_t* cbp = base + 9216 + grp * 128;
        bf16_t* xb = (bf16_t*)base + 4096 + hd * 64 + ph * 32;
        const bf16_t* zb = base + hd * 64 + ph * 32;
        const int xrow = (tid & 255) >> 2, xch = tid & 3;
        const int wrow = tid >> 3, ws0 = (tid & 7) * 8;
        const bf16_t* cgp = CBg + ((size_t)(b * SEQ + wrow) * 8 + grp) * 64 + ws0;
        const float* dtp = dtv + ((size_t)(b * 128) * 64 + hd) * 64;
        const float* acp = acv + ((size_t)(b * 128) * 64 + hd) * 64;
        u32x4 rc[2][2], rb[2][2], rxz[2], rcb[2]; f32x4 rds[2][2], ras[2][2]; float ral[2], rax[2], rdx[2], rat[2], ra0[2] = {0.f, 0.f};
#define SSD_PREFETCH(S_, cc_) do { const size_t ro_ = (size_t)(cc_) * 64 * SINP; \
            _Pragma("unroll") for (int i = 0; i < 2; ++i) { const int idx = i * 512 + tid, row = idx >> 4, ch = idx & 15; rc[S_][i] = *(const u32x4*)(cbp + ro_ + (size_t)row * SINP + ch * 8); rb[S_][i] = *(const u32x4*)(bb + ro_ + (size_t)row * SINP + ch * 8); } \
            rxz[S_] = *(const u32x4*)((tid < 256 ? (const bf16_t*)xb : zb) + ro_ + (size_t)xrow * SINP + xch * 8); \
            rcb[S_] = *(const u32x4*)(cgp + (size_t)(cc_) * 64 * 512); \
            const float* d_ = dtp + (size_t)(cc_) * 4096; const float* a_ = acp + (size_t)(cc_) * 4096; \
            rds[S_][0] = *(const f32x4*)(d_ + ws0); rds[S_][1] = *(const f32x4*)(d_ + ws0 + 4); ras[S_][0] = *(const f32x4*)(a_ + ws0); ras[S_][1] = *(const f32x4*)(a_ + ws0 + 4); \
            ral[S_] = a_[wrow]; rax[S_] = a_[xrow]; rdx[S_] = d_[xrow]; rat[S_] = a_[63]; if (tid < 64) ra0[S_] = a_[tid]; } while (0)
        SSD_PREFETCH(0, 0); SSD_PREFETCH(1, 1);
        for (int c0 = 0; c0 < 128; c0 += 2) {
#pragma unroll
          for (int par = 0; par < 2; ++par) {
            const int c = c0 + par;
            LAS unsigned char* Stc = Sts0 + par * 8704; LAS unsigned char* Stn = Sts0 + (par ^ 1) * 8704;
#pragma unroll
            for (int i = 0; i < 2; ++i) { const int idx = i * 512 + tid, row = idx >> 4, ch = idx & 15; *(LAS u32x4*)(Cs + row * CS + ch * 16) = rc[par][i]; *(LAS u32x4*)(Bs + row * CS + ch * 16) = rb[par][i]; }
            const u32x4 rxv = rxz[par];
            *(LAS u32x4*)((tid < 256 ? Xs : Zs) + xrow * XS + xch * 16) = rxv;
            if (tid < 256) {
                const float f = rdx[par] * expf(rat[par] - rax[par]);
                u32x4 z; z.x = pk2(bflo(rxv.x) * f, bfhi(rxv.x) * f); z.y = pk2(bflo(rxv.y) * f, bfhi(rxv.y) * f); z.z = pk2(bflo(rxv.z) * f, bfhi(rxv.z) * f); z.w = pk2(bflo(rxv.w) * f, bfhi(rxv.w) * f);
                *(LAS u32x4*)(Xw + xrow * XS + xch * 16) = z;
            }
            {
                const u32x4 rcv = rcb[par];
                const float cv[8] = {bflo(rcv.x), bfhi(rcv.x), bflo(rcv.y), bfhi(rcv.y), bflo(rcv.z), bfhi(rcv.z), bflo(rcv.w), bfhi(rcv.w)};
                float wv[8];
#pragma unroll
                for (int e = 0; e < 8; ++e) { const float as = e < 4 ? ras[par][0][e & 3] : ras[par][1][e & 3], ds = e < 4 ? rds[par][0][e & 3] : rds[par][1][e & 3];
                    wv[e] = (wrow >= ws0 + e) ? cv[e] * expf(ral[par] - as) * ds : 0.f; }
                u32x4 w; w.x = pk2(wv[0], wv[1]); w.y = pk2(wv[2], wv[3]); w.z = pk2(wv[4], wv[5]); w.w = pk2(wv[6], wv[7]);
                *(LAS u32x4*)(Ws + wrow * WS + ws0 * 2) = w;
            }
            if (tid < 64) acum[tid] = ra0[par];
            LDS_BARRIER();
            if (c + 2 < 128) SSD_PREFETCH(par, c + 2);
            const float atot = acum[63];
            float al[4];
#pragma unroll
            for (int j = 0; j < 4; ++j) al[j] = acum[lm * 16 + fq * 4 + j];
            f32x4 aY0 = {0.f, 0.f, 0.f, 0.f}, aY1 = {0.f, 0.f, 0.f, 0.f}, aD = {0.f, 0.f, 0.f, 0.f};
#pragma unroll
            for (int ks = 0; ks < 4; ks += 2) {
                const bf16x8 a0 = *(const LAS bf16x8*)(Cs + (lm * 16 + fr) * CS + ks * 64 + fq * 16);
                const bf16x8 s0 = *(const LAS bf16x8*)(Stc + (c2 * 16 + fr) * CS + ks * 64 + fq * 16);
                const bf16x8 a1 = *(const LAS bf16x8*)(Cs + (lm * 16 + fr) * CS + (ks + 1) * 64 + fq * 16);
                const bf16x8 s1 = *(const LAS bf16x8*)(Stc + (c2 * 16 + fr) * CS + (ks + 1) * 64 + fq * 16);
                aY0 = __builtin_amdgcn_mfma_f32_16x16x32_bf16(a0, s0, aY0, 0, 0, 0);
                aY1 = __builtin_amdgcn_mfma_f32_16x16x32_bf16(a1, s1, aY1, 0, 0, 0);
            }
#pragma unroll
            for (int ks = 0; ks < 2; ++ks) {
                const bf16x8 a = *(const LAS bf16x8*)(Ws + (lm * 16 + fr) * WS + ks * 64 + fq * 16);
                const bf16x8 bx = tr_frag(Xs, XS, ks * 32, c2 * 16, lane);
                aD = __builtin_amdgcn_mfma_f32_16x16x32_bf16(a, bx, aD, 0, 0, 0);
            }
            {
                const int pc = c2 * 16 + fr;
                bf16_t* ob = xb + (size_t)(c * 64) * SINP + pc;
#pragma unroll
                for (int j = 0; j < 4; ++j) { const int l = lm * 16 + fq * 4 + j;
                    const float xv = bf2f(*(const LAS bf16_t*)(Xs + l * XS + pc * 2)), zv = bf2f(*(const LAS bf16_t*)(Zs + l * XS + pc * 2));
                    const float y = aD[j] + (aY0[j] + aY1[j]) * expf(al[j]) + dsk * xv;
                    ob[(size_t)l * SINP] = (bf16_t)f2bf(y * silu(zv)); }
            }
            const float sdec = expf(atot);
            accT[0] *= sdec; accT[1] *= sdec;
#pragma unroll
            for (int ks = 0; ks < 2; ++ks) {
                const bf16x8 an_ = tr_frag(Bs, CS, ks * 32, wid * 16, lane);
                const bf16x8 bp0 = tr_frag(Xw, XS, ks * 32, 0, lane);
                const bf16x8 bp1 = tr_frag(Xw, XS, ks * 32, 16, lane);
                accT[0] = __builtin_amdgcn_mfma_f32_16x16x32_bf16(an_, bp0, accT[0], 0, 0, 0);
                accT[1] = __builtin_amdgcn_mfma_f32_16x16x32_bf16(an_, bp1, accT[1], 0, 0, 0);
            }
#pragma unroll
            for (int pi = 0; pi < 2; ++pi) {
                u32x2 w; w.x = pk2(accT[pi][0], accT[pi][1]); w.y = pk2(accT[pi][2], accT[pi][3]);
                *(LAS u32x2*)(Stn + (pi * 16 + fr) * CS + (wid * 16 + fq * 4) * 2) = w;
            }
            LDS_BARRIER();
          }
        }
#undef SSD_PREFETCH
    }
}

__device__ __forceinline__ void ssd_norm(bf16_t* proj, const float* nw, int wg, int G) {
    const int tid_ = otid(); const int wave = tid_ >> 6, lane = tid_ & 63;
    for (int pair = wg * 8 + wave; pair < T * 8; pair += G * 8) {
        const int t = pair >> 3, gr = pair & 7;
        bf16_t* yp = proj + (size_t)t * SINP + 4096 + gr * 512 + lane * 8;
        const u32x4 yv = *(const u32x4*)yp;
        float y[8] = {bflo(yv.x), bfhi(yv.x), bflo(yv.y), bfhi(yv.y), bflo(yv.z), bfhi(yv.z), bflo(yv.w), bfhi(yv.w)};
        float q = 0.f;
#pragma unroll
        for (int e = 0; e < 8; ++e) q += y[e] * y[e];
        const float r = rsqrtf(wave_sum(q) * (1.0f / 512.0f) + 1e-6f);
        const f32x4 w0 = *(const f32x4*)(nw + gr * 512 + lane * 8), w1 = *(const f32x4*)(nw + gr * 512 + lane * 8 + 4);
        u32x4 w; w.x = pk2(y[0] * r * w0[0], y[1] * r * w0[1]); w.y = pk2(y[2] * r * w0[2], y[3] * r * w0[3]);
        w.z = pk2(y[4] * r * w1[0], y[5] * r * w1[1]); w.w = pk2(y[6] * r * w1[2], y[7] * r * w1[3]);
        *(u32x4*)yp = w;
    }
}


#define XB_TMO      128
#define XB_XCNT(j)  (256  + 64 * (j))
#define XB_XSUB(j)  (1280 + 64 * (j))
#define XB_XGEN(j)  (2304 + 64 * (j))
#define XB_TOP      3328
#define XB_TOPGEN   3392
#define XCD_BAR_WORDS 3456
#define XB_SPIN_CAP (1u << 18)
__device__ __forceinline__ unsigned xb_ld(unsigned* p)              { return __hip_atomic_load(p, __ATOMIC_RELAXED, __HIP_MEMORY_SCOPE_AGENT); }
__device__ __forceinline__ unsigned xb_add(unsigned* p, unsigned v) { return __hip_atomic_fetch_add(p, v, __ATOMIC_RELAXED, __HIP_MEMORY_SCOPE_AGENT); }
__device__ __forceinline__ unsigned xb_xcc_id() { return (unsigned)__builtin_amdgcn_s_getreg((3 << 11) | 20) & 0xFu; }
#define XB_SPIN(cond, bar) do { unsigned _sp = 0; while (cond) { __builtin_amdgcn_s_sleep(1); \
    if ((++_sp & 255u) == 0u) { if (xb_ld(&(bar)[XB_TMO])) break; if (_sp > XB_SPIN_CAP) { atomicAdd(&(bar)[XB_TMO], 1u); break; } } } } while (0)
struct XcdBarrier { unsigned* bar; unsigned x; volatile LAS unsigned* st; };
__device__ __forceinline__ XcdBarrier xcd_barrier_post(unsigned* bar, volatile LAS unsigned* st) {
    XcdBarrier b; b.bar = bar; b.x = xb_xcc_id(); b.st = st;
    if (threadIdx.x == 0) (void)xb_add(&bar[XB_XCNT(b.x)], 1u);
    return b;
}
__device__ __forceinline__ void xcd_barrier_complete(unsigned* bar, unsigned x, unsigned& nloc, unsigned& nx) {
    const unsigned G = gridDim.x * gridDim.y * gridDim.z;
    unsigned sum, cnt, mine, sp = 0u;
    for (;;) {
        sum = 0u; cnt = 0u; mine = 0u;
#pragma unroll
        for (unsigned j = 0; j < 16; ++j) { const unsigned c = xb_ld(&bar[XB_XCNT(j)]); sum += c; cnt += (c > 0u) ? 1u : 0u; mine = (j == x) ? c : mine; }
        if (sum == G) break;
        __builtin_amdgcn_s_sleep(1);
        if ((++sp & 255u) == 0u) { if (xb_ld(&bar[XB_TMO])) break; if (sp > XB_SPIN_CAP) { atomicAdd(&bar[XB_TMO], 1u); break; } }
    }
    nloc = mine > 0u ? mine : 1u; nx = cnt > 0u ? cnt : 1u;
}
__device__ __forceinline__ void xcd_barrier(const XcdBarrier& b) {
    asm volatile("s_waitcnt vmcnt(0)" ::: "memory");
    __syncthreads();
    if (threadIdx.x == 0) {
        unsigned* bar = b.bar;
        __builtin_amdgcn_s_waitcnt(0);
        unsigned nloc = b.st[0], nx = b.st[1];
        if (nloc == 0u) { xcd_barrier_complete(bar, b.x, nloc, nx); b.st[0] = nloc; b.st[1] = nx; }
        const unsigned old = xb_add(&bar[XB_XSUB(b.x)], 1u);
        const unsigned gen = old / nloc;
        if (old + 1u == (gen + 1u) * nloc) {
            __builtin_amdgcn_fence(__ATOMIC_RELEASE, "agent");
            asm volatile("s_waitcnt vmcnt(0)" ::: "memory");
            const unsigned og = xb_add(&bar[XB_TOP], 1u);
            const unsigned tg = og / nx;
            if (og + 1u == (tg + 1u) * nx) xb_add(&bar[XB_TOPGEN], 1u);
            else XB_SPIN(xb_ld(&bar[XB_TOPGEN]) == tg, bar);
            __builtin_amdgcn_fence(__ATOMIC_ACQUIRE, "agent");
            xb_add(&bar[XB_XGEN(b.x)], 1u);
            asm volatile("s_waitcnt vmcnt(0)" ::: "memory");
        } else {
            XB_SPIN(xb_ld(&bar[XB_XGEN(b.x)]) == gen, bar);
            __builtin_amdgcn_fence(__ATOMIC_ACQUIRE, "agent");
            asm volatile("s_waitcnt vmcnt(0)" ::: "memory");
        }
    }
    __syncthreads();
}

struct Params {
    const float* x; const float* nmp; const float* nmq; const float* nfp; const float* nfq;
    const float* ret_w_in; const float* ret_gn_w; const float* ret_w_out;
    const float* ssd_w_in; const float* conv_w; const float* conv_b; const float* dt_bias; const float* a_log; const float* d_skip; const float* ssd_norm_w; const float* ssd_w_out;
    const float* w_up; const float* w_down;
    float* out; unsigned char* ws;
};


__global__ void __launch_bounds__(NTHREADS, 2) mega(Params p) {
    extern __shared__ __attribute__((aligned(16))) unsigned char lds_raw[];
    LAS unsigned char* lds = (LAS unsigned char*)lds_raw;
    cg::grid_group grid = cg::this_grid();
    const int G = gridDim.x, wg = blockIdx.x;
    bf16_t* WA = (bf16_t*)(p.ws + OFF_WA); bf16_t* WB = (bf16_t*)(p.ws + OFF_WB);
    bf16_t* ACT = (bf16_t*)(p.ws + OFF_ACT); bf16_t* U_ACT = (bf16_t*)(p.ws + OFF_ACT + HID_BYTES); bf16_t* F_ACT = (bf16_t*)(p.ws + OFF_ACT + HID_BYTES);
    bf16_t* U_R2 = (bf16_t*)(p.ws + OFF_R2); bf16_t* MF_R2 = (bf16_t*)(p.ws + OFF_R2);
    float* ROT = (float*)(p.ws + OFF_ROT); bf16_t* HALO = (bf16_t*)(p.ws + OFF_HALO); float* DTV = (float*)(p.ws + OFF_DTV); float* ACV = (float*)(p.ws + OFF_ACV); bf16_t* CBG = (bf16_t*)(p.ws + OFF_CBG); bf16_t* PG = (bf16_t*)p.out; bf16_t* HB1 = (bf16_t*)p.out; bf16_t* HB2 = (bf16_t*)(p.ws + OFF_ACT + HID_BYTES + 67108864);

#define GEMM(KIND, ...) do { const pg8::Gemm gd = pg8::Gemm{__VA_ARGS__}; pg8::StaticOrder S; S.init(gd.M, gd.N, G, wg); pg8::gemm_phase<KIND>(lds, gd, S); GSYNC(); } while (0)
    unsigned* barw = (unsigned*)(p.ws + OFF_BAR);
    volatile LAS unsigned* bst = (volatile LAS unsigned*)(lds + LDS_STAGE);
    if (wg == 0) for (int i = threadIdx.x; i < XCD_BAR_WORDS; i += NTHREADS) barw[i] = 0u;
    if (threadIdx.x < 2) bst[threadIdx.x] = 0u;
    norm_pass(NormDesc{0, p.x, nullptr, nullptr, nullptr, p.nmp, U_R2, 0, 0}, wg, G);
    convert_w(ConvDesc{p.ret_w_in, WA, 2048, RIN, RIN, 1}, lds, wg, G);
    convert_w(ConvDesc{p.ret_w_out, WB, 4096, 2048, 2048, 0}, lds, wg, G);
    rot_table(ROT, wg, G);
    grid.sync();
    const XcdBarrier xb = xcd_barrier_post(barw, bst);
#define GSYNC() xcd_barrier(xb)
    GEMM(3, U_R2, WA, T, RIN, 2048, 2048, 3, ACT, RIN, ROT);
    ret_pre(ACT, PG, lds, wg, G); GSYNC();
    ret_scan(ACT, PG, lds, wg, G); GSYNC();
    ret_gn(ACT, p.ret_gn_w, wg, G); GSYNC();
    GEMM(1, ACT + 8192, WB, T, 2048, 4096, RIN, 1, MF_R2, 2048, nullptr);
    norm_pass(NormDesc{1, MF_R2, p.x, HB1, p.nmq, p.nfp, U_ACT, 0, 1}, wg, G);
    convert_w(ConvDesc{p.w_up, WA, 2048, DFF, DFF, 0}, lds, wg, G);
    convert_w(ConvDesc{p.w_down, WB, DFF, 2048, 2048, 0}, lds, wg, G);
    GSYNC();
    GEMM(2, U_ACT, WA, T, DFF, 2048, 2048, 2, ACT, DFF, nullptr);
    GEMM(1, ACT, WB, T, 2048, DFF, DFF, 1, F_ACT, 2048, nullptr);
    norm_pass(NormDesc{1, F_ACT, HB1, HB1, p.nfq, p.nmp + DM, U_R2, 1, 1}, wg, G);
    convert_w(ConvDesc{p.ssd_w_in, WA, 2048, SIN, SINP, 0}, lds, wg, G);
    convert_w(ConvDesc{p.ssd_w_out, WB, 4096, 2048, 2048, 0}, lds, wg, G);
    GSYNC();
    GEMM(1, U_R2, WA, T, SINP, 2048, 2048, 1, ACT, SINP, nullptr);
    ssd_pre(ACT, HALO, DTV, ACV, p.dt_bias, p.a_log, wg, G); GSYNC();
    ssd_conv(ACT, HALO, p.conv_w, p.conv_b, wg, G); GSYNC();
    ssd_cb(ACT, CBG, lds, wg, G); GSYNC();
    ssd_scan(ACT, CBG, DTV, ACV, p.d_skip, lds, wg, G); GSYNC();
    ssd_norm(ACT, p.ssd_norm_w, wg, G); GSYNC();
    GEMM(1, ACT + 4096, WB, T, 2048, 4096, SINP, 1, MF_R2, 2048, nullptr);
    norm_pass(NormDesc{1, MF_R2, HB1, HB2, p.nmq + DM, p.nfp + DM, U_ACT, 1, 1}, wg, G);
    convert_w(ConvDesc{p.w_up + (size_t)2048 * DFF, WA, 2048, DFF, DFF, 0}, lds, wg, G);
    convert_w(ConvDesc{p.w_down + (size_t)DFF * 2048, WB, DFF, 2048, 2048, 0}, lds, wg, G);
    GSYNC();
    GEMM(2, U_ACT, WA, T, DFF, 2048, 2048, 2, ACT, DFF, nullptr);
    GEMM(1, ACT, WB, T, 2048, DFF, DFF, 1, F_ACT, 2048, nullptr);
    norm_pass(NormDesc{2, F_ACT, HB2, p.out, p.nfq + DM, nullptr, nullptr, 1, 0}, wg, G);
#undef GEMM
#undef GSYNC
}

extern "C" void kernel_launch(void* const* d_in, const int* in_sizes, int n_in, void* d_out, int out_size, void* d_ws, size_t ws_size, hipStream_t stream) {
    static int grid_blocks = 0;
    if (!grid_blocks) {
        int dev = 0, cus = 0, per_cu = 0;
        hipGetDevice(&dev);
        hipDeviceGetAttribute(&cus, hipDeviceAttributeMultiprocessorCount, dev);
        hipFuncSetAttribute((const void*)mega, hipFuncAttributeMaxDynamicSharedMemorySize, LDS_BYTES);
        hipOccupancyMaxActiveBlocksPerMultiprocessor(&per_cu, (const void*)mega, NTHREADS, LDS_BYTES);
        if (per_cu < 1) per_cu = 1;
        grid_blocks = cus * per_cu;
        if (ws_size < WS_END) { fprintf(stderr, "kernel_launch: workspace too small: %zu < %zu\n", ws_size, (size_t)WS_END); grid_blocks = -1; }
    }
    if (grid_blocks < 0) return;
    Params p{};
    p.x = (const float*)d_in[0]; p.nmp = (const float*)d_in[1]; p.nmq = (const float*)d_in[2]; p.nfp = (const float*)d_in[3]; p.nfq = (const float*)d_in[4];
    p.ret_w_in = (const float*)d_in[5]; p.ret_gn_w = (const float*)d_in[6]; p.ret_w_out = (const float*)d_in[7];
    p.ssd_w_in = (const float*)d_in[8]; p.conv_w = (const float*)d_in[9]; p.conv_b = (const float*)d_in[10]; p.dt_bias = (const float*)d_in[11];
    p.a_log = (const float*)d_in[12]; p.d_skip = (const float*)d_in[13]; p.ssd_norm_w = (const float*)d_in[14]; p.ssd_w_out = (const float*)d_in[15];
    p.w_up = (const float*)d_in[16]; p.w_down = (const float*)d_in[17];
    p.out = (float*)d_out; p.ws = (unsigned char*)d_ws;
    void* args[] = {&p};
    hipError_t e = hipLaunchCooperativeKernel((const void*)mega, dim3(grid_blocks), dim3(NTHREADS), args, LDS_BYTES, stream);
    if (e != hipSuccess) fprintf(stderr, "cooperative launch failed: %s (grid %d)\n", hipGetErrorString(e), grid_blocks);
}
```

```cpp
#include <hip/hip_runtime.h>
#include <hip/hip_cooperative_groups.h>
#include <cstdio>
namespace cg = cooperative_groups;

#define LAS __attribute__((address_space(3)))
typedef unsigned short bf16_t;
typedef short bf16x8 __attribute__((ext_vector_type(8)));
typedef short s16x4 __attribute__((ext_vector_type(4)));
typedef float f32x4 __attribute__((ext_vector_type(4)));
typedef float f32x2 __attribute__((ext_vector_type(2)));
typedef unsigned u32x4 __attribute__((ext_vector_type(4)));
typedef unsigned u32x2 __attribute__((ext_vector_type(2)));

constexpr int T = 16384, DM = 2048, SEQ = 8192;
constexpr int RIN = 12288;
constexpr int SIN = 10304, SINP = 10496;
constexpr int DFF = 8192;
constexpr int NTHREADS = 512;
constexpr int LDS_STAGE = 131072;
constexpr int LDS_BYTES = LDS_STAGE + 16;

constexpr size_t OFF_WA = 0;
constexpr size_t OFF_WB = 50331648;
constexpr size_t OFF_ACT = OFF_WB + 33554432;
constexpr size_t ACT_BYTES = 402653184;
constexpr size_t HID_BYTES = 268435456;
constexpr size_t OFF_R2 = OFF_ACT + ACT_BYTES;
constexpr size_t R2_BYTES = 134217728;
constexpr size_t OFF_ROT = OFF_R2 + 67108864;
constexpr size_t OFF_HALO = OFF_R2 + 67108864;
constexpr size_t OFF_DTV = OFF_R2 + 67108864 + 16777216;
constexpr size_t OFF_ACV = OFF_DTV + 4194304;
constexpr size_t OFF_CBG = OFF_R2;
constexpr size_t OFF_BAR = OFF_R2 + 100663296;
constexpr size_t WS_END = OFF_R2 + R2_BYTES;

typedef __bf16 bf16x2v __attribute__((ext_vector_type(2)));
__device__ __forceinline__ unsigned cvt_pk_bf16(float lo, float hi) { const f32x2 v = {lo, hi}; const bf16x2v b = __builtin_convertvector(v, bf16x2v); return __builtin_bit_cast(unsigned, b); }
__device__ __forceinline__ unsigned pk2(float lo, float hi) { return cvt_pk_bf16(lo, hi); }
__device__ __forceinline__ unsigned f2bf(float f) { return (unsigned)__builtin_bit_cast(unsigned short, (__bf16)f); }
__device__ __forceinline__ float bflo(unsigned w) { return __uint_as_float(w << 16); }
__device__ __forceinline__ float bfhi(unsigned w) { return __uint_as_float(w & 0xffff0000u); }
__device__ __forceinline__ float bf2f(bf16_t b) { return __uint_as_float(((unsigned)b) << 16); }
__device__ __forceinline__ float wave_sum(float v) {
#pragma unroll
    for (int o = 32; o >= 1; o >>= 1) v += __shfl_xor(v, o);
    return v;
}
__device__ __forceinline__ int otid() { int t = threadIdx.x; asm volatile("" : "+v"(t)); return t; }
#define LDS_BARRIER() do { asm volatile("s_waitcnt lgkmcnt(0)" ::: "memory"); __builtin_amdgcn_s_barrier(); asm volatile("" ::: "memory"); } while (0)
__device__ __forceinline__ float silu(float x) { return x / (1.0f + __expf(-x)); }

__device__ __forceinline__ bf16x8 tr_frag(LAS unsigned char* img, int rs, int kbase, int n0, int lane) {
    const int g = lane >> 4, q = (lane & 15) >> 2, p = lane & 3;
    LAS unsigned char* a0 = img + (kbase + 8 * g + q) * rs + (n0 + 4 * p) * 2;
    s16x4 a = __builtin_amdgcn_ds_read_tr16_b64_v4i16((LAS s16x4*)a0);
    s16x4 b = __builtin_amdgcn_ds_read_tr16_b64_v4i16((LAS s16x4*)(a0 + 4 * rs));
    bf16x8 r = {a[0], a[1], a[2], a[3], b[0], b[1], b[2], b[3]};
    return r;
}

namespace pg8 {
constexpr int BM = 256, BK = 64, HALF = 128, HTB = HALF * BK * 2, STAGE_BYTES = 8 * HTB, NXCD = 8, WGM = 8;
__device__ __forceinline__ int lds_byte(int r, int c) { const int st = (r >> 4) * 2 + (c >> 5), rr = r & 15, cc = c & 31, ob = rr * 64 + cc * 2; return st * 1024 + (ob ^ (((ob >> 9) & 1) << 5)); }
__device__ __forceinline__ void stage_rc(int b, int& R, int& C) { const int st = b / 1024, sb = b % 1024, swz = sb ^ (((sb >> 9) & 1) << 5); R = (st >> 1) * 16 + swz / 64; C = (st & 1) * 32 + (swz % 64) / 2; }
__device__ __forceinline__ int perm32(int rho) { const int n = rho >> 4, i = rho & 15; return 8 * (i >> 2) + 4 * n + (i & 3); }
struct Unit { int pm, pn; };
struct Gemm { const bf16_t* A; const bf16_t* Bt; int M, N, K, lda; int kind; void* out; int ldc; const float* rot; };
struct StaticOrder {
    int nM, nN, nwg, G, c;
    __device__ void init(int M, int N, int G_, int c_) { nM = M / BM; nN = N / BM; nwg = nM * nN; G = G_; c = c_; }
    __device__ bool next(int i, Unit& u) const {
        const long L = (long)i * G + c; if (L >= nwg) return false;
        int wgid = (int)L; { const int q = nwg / NXCD, r = nwg % NXCD, xcd = wgid % NXCD, off = wgid / NXCD; wgid = (xcd < r ? xcd * (q + 1) : r * (q + 1) + (xcd - r) * q) + off; }
        const int nig = WGM * nN, gid = wgid / nig, fm = gid * WGM, gsz = (nM - fm) < WGM ? (nM - fm) : WGM;
        u.pm = fm + ((wgid % nig) % gsz); u.pn = (wgid % nig) / gsz; return true;
    }
};

template <int KIND> __device__ __forceinline__ void epilogue(const Gemm& g, const f32x4 (&acc)[2][2][4][2], const Unit& u, int wr, int wc, int fr, int fq) {
    if constexpr (KIND == 0) {
        float* C = (float*)g.out; const int ldc = g.ldc;
        const int row0 = u.pm * BM + wr * 64 + fr, col0 = u.pn * BM + wc * 32 + 4 * fq;
#pragma unroll
        for (int ai = 0; ai < 2; ++ai)
#pragma unroll
            for (int m = 0; m < 4; ++m) { float* rowp = C + (size_t)(row0 + ai * HALF + m * 16) * ldc + col0;
#pragma unroll
                for (int bj = 0; bj < 2; ++bj)
#pragma unroll
                    for (int n = 0; n < 2; ++n) *(f32x4*)(rowp + bj * HALF + n * 16) = acc[ai][bj][m][n]; }
    } else {
        bf16_t* O = (bf16_t*)g.out; const int ldc = g.ldc;
        const int row0 = u.pm * BM + wr * 64 + fr, col0 = u.pn * BM + wc * 32 + 8 * fq;
        const bool isrot = (KIND == 3) && (u.pn < 16);
        const float sc = (u.pn >= 8) ? 0.0625f : 1.0f;
        constexpr bool relu2 = (KIND == 2);
#pragma unroll
        for (int ai = 0; ai < 2; ++ai)
#pragma unroll
            for (int m = 0; m < 4; ++m) {
                const int row = row0 + ai * HALF + m * 16;
                bf16_t* rowp = O + (size_t)row * ldc + col0;
                const int pos = row & (SEQ - 1);
#pragma unroll
                for (int bj = 0; bj < 2; ++bj) {
                    f32x4 v0 = acc[ai][bj][m][0], v1 = acc[ai][bj][m][1];
                    if (relu2) {
#pragma unroll
                        for (int j = 0; j < 4; ++j) { const float a = fmaxf(v0[j], 0.f), b = fmaxf(v1[j], 0.f); v0[j] = a * a; v1[j] = b * b; }
                    }
                    if (isrot) {
                        const float* rp = g.rot + ((size_t)pos * 128 + 64 * bj + 16 * wc + 4 * fq) * 2;
                        const f32x4 c0 = *(const f32x4*)rp, c1 = *(const f32x4*)(rp + 4);
                        f32x4 r0, r1;
                        r0[0] = v0[0] * c0[0] - v0[1] * c0[1]; r0[1] = v0[0] * c0[1] + v0[1] * c0[0];
                        r0[2] = v0[2] * c0[2] - v0[3] * c0[3]; r0[3] = v0[2] * c0[3] + v0[3] * c0[2];
                        r1[0] = v1[0] * c1[0] - v1[1] * c1[1]; r1[1] = v1[0] * c1[1] + v1[1] * c1[0];
                        r1[2] = v1[2] * c1[2] - v1[3] * c1[3]; r1[3] = v1[2] * c1[3] + v1[3] * c1[2];
                        v0 = r0 * sc; v1 = r1 * sc;
                    }
                    u32x4 w; w.x = cvt_pk_bf16(v0[0], v0[1]); w.y = cvt_pk_bf16(v0[2], v0[3]); w.z = cvt_pk_bf16(v1[0], v1[1]); w.w = cvt_pk_bf16(v1[2], v1[3]);
                    *(u32x4*)(rowp + bj * HALF) = w;
                }
            }
    }
}

template <int KIND> __device__ __forceinline__ void gemm_phase(LAS unsigned char* lds, const Gemm g, const StaticOrder& S) {
    const int tid = otid(), wid = __builtin_amdgcn_readfirstlane(tid >> 6), lane = tid & 63, wr = wid >> 2, wc = wid & 3, fr = lane & 15, fq = lane >> 4;
    const int K = g.K, nt = K / BK, lda = g.lda;
    constexpr bool perm = KIND != 0;
    unsigned voffA[2], voffB[2];
#pragma unroll
    for (int i = 0; i < 2; ++i) { int R, C; stage_rc(tid * 16 + i * 8192, R, C); const int Rb = perm ? ((R & ~31) + perm32(R & 31)) : R;
        voffA[i] = (unsigned)(R * lda + C) * 2u; voffB[i] = (unsigned)(Rb * K + C) * 2u; }
    const size_t kstep = (size_t)(BK * 2);
    const size_t hstepA = (size_t)HALF * lda * 2, hstepB = (size_t)HALF * K * 2;
    const size_t tstepA = 2 * hstepA, tstepB = 2 * hstepB;
    const unsigned ldsw = (unsigned)wid * 1024u;
    const int aoff = lds_byte(wr * 64 + fr, fq * 8), boff = lds_byte(wc * 32 + fr, fq * 8);
#define PG8_SA(b, h) (((b) * 2 + (h)) * HTB)
#define PG8_SB(b, h) ((4 + (b) * 2 + (h)) * HTB)
#define PG8_STAGE(bufoff, gbase, voff) do { _Pragma("unroll") for (int _i = 0; _i < 2; ++_i) \
        __builtin_amdgcn_global_load_lds((const unsigned*)((const char*)(gbase) + (voff)[_i]), (LAS unsigned*)(lds + (bufoff) + ldsw + _i * 8192), 16, 0, 0); } while (0)
#define PG8_LDA(dst, b, h) do { _Pragma("unroll") for (int m = 0; m < 4; ++m) _Pragma("unroll") for (int k = 0; k < 2; ++k) dst[m][k] = *(const LAS bf16x8*)(lds + PG8_SA(b, h) + aoff + m * 2048 + k * 1024); } while (0)
#define PG8_LDB(dst, b, h) do { _Pragma("unroll") for (int n = 0; n < 2; ++n) _Pragma("unroll") for (int k = 0; k < 2; ++k) dst[n][k] = *(const LAS bf16x8*)(lds + PG8_SB(b, h) + boff + n * 2048 + k * 1024); } while (0)
#define PG8_MMA(ai, bj, At, Bt) do { __builtin_amdgcn_s_setprio(1); _Pragma("unroll") for (int m = 0; m < 4; ++m) _Pragma("unroll") for (int n = 0; n < 2; ++n) _Pragma("unroll") for (int k = 0; k < 2; ++k) \
        acc[ai][bj][m][n] = __builtin_amdgcn_mfma_f32_16x16x32_bf16(Bt[n][k], At[m][k], acc[ai][bj][m][n], 0, 0, 0); __builtin_amdgcn_s_setprio(0); } while (0)
#define PG8_WAIT_V(n) asm volatile("s_waitcnt vmcnt(" #n ")" ::: "memory")
#define PG8_WAIT_L(n) asm volatile("s_waitcnt lgkmcnt(" #n ")" ::: "memory")
#define PG8_BAR __builtin_amdgcn_s_barrier()
#define PG8_SCHED __builtin_amdgcn_sched_barrier(0)
    Unit cur, nxt; int ui = 0;
    if (!S.next(0, cur)) return;
    f32x4 acc[2][2][4][2];
#pragma unroll
    for (int a = 0; a < 2; ++a)
#pragma unroll
        for (int b = 0; b < 2; ++b)
#pragma unroll
            for (int m = 0; m < 4; ++m)
#pragma unroll
                for (int n = 0; n < 2; ++n) acc[a][b][m][n] = (f32x4){0.f, 0.f, 0.f, 0.f};
    bf16x8 At[4][2], B0[2][2], B1[2][2];
    const char* cA = (const char*)g.A + (size_t)cur.pm * tstepA; const char* cB = (const char*)g.Bt + (size_t)cur.pn * tstepB;
    PG8_STAGE(PG8_SB(0, 0), cB, voffB); PG8_STAGE(PG8_SA(0, 0), cA, voffA); PG8_STAGE(PG8_SB(0, 1), cB + hstepB, voffB); PG8_STAGE(PG8_SA(0, 1), cA + hstepA, voffA);
    if (wr == 1) PG8_BAR;
    PG8_WAIT_V(4); PG8_BAR;
    PG8_STAGE(PG8_SB(1, 0), cB + kstep, voffB); PG8_STAGE(PG8_SA(1, 0), cA + kstep, voffA); PG8_STAGE(PG8_SB(1, 1), cB + hstepB + kstep, voffB);
    PG8_WAIT_V(6); PG8_BAR;
    for (;;) {
        const bool has_next = S.next(ui + 1, nxt);
        const char* nA = has_next ? (const char*)g.A + (size_t)nxt.pm * tstepA : cA; const char* nB = has_next ? (const char*)g.Bt + (size_t)nxt.pn * tstepB : cB;
        for (int t = 0; t < nt; t += 2) {
            const bool last = (t == nt - 2);
            const char* a1 = cA + (size_t)(t + 1) * kstep;
            const char* a2 = last ? nA : cA + (size_t)(t + 2) * kstep; const char* b2 = last ? nB : cB + (size_t)(t + 2) * kstep;
            const char* a3 = a2 + kstep; const char* b3 = b2 + kstep;
            PG8_LDB(B0, 0, 0); PG8_SCHED; PG8_LDA(At, 0, 0); PG8_STAGE(PG8_SA(1, 1), a1 + hstepA, voffA);
            PG8_WAIT_L(8); PG8_BAR; PG8_WAIT_L(0); PG8_MMA(0, 0, At, B0); PG8_BAR; PG8_SCHED;
            PG8_LDB(B1, 0, 1); PG8_STAGE(PG8_SB(0, 0), b2, voffB);
            PG8_BAR; PG8_WAIT_L(0); PG8_MMA(0, 1, At, B1); PG8_BAR;
            PG8_LDA(At, 0, 1); PG8_STAGE(PG8_SA(0, 0), a2, voffA);
            PG8_BAR; PG8_WAIT_L(0); PG8_MMA(1, 0, At, B0); PG8_BAR; PG8_SCHED;
            PG8_STAGE(PG8_SB(0, 1), b2 + hstepB, voffB);
            PG8_WAIT_V(6); PG8_BAR; PG8_MMA(1, 1, At, B1); PG8_BAR;
            PG8_LDB(B0, 1, 0); PG8_SCHED; PG8_LDA(At, 1, 0); PG8_STAGE(PG8_SA(0, 1), a2 + hstepA, voffA);
            PG8_WAIT_L(8); PG8_BAR; PG8_WAIT_L(0); PG8_MMA(0, 0, At, B0); PG8_BAR; PG8_SCHED;
            PG8_LDB(B1, 1, 1); PG8_STAGE(PG8_SB(1, 0), b3, voffB);
            PG8_BAR; PG8_WAIT_L(0); PG8_MMA(0, 1, At, B1); PG8_BAR;
            PG8_LDA(At, 1, 1); PG8_STAGE(PG8_SA(1, 0), a3, voffA);
            PG8_BAR; PG8_WAIT_L(0); PG8_MMA(1, 0, At, B0); PG8_BAR; PG8_SCHED;
            PG8_STAGE(PG8_SB(1, 1), b3 + hstepB, voffB);
            PG8_WAIT_V(6); PG8_BAR; PG8_MMA(1, 1, At, B1); PG8_BAR;
        }
        epilogue<KIND>(g, acc, cur, wr, wc, fr, fq);
        if (!has_next) break;
#pragma unroll
        for (int a = 0; a < 2; ++a)
#pragma unroll
            for (int b = 0; b < 2; ++b)
#pragma unroll
                for (int m = 0; m < 4; ++m)
#pragma unroll
                    for (int n = 0; n < 2; ++n) acc[a][b][m][n] = (f32x4){0.f, 0.f, 0.f, 0.f};
        cur = nxt; cA = nA; cB = nB; ++ui;
    }
    PG8_WAIT_V(0);
    if (wr == 0) PG8_BAR;
    PG8_BAR;
#undef PG8_SA
#undef PG8_SB
#undef PG8_STAGE
#undef PG8_LDA
#undef PG8_LDB
#undef PG8_MMA
#undef PG8_WAIT_V
#undef PG8_WAIT_L
#undef PG8_BAR
#undef PG8_SCHED
}
}

struct ConvDesc { const float* src; bf16_t* dst; int K, Nsrc, Ndst, permq; };
__device__ __forceinline__ void convert_w(const ConvDesc& c, LAS unsigned char* lds, int wg, int G) {
    const int tid = otid();
    constexpr int RS = 144;
    const int nnt = c.Ndst / 128, ntile = (c.K / 64) * nnt;
    const int c4 = tid & 31, kq = tid >> 5;
    f32x4 r[4];
#define CW_LOAD(u_) do { const int nt_ = (u_) % nnt, kt_ = (u_) / nnt; const int col_ = nt_ * 128 + c4 * 4; \
        const float* sp_ = c.src + (size_t)(kt_ * 64 + kq * 4) * c.Nsrc + col_; const bool ok_ = col_ < c.Nsrc; \
        _Pragma("unroll") for (int i_ = 0; i_ < 4; ++i_) r[i_] = ok_ ? *(const f32x4*)(sp_ + (size_t)i_ * c.Nsrc) : (f32x4){0.f, 0.f, 0.f, 0.f}; } while (0)
    int u = wg;
    if (u < ntile) CW_LOAD(u);
    while (u < ntile) {
#pragma unroll
        for (int e = 0; e < 4; ++e) { u32x2 w; w.x = pk2(r[0][e], r[1][e]); w.y = pk2(r[2][e], r[3][e]); *(LAS u32x2*)(lds + (c4 * 4 + e) * RS + kq * 8) = w; }
        const int un = u + G;
        if (un < ntile) CW_LOAD(un);
        LDS_BARRIER();
        {
            const int nt = u % nnt, kt = u / nnt, n0 = nt * 128;
            const bool pm = c.permq && n0 < 4096;
#pragma unroll
            for (int i = 0; i < 2; ++i) { const int idx = i * 512 + tid, row = idx >> 3, kb = idx & 7;
                const u32x4 v = *(const LAS u32x4*)(lds + row * RS + kb * 16);
                const int drow = pm ? ((n0 & ~255) + 2 * row + ((n0 >> 7) & 1)) : (n0 + row);
                *(u32x4*)(c.dst + (size_t)drow * c.K + kt * 64 + kb * 8) = v; }
        }
        LDS_BARRIER();
        u = un;
    }
#undef CW_LOAD
}

struct NormDesc { int mode; const void* m; const void* hres; void* hout; const float* wpost; const float* wpre; bf16_t* ub; int hin_bf16, hout_bf16; };
__device__ __forceinline__ void norm_pass(const NormDesc& d, int wg, int G) {
    const int tid_ = otid(); const int wave = tid_ >> 6, lane = tid_ & 63;
    constexpr int NR = 2;
    for (int row0 = (wg * 8 + wave) * NR; row0 < T; row0 += G * 8 * NR) {
        float v[NR][4][8]; float ss[NR], r[NR], r2[NR];
#pragma unroll
        for (int q = 0; q < NR; ++q) {
            const size_t ro = (size_t)(row0 + q) * DM;
            if (d.mode == 0) {
#pragma unroll
                for (int i = 0; i < 4; ++i) { const int c = (i * 64 + lane) * 8; const f32x4 a = *(const f32x4*)((const float*)d.m + ro + c), b = *(const f32x4*)((const float*)d.m + ro + c + 4);
#pragma unroll
                    for (int e = 0; e < 4; ++e) { v[q][i][e] = a[e]; v[q][i][4 + e] = b[e]; } }
            } else {
#pragma unroll
                for (int i = 0; i < 4; ++i) { const int c = (i * 64 + lane) * 8; const u32x4 a = *(const u32x4*)((const bf16_t*)d.m + ro + c);
                    v[q][i][0] = bflo(a.x); v[q][i][1] = bfhi(a.x); v[q][i][2] = bflo(a.y); v[q][i][3] = bfhi(a.y); v[q][i][4] = bflo(a.z); v[q][i][5] = bfhi(a.z); v[q][i][6] = bflo(a.w); v[q][i][7] = bfhi(a.w); }
            }
        }
#pragma unroll
        for (int q = 0; q < NR; ++q) {
            float s = 0.f;
#pragma unroll
            for (int i = 0; i < 4; ++i)
#pragma unroll
                for (int e = 0; e < 8; ++e) s += v[q][i][e] * v[q][i][e];
            ss[q] = s;
        }
#pragma unroll
        for (int q = 0; q < NR; ++q) { ss[q] = wave_sum(ss[q]); r[q] = rsqrtf(ss[q] * (1.0f / DM) + 1e-6f); r2[q] = r[q]; }
        if (d.mode != 0) {
            float s2[NR];
#pragma unroll
            for (int q = 0; q < NR; ++q) {
                const size_t ro = (size_t)(row0 + q) * DM;
                float s = 0.f;
#pragma unroll
                for (int i = 0; i < 4; ++i) { const int c = (i * 64 + lane) * 8;
                    const f32x4 w0 = *(const f32x4*)(d.wpost + c), w1 = *(const f32x4*)(d.wpost + c + 4);
                    f32x4 h0, h1;
                    if (d.hin_bf16) { const u32x4 hv = *(const u32x4*)((const bf16_t*)d.hres + ro + c); h0[0] = bflo(hv.x); h0[1] = bfhi(hv.x); h0[2] = bflo(hv.y); h0[3] = bfhi(hv.y); h1[0] = bflo(hv.z); h1[1] = bfhi(hv.z); h1[2] = bflo(hv.w); h1[3] = bfhi(hv.w); }
                    else { h0 = *(const f32x4*)((const float*)d.hres + ro + c); h1 = *(const f32x4*)((const float*)d.hres + ro + c + 4); }
                    f32x4 o0, o1;
#pragma unroll
                    for (int e = 0; e < 4; ++e) { o0[e] = h0[e] + v[q][i][e] * r[q] * w0[e]; o1[e] = h1[e] + v[q][i][4 + e] * r[q] * w1[e]; v[q][i][e] = o0[e]; v[q][i][4 + e] = o1[e]; s += o0[e] * o0[e] + o1[e] * o1[e]; }
                    if (d.hout_bf16) { u32x4 hw; hw.x = pk2(o0[0], o0[1]); hw.y = pk2(o0[2], o0[3]); hw.z = pk2(o1[0], o1[1]); hw.w = pk2(o1[2], o1[3]); *(u32x4*)((bf16_t*)d.hout + ro + c) = hw; }
                    else { *(f32x4*)((float*)d.hout + ro + c) = o0; *(f32x4*)((float*)d.hout + ro + c + 4) = o1; } }
                s2[q] = s;
            }
            if (d.mode == 1) {
#pragma unroll
                for (int q = 0; q < NR; ++q) { s2[q] = wave_sum(s2[q]); r2[q] = rsqrtf(s2[q] * (1.0f / DM) + 1e-6f); }
            }
        }
        if (d.mode != 2) {
#pragma unroll
            for (int q = 0; q < NR; ++q) {
                const size_t ro = (size_t)(row0 + q) * DM;
#pragma unroll
                for (int i = 0; i < 4; ++i) { const int c = (i * 64 + lane) * 8;
                    const f32x4 w0 = *(const f32x4*)(d.wpre + c), w1 = *(const f32x4*)(d.wpre + c + 4);
                    u32x4 o; o.x = pk2(v[q][i][0] * r2[q] * w0[0], v[q][i][1] * r2[q] * w0[1]); o.y = pk2(v[q][i][2] * r2[q] * w0[2], v[q][i][3] * r2[q] * w0[3]);
                    o.z = pk2(v[q][i][4] * r2[q] * w1[0], v[q][i][5] * r2[q] * w1[1]); o.w = pk2(v[q][i][6] * r2[q] * w1[2], v[q][i][7] * r2[q] * w1[3]);
                    *(u32x4*)(d.ub + ro + c) = o; }
            }
        }
    }
}

__device__ __forceinline__ void rot_table(float* rot, int wg, int G) {
    for (int e = wg * NTHREADS + otid(); e < SEQ * 128; e += G * NTHREADS) {
        const int pos = e >> 7, jf = e & 127;
        const float inv = exp2f(-(float)jf * (13.287712379549449f / 128.0f));
        const float ang = (float)pos * inv;
        const double a = (double)ang; const double k = rint(a * 0.15915494309189535); const float rf = (float)(a - k * 6.283185307179586);
        f32x2 cs; cs.x = cosf(rf); cs.y = sinf(rf);
        *(f32x2*)(rot + 2 * (size_t)e) = cs;
    }
}

__device__ __forceinline__ void ret_pre(const bf16_t* proj, bf16_t* Pg, LAS unsigned char* lds, int wg, int G) {
    const int tid = otid(), lane = tid & 63, wid = __builtin_amdgcn_readfirstlane(tid >> 6), fr = lane & 15, fq = lane >> 4;
    constexpr int QS = 528;
    LAS unsigned char* Qs = lds; LAS unsigned char* Ks = lds + 33792;
    const int lm = wid >> 1, c2 = wid & 1;
    u32x4 rq[4], rk[4];
    int u = wg;
    if (u < 2048) {
        const bf16_t* qb = proj + (size_t)((u >> 3) * 64) * RIN + (u & 7) * 256;
#pragma unroll
        for (int i = 0; i < 4; ++i) { const int idx = i * 512 + tid, row = idx >> 5, ch = idx & 31; rq[i] = *(const u32x4*)(qb + (size_t)row * RIN + ch * 8); rk[i] = *(const u32x4*)(qb + 2048 + (size_t)row * RIN + ch * 8); }
    }
    for (; u < 2048; u += G) {
        const int h = u & 7, t0 = (u >> 3) * 64;
#pragma unroll
        for (int i = 0; i < 4; ++i) { const int idx = i * 512 + tid, row = idx >> 5, ch = idx & 31; *(LAS u32x4*)(Qs + row * QS + ch * 16) = rq[i]; *(LAS u32x4*)(Ks + row * QS + ch * 16) = rk[i]; }
        LDS_BARRIER();
        const int un = u + G;
        if (un < 2048) {
            const bf16_t* qb = proj + (size_t)((un >> 3) * 64) * RIN + (un & 7) * 256;
#pragma unroll
            for (int i = 0; i < 4; ++i) { const int idx = i * 512 + tid, row = idx >> 5, ch = idx & 31; rq[i] = *(const u32x4*)(qb + (size_t)row * RIN + ch * 8); rk[i] = *(const u32x4*)(qb + 2048 + (size_t)row * RIN + ch * 8); }
        }
        const float lg = log1pf(-exp2f(-5.0f - (float)h));
        f32x4 aP0 = {0.f, 0.f, 0.f, 0.f}, aP1 = {0.f, 0.f, 0.f, 0.f};
#pragma unroll
        for (int ks = 0; ks < 8; ++ks) {
            const bf16x8 a = *(const LAS bf16x8*)(Qs + (lm * 16 + fr) * QS + ks * 64 + fq * 16);
            const bf16x8 b0 = *(const LAS bf16x8*)(Ks + ((c2 * 2 + 0) * 16 + fr) * QS + ks * 64 + fq * 16);
            const bf16x8 b1 = *(const LAS bf16x8*)(Ks + ((c2 * 2 + 1) * 16 + fr) * QS + ks * 64 + fq * 16);
            aP0 = __builtin_amdgcn_mfma_f32_16x16x32_bf16(a, b0, aP0, 0, 0, 0);
            aP1 = __builtin_amdgcn_mfma_f32_16x16x32_bf16(a, b1, aP1, 0, 0, 0);
        }
#pragma unroll
        for (int j = 0; j < 4; ++j) { const int l = lm * 16 + fq * 4 + j;
            const int m0 = (c2 * 2 + 0) * 16 + fr, m1 = m0 + 16;
            const int d0 = l > m0 ? l - m0 : m0 - l, d1 = l > m1 ? l - m1 : m1 - l;
            bf16_t* pp = Pg + ((size_t)(t0 + l) * 8 + h) * 64;
            pp[m0] = (bf16_t)f2bf(aP0[j] * expf((float)d0 * lg));
            pp[m1] = (bf16_t)f2bf(aP1[j] * expf((float)d1 * lg)); }
        LDS_BARRIER();
    }
}

__device__ __forceinline__ void ret_scan(bf16_t* proj, const bf16_t* Pg, LAS unsigned char* lds, int wg, int G) {
    const int tid = otid(), lane = tid & 63, wid = __builtin_amdgcn_readfirstlane(tid >> 6), fr = lane & 15, fq = lane >> 4;
    constexpr int QS = 528, VS = 80, PS = 144;
    LAS unsigned char* Qs = lds; LAS unsigned char* Ks = lds + 33792; LAS unsigned char* Vs = lds + 67584; LAS unsigned char* Vz = lds + 72704;
    LAS unsigned char* Ps = lds + 77824; LAS unsigned char* St0 = lds + 87040;
    const int lm = wid >> 1, c2 = wid & 1;
    for (int unit = wg; unit < 256; unit += G) {
        const int xc = unit & 7, ii = unit >> 3, bh = xc * 2 + (ii >> 4), vs = ii & 15, b = bh >> 3, h = bh & 7;
        const float lg = log1pf(-exp2f(-5.0f - (float)h));
        float xi[4];
#pragma unroll
        for (int j = 0; j < 4; ++j) { const int l = lm * 16 + fq * 4 + j; xi[j] = expf((float)(l + 1) * lg); }
        const float cdecay = expf(64.0f * lg);
        const int vrow = (tid & 255) >> 2, vch = tid & 3;
        const float zeta = expf((float)(63 - vrow) * lg);
        const int prow = tid >> 3, pch = tid & 7;
        f32x4 accS[2][2];
#pragma unroll
        for (int a = 0; a < 2; ++a)
#pragma unroll
            for (int c = 0; c < 2; ++c) accS[a][c] = (f32x4){0.f, 0.f, 0.f, 0.f};
        for (int i = tid; i < 16896 / 4; i += NTHREADS) ((LAS unsigned*)St0)[i] = 0u;
        const bf16_t* qb = proj + (size_t)(b * SEQ) * RIN + h * 256;
        const bf16_t* kb = qb + 2048;
        bf16_t* vb = proj + (size_t)(b * SEQ) * RIN + 4096 + h * 512 + vs * 32;
        const bf16_t* pb = Pg + ((size_t)(b * SEQ + prow) * 8 + h) * 64 + pch * 8;
        u32x4 rq[2][4], rk[2][4], rv[2], rp[2];
#define RET_LOAD(S_, cc_) do { const size_t ro_ = (size_t)(cc_) * 64 * RIN; \
            _Pragma("unroll") for (int i = 0; i < 4; ++i) { const int idx = i * 512 + tid, row = idx >> 5, ch = idx & 31; rq[S_][i] = *(const u32x4*)(qb + ro_ + (size_t)row * RIN + ch * 8); rk[S_][i] = *(const u32x4*)(kb + ro_ + (size_t)row * RIN + ch * 8); } \
            if (tid < 256) rv[S_] = *(const u32x4*)(vb + ro_ + (size_t)vrow * RIN + vch * 8); \
            rp[S_] = *(const u32x4*)(pb + (size_t)(cc_) * 64 * 512); } while (0)
        rv[0] = (u32x4){0u, 0u, 0u, 0u}; rv[1] = rv[0];
        RET_LOAD(0, 0); RET_LOAD(1, 1);
        for (int c0 = 0; c0 < 128; c0 += 2) {
#pragma unroll
          for (int par = 0; par < 2; ++par) {
            const int c = c0 + par;
            LAS unsigned char* Stc = St0 + par * 16896; LAS unsigned char* Stn = St0 + (par ^ 1) * 16896;
#pragma unroll
            for (int i = 0; i < 4; ++i) { const int idx = i * 512 + tid, row = idx >> 5, ch = idx & 31; *(LAS u32x4*)(Qs + row * QS + ch * 16) = rq[par][i]; *(LAS u32x4*)(Ks + row * QS + ch * 16) = rk[par][i]; }
            if (tid < 256) {
                const u32x4 rvv = rv[par];
                *(LAS u32x4*)(Vs + vrow * VS + vch * 16) = rvv;
                u32x4 z; z.x = pk2(bflo(rvv.x) * zeta, bfhi(rvv.x) * zeta); z.y = pk2(bflo(rvv.y) * zeta, bfhi(rvv.y) * zeta);
                z.z = pk2(bflo(rvv.z) * zeta, bfhi(rvv.z) * zeta); z.w = pk2(bflo(rvv.w) * zeta, bfhi(rvv.w) * zeta);
                *(LAS u32x4*)(Vz + vrow * VS + vch * 16) = z;
            }
            *(LAS u32x4*)(Ps + prow * PS + pch * 16) = rp[par];
            LDS_BARRIER();
            if (c + 2 < 128) RET_LOAD(par, c + 2);
            f32x4 aX0 = {0.f, 0.f, 0.f, 0.f}, aX1 = {0.f, 0.f, 0.f, 0.f}, aI = {0.f, 0.f, 0.f, 0.f};
#pragma unroll
            for (int ks = 0; ks < 8; ks += 2) {
                const bf16x8 a0 = *(const LAS bf16x8*)(Qs + (lm * 16 + fr) * QS + ks * 64 + fq * 16);
                const bf16x8 s0 = *(const LAS bf16x8*)(Stc + (c2 * 16 + fr) * QS + ks * 64 + fq * 16);
                const bf16x8 a1 = *(const LAS bf16x8*)(Qs + (lm * 16 + fr) * QS + (ks + 1) * 64 + fq * 16);
                const bf16x8 s1 = *(const LAS bf16x8*)(Stc + (c2 * 16 + fr) * QS + (ks + 1) * 64 + fq * 16);
                aX0 = __builtin_amdgcn_mfma_f32_16x16x32_bf16(a0, s0, aX0, 0, 0, 0);
                aX1 = __builtin_amdgcn_mfma_f32_16x16x32_bf16(a1, s1, aX1, 0, 0, 0);
            }
#pragma unroll
            for (int ks = 0; ks < 2; ++ks) {
                const bf16x8 a = *(const LAS bf16x8*)(Ps + (lm * 16 + fr) * PS + ks * 64 + fq * 16);
                const bf16x8 bv = tr_frag(Vs, VS, ks * 32, c2 * 16, lane);
                aI = __builtin_amdgcn_mfma_f32_16x16x32_bf16(a, bv, aI, 0, 0, 0);
            }
            {
                bf16_t* ob = vb + (size_t)(c * 64) * RIN + c2 * 16 + fr;
#pragma unroll
                for (int j = 0; j < 4; ++j) { const int l = lm * 16 + fq * 4 + j; ob[(size_t)l * RIN] = (bf16_t)f2bf(aI[j] + (aX0[j] + aX1[j]) * xi[j]); }
            }
#pragma unroll
            for (int a = 0; a < 2; ++a)
#pragma unroll
                for (int cc = 0; cc < 2; ++cc) accS[a][cc] *= cdecay;
#pragma unroll
            for (int ks = 0; ks < 2; ++ks) {
                const bf16x8 ad0 = tr_frag(Ks, QS, ks * 32, (wid * 2 + 0) * 16, lane);
                const bf16x8 ad1 = tr_frag(Ks, QS, ks * 32, (wid * 2 + 1) * 16, lane);
                const bf16x8 bv0 = tr_frag(Vz, VS, ks * 32, 0, lane);
                const bf16x8 bv1 = tr_frag(Vz, VS, ks * 32, 16, lane);
                accS[0][0] = __builtin_amdgcn_mfma_f32_16x16x32_bf16(ad0, bv0, accS[0][0], 0, 0, 0);
                accS[0][1] = __builtin_amdgcn_mfma_f32_16x16x32_bf16(ad0, bv1, accS[0][1], 0, 0, 0);
                accS[1][0] = __builtin_amdgcn_mfma_f32_16x16x32_bf16(ad1, bv0, accS[1][0], 0, 0, 0);
                accS[1][1] = __builtin_amdgcn_mfma_f32_16x16x32_bf16(ad1, bv1, accS[1][1], 0, 0, 0);
            }
#pragma unroll
            for (int a = 0; a < 2; ++a)
#pragma unroll
                for (int cc = 0; cc < 2; ++cc) {
                    u32x2 w; w.x = pk2(accS[a][cc][0], accS[a][cc][1]); w.y = pk2(accS[a][cc][2], accS[a][cc][3]);
                    *(LAS u32x2*)(Stn + (cc * 16 + fr) * QS + ((wid * 2 + a) * 16 + fq * 4) * 2) = w;
                }
            LDS_BARRIER();
          }
        }
#undef RET_LOAD
    }
}

__device__ __forceinline__ void ret_gn(bf16_t* proj, const float* gnw, int wg, int G) {
    const int tid_ = otid(); const int wave = tid_ >> 6, lane = tid_ & 63;
    constexpr int NP = 4;
    for (int pair0 = (wg * 8 + wave) * NP; pair0 < T * 8; pair0 += G * 8 * NP) {
        u32x4 ov[NP], gv[NP];
#pragma unroll
        for (int q = 0; q < NP; ++q) { const int pair = pair0 + q, t = pair >> 3, h = pair & 7;
            const bf16_t* op = proj + (size_t)t * RIN + 4096 + h * 512 + lane * 8; ov[q] = *(const u32x4*)op; gv[q] = *(const u32x4*)(op + 4096); }
#pragma unroll
        for (int q = 0; q < NP; ++q) { const int pair = pair0 + q, t = pair >> 3, h = pair & 7;
            bf16_t* gp = proj + (size_t)t * RIN + 8192 + h * 512 + lane * 8;
            float o[8] = {bflo(ov[q].x), bfhi(ov[q].x), bflo(ov[q].y), bfhi(ov[q].y), bflo(ov[q].z), bfhi(ov[q].z), bflo(ov[q].w), bfhi(ov[q].w)};
            float g[8] = {bflo(gv[q].x), bfhi(gv[q].x), bflo(gv[q].y), bfhi(gv[q].y), bflo(gv[q].z), bfhi(gv[q].z), bflo(gv[q].w), bfhi(gv[q].w)};
            float s = 0.f;
#pragma unroll
            for (int e = 0; e < 8; ++e) s += o[e];
            const float mu = wave_sum(s) * (1.0f / 512.0f);
            float qq = 0.f;
#pragma unroll
            for (int e = 0; e < 8; ++e) { o[e] -= mu; qq += o[e] * o[e]; }
            const float rstd = rsqrtf(wave_sum(qq) * (1.0f / 512.0f) + 1e-5f);
            const f32x4 w0 = *(const f32x4*)(gnw + h * 512 + lane * 8), w1 = *(const f32x4*)(gnw + h * 512 + lane * 8 + 4);
            float y[8];
#pragma unroll
            for (int e = 0; e < 8; ++e) y[e] = silu(g[e]) * (o[e] * rstd) * (e < 4 ? w0[e & 3] : w1[e & 3]);
            u32x4 w; w.x = pk2(y[0], y[1]); w.y = pk2(y[2], y[3]); w.z = pk2(y[4], y[5]); w.w = pk2(y[6], y[7]);
            *(u32x4*)gp = w; }
    }
}

__device__ __forceinline__ void ssd_pre(const bf16_t* proj, bf16_t* halo, float* dtv, float* acv, const float* dt_bias, const float* a_log, int wg, int G) {
    const int tid = otid();
    const int gt = wg * NTHREADS + tid, gs = G * NTHREADS;
    for (int e = gt; e < 256 * 3 * 768; e += gs) {
        const int oc = e % 768, r = (e / 768) % 3, ck = e / (768 * 3);
        const u32x4 v = *(const u32x4*)(proj + (size_t)(ck * 64 + 61 + r) * SINP + 4096 + oc * 8);
        *(u32x4*)(halo + ((size_t)ck * 3 + r) * 6144 + oc * 8) = v;
    }
    const int wave = tid >> 6, lane = tid & 63;
    for (int task = wg * 8 + wave; task < 256 * 64; task += G * 8) {
        const int ck = task >> 6, hd = task & 63;
        const float x = bf2f(proj[(size_t)(ck * 64 + lane) * SINP + 10240 + hd]) + dt_bias[hd];
        const float dt = x > 20.f ? x : log1pf(expf(x));
        float sa = dt * (-expf(a_log[hd]));
#pragma unroll
        for (int o = 1; o < 64; o <<= 1) { const float tt = __shfl_up(sa, o); if (lane >= o) sa += tt; }
        dtv[(size_t)task * 64 + lane] = dt; acv[(size_t)task * 64 + lane] = sa;
    }
}
__device__ __forceinline__ void ssd_conv(bf16_t* proj, const bf16_t* halo, const float* cw, const float* cb, int wg, int G) {
    const int gt = wg * NTHREADS + otid(), gs = G * NTHREADS;
    for (int e = gt; e < 256 * 768; e += gs) {
        const int oc = e % 768, ck = e / 768, col = oc * 8;
        float w[4][8], bias[8];
#pragma unroll
        for (int tp = 0; tp < 4; ++tp) { const f32x4 a = *(const f32x4*)(cw + tp * 6144 + col), b = *(const f32x4*)(cw + tp * 6144 + col + 4);
#pragma unroll
            for (int i = 0; i < 4; ++i) { w[tp][i] = a[i]; w[tp][4 + i] = b[i]; } }
        { const f32x4 a = *(const f32x4*)(cb + col), b = *(const f32x4*)(cb + col + 4);
#pragma unroll
            for (int i = 0; i < 4; ++i) { bias[i] = a[i]; bias[4 + i] = b[i]; } }
        float p3[8], p2[8], p1[8];
        if ((ck & 127) == 0) {
#pragma unroll
            for (int i = 0; i < 8; ++i) { p3[i] = 0.f; p2[i] = 0.f; p1[i] = 0.f; }
        } else {
            const bf16_t* hp = halo + ((size_t)(ck - 1) * 3) * 6144 + col;
            const u32x4 a = *(const u32x4*)hp, b = *(const u32x4*)(hp + 6144), c = *(const u32x4*)(hp + 2 * 6144);
            p3[0] = bflo(a.x); p3[1] = bfhi(a.x); p3[2] = bflo(a.y); p3[3] = bfhi(a.y); p3[4] = bflo(a.z); p3[5] = bfhi(a.z); p3[6] = bflo(a.w); p3[7] = bfhi(a.w);
            p2[0] = bflo(b.x); p2[1] = bfhi(b.x); p2[2] = bflo(b.y); p2[3] = bfhi(b.y); p2[4] = bflo(b.z); p2[5] = bfhi(b.z); p2[6] = bflo(b.w); p2[7] = bfhi(b.w);
            p1[0] = bflo(c.x); p1[1] = bfhi(c.x); p1[2] = bflo(c.y); p1[3] = bfhi(c.y); p1[4] = bflo(c.z); p1[5] = bfhi(c.z); p1[6] = bflo(c.w); p1[7] = bfhi(c.w);
        }
        bf16_t* rp = proj + (size_t)(ck * 64) * SINP + 4096 + col;
        for (int r8 = 0; r8 < 64; r8 += 8) {
          u32x4 xvv[8];
#pragma unroll
          for (int rr = 0; rr < 8; ++rr) xvv[rr] = *(const u32x4*)(rp + (size_t)(r8 + rr) * SINP);
#pragma unroll
          for (int rr = 0; rr < 8; ++rr) {
            const int r = r8 + rr; const u32x4 xv = xvv[rr];
            float x[8] = {bflo(xv.x), bfhi(xv.x), bflo(xv.y), bfhi(xv.y), bflo(xv.z), bfhi(xv.z), bflo(xv.w), bfhi(xv.w)};
            float y[8];
#pragma unroll
            for (int i = 0; i < 8; ++i) { const float s = bias[i] + w[0][i] * p3[i] + w[1][i] * p2[i] + w[2][i] * p1[i] + w[3][i] * x[i]; y[i] = silu(s); p3[i] = p2[i]; p2[i] = p1[i]; p1[i] = x[i]; }
            u32x4 o; o.x = pk2(y[0], y[1]); o.y = pk2(y[2], y[3]); o.z = pk2(y[4], y[5]); o.w = pk2(y[6], y[7]);
            *(u32x4*)(rp + (size_t)r * SINP) = o;
          }
        }
    }
}

__device__ __forceinline__ void ssd_cb(const bf16_t* proj, bf16_t* CBg, LAS unsigned char* lds, int wg, int G) {
    const int tid = otid(), lane = tid & 63, wid = __builtin_amdgcn_readfirstlane(tid >> 6), fr = lane & 15, fq = lane >> 4;
    constexpr int CS = 272;
    LAS unsigned char* Cs = lds; LAS unsigned char* Bs = lds + 17408;
    const int lm = wid >> 1, c2 = wid & 1;
    u32x4 rc[2], rb[2];
    int u = wg;
    if (u < 2048) {
        const bf16_t* bb = proj + (size_t)((u >> 3) * 64) * SINP + 8192 + (u & 7) * 128;
#pragma unroll
        for (int i = 0; i < 2; ++i) { const int idx = i * 512 + tid, row = idx >> 4, ch = idx & 15; rb[i] = *(const u32x4*)(bb + (size_t)row * SINP + ch * 8); rc[i] = *(const u32x4*)(bb + 1024 + (size_t)row * SINP + ch * 8); }
    }
    for (; u < 2048; u += G) {
        const int g = u & 7, t0 = (u >> 3) * 64;
#pragma unroll
        for (int i = 0; i < 2; ++i) { const int idx = i * 512 + tid, row = idx >> 4, ch = idx & 15; *(LAS u32x4*)(Cs + row * CS + ch * 16) = rc[i]; *(LAS u32x4*)(Bs + row * CS + ch * 16) = rb[i]; }
        LDS_BARRIER();
        const int un = u + G;
        if (un < 2048) {
            const bf16_t* bb = proj + (size_t)((un >> 3) * 64) * SINP + 8192 + (un & 7) * 128;
#pragma unroll
            for (int i = 0; i < 2; ++i) { const int idx = i * 512 + tid, row = idx >> 4, ch = idx & 15; rb[i] = *(const u32x4*)(bb + (size_t)row * SINP + ch * 8); rc[i] = *(const u32x4*)(bb + 1024 + (size_t)row * SINP + ch * 8); }
        }
        f32x4 aW0 = {0.f, 0.f, 0.f, 0.f}, aW1 = {0.f, 0.f, 0.f, 0.f};
#pragma unroll
        for (int ks = 0; ks < 4; ++ks) {
            const bf16x8 a = *(const LAS bf16x8*)(Cs + (lm * 16 + fr) * CS + ks * 64 + fq * 16);
            const bf16x8 b0 = *(const LAS bf16x8*)(Bs + ((c2 * 2 + 0) * 16 + fr) * CS + ks * 64 + fq * 16);
            const bf16x8 b1 = *(const LAS bf16x8*)(Bs + ((c2 * 2 + 1) * 16 + fr) * CS + ks * 64 + fq * 16);
            aW0 = __builtin_amdgcn_mfma_f32_16x16x32_bf16(a, b0, aW0, 0, 0, 0);
            aW1 = __builtin_amdgcn_mfma_f32_16x16x32_bf16(a, b1, aW1, 0, 0, 0);
        }
#pragma unroll
        for (int j = 0; j < 4; ++j) { const int l = lm * 16 + fq * 4 + j;
            bf16_t* pp = CBg + ((size_t)(t0 + l) * 8 + g) * 64 + (c2 * 2) * 16 + fr;
            pp[0] = (bf16_t)f2bf(aW0[j]); pp[16] = (bf16_t)f2bf(aW1[j]); }
        LDS_BARRIER();
    }
}

__device__ __forceinline__ void ssd_scan(bf16_t* proj, const bf16_t* CBg, const float* dtv, const float* acv, const float* d_skip, LAS unsigned char* lds, int wg, int G) {
    const int tid = otid(), lane = tid & 63, wid = __builtin_amdgcn_readfirstlane(tid >> 6), fr = lane & 15, fq = lane >> 4;
    constexpr int CS = 272, XS = 80, WS = 144;
    LAS unsigned char* Cs = lds; LAS unsigned char* Bs = lds + 17408; LAS unsigned char* Xs = lds + 34816; LAS unsigned char* Xw = lds + 39936; LAS unsigned char* Zs = lds + 45056;
    LAS unsigned char* Ws = lds + 50176; LAS unsigned char* Sts0 = lds + 59392; LAS float* acum = (LAS float*)(lds + 76800);
    const int lm = wid >> 1, c2 = wid & 1;
    for (int unit = wg; unit < 256; unit += G) {
        const int grp = unit & 7, ii = unit >> 3, b = ii >> 4, hd = grp * 8 + ((ii & 15) >> 1), ph = ii & 1;
        const float dsk = d_skip[hd];
        f32x4 accT[2];
        accT[0] = (f32x4){0.f, 0.f, 0.f, 0.f}; accT[1] = (f32x4){0.f, 0.f, 0.f, 0.f};
        for (int i = tid; i < 8704 / 4; i += NTHREADS) ((LAS unsigned*)Sts0)[i] = 0u;
        const bf16_t* base = proj + (size_t)(b * SEQ) * SINP;
        const bf16_t* bb = base + 8192 + grp * 128;
        const bf16_t* cbp = base + 9216 + grp * 128;
        bf16_t* xb = (bf16_t*)base + 4096 + hd * 64 + ph * 32;
        const bf16_t* zb = base + hd * 64 + ph * 32;
        const int xrow = (tid & 255) >> 2, xch = tid & 3;
        const int wrow = tid >> 3, ws0 = (tid & 7) * 8;
        const bf16_t* cgp = CBg + ((size_t)(b * SEQ + wrow) * 8 + grp) * 64 + ws0;
        const float* dtp = dtv + ((size_t)(b * 128) * 64 + hd) * 64;
        const float* acp = acv + ((size_t)(b * 128) * 64 + hd) * 64;
        u32x4 rc[2][2], rb[2][2], rxz[2], rcb[2]; f32x4 rds[2][2], ras[2][2]; float ral[2], rax[2], rdx[2], rat[2], ra0[2] = {0.f, 0.f};
#define SSD_PREFETCH(S_, cc_) do { const size_t ro_ = (size_t)(cc_) * 64 * SINP; \
            _Pragma("unroll") for (int i = 0; i < 2; ++i) { const int idx = i * 512 + tid, row = idx >> 4, ch = idx & 15; rc[S_][i] = *(const u32x4*)(cbp + ro_ + (size_t)row * SINP + ch * 8); rb[S_][i] = *(const u32x4*)(bb + ro_ + (size_t)row * SINP + ch * 8); } \
            rxz[S_] = *(const u32x4*)((tid < 256 ? (const bf16_t*)xb : zb) + ro_ + (size_t)xrow * SINP + xch * 8); \
            rcb[S_] = *(const u32x4*)(cgp + (size_t)(cc_) * 64 * 512); \
            const float* d_ = dtp + (size_t)(cc_) * 4096; const float* a_ = acp + (size_t)(cc_) * 4096; \
            rds[S_][0] = *(const f32x4*)(d_ + ws0); rds[S_][1] = *(const f32x4*)(d_ + ws0 + 4); ras[S_][0] = *(const f32x4*)(a_ + ws0); ras[S_][1] = *(const f32x4*)(a_ + ws0 + 4); \
            ral[S_] = a_[wrow]; rax[S_] = a_[xrow]; rdx[S_] = d_[xrow]; rat[S_] = a_[63]; if (tid < 64) ra0[S_] = a_[tid]; } while (0)
        SSD_PREFETCH(0, 0); SSD_PREFETCH(1, 1);
        for (int c0 = 0; c0 < 128; c0 += 2) {
#pragma unroll
          for (int par = 0; par < 2; ++par) {
            const int c = c0 + par;
            LAS unsigned char* Stc = Sts0 + par * 8704; LAS unsigned char* Stn = Sts0 + (par ^ 1) * 8704;
#pragma unroll
            for (int i = 0; i < 2; ++i) { const int idx = i * 512 + tid, row = idx >> 4, ch = idx & 15; *(LAS u32x4*)(Cs + row * CS + ch * 16) = rc[par][i]; *(LAS u32x4*)(Bs + row * CS + ch * 16) = rb[par][i]; }
            const u32x4 rxv = rxz[par];
            *(LAS u32x4*)((tid < 256 ? Xs : Zs) + xrow * XS + xch * 16) = rxv;
            if (tid < 256) {
                const float f = rdx[par] * expf(rat[par] - rax[par]);
                u32x4 z; z.x = pk2(bflo(rxv.x) * f, bfhi(rxv.x) * f); z.y = pk2(bflo(rxv.y) * f, bfhi(rxv.y) * f); z.z = pk2(bflo(rxv.z) * f, bfhi(rxv.z) * f); z.w = pk2(bflo(rxv.w) * f, bfhi(rxv.w) * f);
                *(LAS u32x4*)(Xw + xrow * XS + xch * 16) = z;
            }
            {
                const u32x4 rcv = rcb[par];
                const float cv[8] = {bflo(rcv.x), bfhi(rcv.x), bflo(rcv.y), bfhi(rcv.y), bflo(rcv.z), bfhi(rcv.z), bflo(rcv.w), bfhi(rcv.w)};
                float wv[8];
#pragma unroll
                for (int e = 0; e < 8; ++e) { const float as = e < 4 ? ras[par][0][e & 3] : ras[par][1][e & 3], ds = e < 4 ? rds[par][0][e & 3] : rds[par][1][e & 3];
                    wv[e] = (wrow >= ws0 + e) ? cv[e] * expf(ral[par] - as) * ds : 0.f; }
                u32x4 w; w.x = pk2(wv[0], wv[1]); w.y = pk2(wv[2], wv[3]); w.z = pk2(wv[4], wv[5]); w.w = pk2(wv[6], wv[7]);
                *(LAS u32x4*)(Ws + wrow * WS + ws0 * 2) = w;
            }
            if (tid < 64) acum[tid] = ra0[par];
            LDS_BARRIER();
            if (c + 2 < 128) SSD_PREFETCH(par, c + 2);
            const float atot = acum[63];
            float al[4];
#pragma unroll
            for (int j = 0; j < 4; ++j) al[j] = acum[lm * 16 + fq * 4 + j];
            f32x4 aY0 = {0.f, 0.f, 0.f, 0.f}, aY1 = {0.f, 0.f, 0.f, 0.f}, aD = {0.f, 0.f, 0.f, 0.f};
#pragma unroll
            for (int ks = 0; ks < 4; ks += 2) {
                const bf16x8 a0 = *(const LAS bf16x8*)(Cs + (lm * 16 + fr) * CS + ks * 64 + fq * 16);
                const bf16x8 s0 = *(const LAS bf16x8*)(Stc + (c2 * 16 + fr) * CS + ks * 64 + fq * 16);
                const bf16x8 a1 = *(const LAS bf16x8*)(Cs + (lm * 16 + fr) * CS + (ks + 1) * 64 + fq * 16);
                const bf16x8 s1 = *(const LAS bf16x8*)(Stc + (c2 * 16 + fr) * CS + (ks + 1) * 64 + fq * 16);
                aY0 = __builtin_amdgcn_mfma_f32_16x16x32_bf16(a0, s0, aY0, 0, 0, 0);
                aY1 = __builtin_amdgcn_mfma_f32_16x16x32_bf16(a1, s1, aY1, 0, 0, 0);
            }
#pragma unroll
            for (int ks = 0; ks < 2; ++ks) {
                const bf16x8 a = *(const LAS bf16x8*)(Ws + (lm * 16 + fr) * WS + ks * 64 + fq * 16);
                const bf16x8 bx = tr_frag(Xs, XS, ks * 32, c2 * 16, lane);
                aD = __builtin_amdgcn_mfma_f32_16x16x32_bf16(a, bx, aD, 0, 0, 0);
            }
            {
                const int pc = c2 * 16 + fr;
                bf16_t* ob = xb + (size_t)(c * 64) * SINP + pc;
#pragma unroll
                for (int j = 0; j < 4; ++j) { const int l = lm * 16 + fq * 4 + j;
                    const float xv = bf2f(*(const LAS bf16_t*)(Xs + l * XS + pc * 2)), zv = bf2f(*(const LAS bf16_t*)(Zs + l * XS + pc * 2));
                    const float y = aD[j] + (aY0[j] + aY1[j]) * expf(al[j]) + dsk * xv;
                    ob[(size_t)l * SINP] = (bf16_t)f2bf(y * silu(zv)); }
            }
            const float sdec = expf(atot);
            accT[0] *= sdec; accT[1] *= sdec;
#pragma unroll
            for (int ks = 0; ks < 2; ++ks) {
                const bf16x8 an_ = tr_frag(Bs, CS, ks * 32, wid * 16, lane);
                const bf16x8 bp0 = tr_frag(Xw, XS, ks * 32, 0, lane);
                const bf16x8 bp1 = tr_frag(Xw, XS, ks * 32, 16, lane);
                accT[0] = __builtin_amdgcn_mfma_f32_16x16x32_bf16(an_, bp0, accT[0], 0, 0, 0);
                accT[1] = __builtin_amdgcn_mfma_f32_16x16x32_bf16(an_, bp1, accT[1], 0, 0, 0);
            }
#pragma unroll
            for (int pi = 0; pi < 2; ++pi) {
                u32x2 w; w.x = pk2(accT[pi][0], accT[pi][1]); w.y = pk2(accT[pi][2], accT[pi][3]);
                *(LAS u32x2*)(Stn + (pi * 16 + fr) * CS + (wid * 16 + fq * 4) * 2) = w;
            }
            LDS_BARRIER();
          }
        }
#undef SSD_PREFETCH
    }
}

__device__ __forceinline__ void ssd_norm(bf16_t* proj, const float* nw, int wg, int G) {
    const int tid_ = otid(); const int wave = tid_ >> 6, lane = tid_ & 63;
    constexpr int NP = 4;
    for (int pair0 = (wg * 8 + wave) * NP; pair0 < T * 8; pair0 += G * 8 * NP) {
        u32x4 yv[NP];
#pragma unroll
        for (int q = 0; q < NP; ++q) { const int pair = pair0 + q, t = pair >> 3, gr = pair & 7; yv[q] = *(const u32x4*)(proj + (size_t)t * SINP + 4096 + gr * 512 + lane * 8); }
#pragma unroll
        for (int q = 0; q < NP; ++q) { const int pair = pair0 + q, t = pair >> 3, gr = pair & 7;
            bf16_t* yp = proj + (size_t)t * SINP + 4096 + gr * 512 + lane * 8;
            float y[8] = {bflo(yv[q].x), bfhi(yv[q].x), bflo(yv[q].y), bfhi(yv[q].y), bflo(yv[q].z), bfhi(yv[q].z), bflo(yv[q].w), bfhi(yv[q].w)};
            float qq = 0.f;
#pragma unroll
            for (int e = 0; e < 8; ++e) qq += y[e] * y[e];
            const float r = rsqrtf(wave_sum(qq) * (1.0f / 512.0f) + 1e-6f);
            const f32x4 w0 = *(const f32x4*)(nw + gr * 512 + lane * 8), w1 = *(const f32x4*)(nw + gr * 512 + lane * 8 + 4);
            u32x4 w; w.x = pk2(y[0] * r * w0[0], y[1] * r * w0[1]); w.y = pk2(y[2] * r * w0[2], y[3] * r * w0[3]);
            w.z = pk2(y[4] * r * w1[0], y[5] * r * w1[1]); w.w = pk2(y[6] * r * w1[2], y[7] * r * w1[3]);
            *(u32x4*)yp = w; }
    }
}

#define XB_TMO      128
#define XB_XCNT(j)  (256  + 64 * (j))
#define XB_XSUB(j)  (1280 + 64 * (j))
#define XB_XGEN(j)  (2304 + 64 * (j))
#define XB_TOP      3328
#define XB_TOPGEN   3392
#define XCD_BAR_WORDS 3456
#define XB_SPIN_CAP (1u << 18)
__device__ __forceinline__ unsigned xb_ld(unsigned* p)              { return __hip_atomic_load(p, __ATOMIC_RELAXED, __HIP_MEMORY_SCOPE_AGENT); }
__device__ __forceinline__ unsigned xb_add(unsigned* p, unsigned v) { return __hip_atomic_fetch_add(p, v, __ATOMIC_RELAXED, __HIP_MEMORY_SCOPE_AGENT); }
__device__ __forceinline__ unsigned xb_xcc_id() { return (unsigned)__builtin_amdgcn_s_getreg((3 << 11) | 20) & 0xFu; }
#define XB_SPIN(cond, bar) do { unsigned _sp = 0; while (cond) { __builtin_amdgcn_s_sleep(1); \
    if ((++_sp & 255u) == 0u) { if (xb_ld(&(bar)[XB_TMO])) break; if (_sp > XB_SPIN_CAP) { atomicAdd(&(bar)[XB_TMO], 1u); break; } } } } while (0)
struct XcdBarrier { unsigned* bar; unsigned x; volatile LAS unsigned* st; };
__device__ __forceinline__ XcdBarrier xcd_barrier_post(unsigned* bar, volatile LAS unsigned* st) {
    XcdBarrier b; b.bar = bar; b.x = xb_xcc_id(); b.st = st;
    if (threadIdx.x == 0) (void)xb_add(&bar[XB_XCNT(b.x)], 1u);
    return b;
}
__device__ __forceinline__ void xcd_barrier_complete(unsigned* bar, unsigned x, unsigned& nloc, unsigned& nx) {
    const unsigned G = gridDim.x * gridDim.y * gridDim.z;
    unsigned sum, cnt, mine, sp = 0u;
    for (;;) {
        sum = 0u; cnt = 0u; mine = 0u;
#pragma unroll
        for (unsigned j = 0; j < 16; ++j) { const unsigned c = xb_ld(&bar[XB_XCNT(j)]); sum += c; cnt += (c > 0u) ? 1u : 0u; mine = (j == x) ? c : mine; }
        if (sum == G) break;
        __builtin_amdgcn_s_sleep(1);
        if ((++sp & 255u) == 0u) { if (xb_ld(&bar[XB_TMO])) break; if (sp > XB_SPIN_CAP) { atomicAdd(&bar[XB_TMO], 1u); break; } }
    }
    nloc = mine > 0u ? mine : 1u; nx = cnt > 0u ? cnt : 1u;
}
__device__ __forceinline__ void xcd_barrier(const XcdBarrier& b) {
    asm volatile("s_waitcnt vmcnt(0)" ::: "memory");
    __syncthreads();
    if (threadIdx.x == 0) {
        unsigned* bar = b.bar;
        __builtin_amdgcn_s_waitcnt(0);
        unsigned nloc = b.st[0], nx = b.st[1];
        if (nloc == 0u) { xcd_barrier_complete(bar, b.x, nloc, nx); b.st[0] = nloc; b.st[1] = nx; }
        const unsigned old = xb_add(&bar[XB_XSUB(b.x)], 1u);
        const unsigned gen = old / nloc;
        if (old + 1u == (gen + 1u) * nloc) {
            __builtin_amdgcn_fence(__ATOMIC_RELEASE, "agent");
            asm volatile("s_waitcnt vmcnt(0)" ::: "memory");
            const unsigned og = xb_add(&bar[XB_TOP], 1u);
            const unsigned tg = og / nx;
            if (og + 1u == (tg + 1u) * nx) xb_add(&bar[XB_TOPGEN], 1u);
            else XB_SPIN(xb_ld(&bar[XB_TOPGEN]) == tg, bar);
            __builtin_amdgcn_fence(__ATOMIC_ACQUIRE, "agent");
            xb_add(&bar[XB_XGEN(b.x)], 1u);
            asm volatile("s_waitcnt vmcnt(0)" ::: "memory");
        } else {
            XB_SPIN(xb_ld(&bar[XB_XGEN(b.x)]) == gen, bar);
            __builtin_amdgcn_fence(__ATOMIC_ACQUIRE, "agent");
            asm volatile("s_waitcnt vmcnt(0)" ::: "memory");
        }
    }
    __syncthreads();
}

struct Params {
    const float* x; const float* nmp; const float* nmq; const float* nfp; const float* nfq;
    const float* ret_w_in; const float* ret_gn_w; const float* ret_w_out;
    const float* ssd_w_in; const float* conv_w; const float* conv_b; const float* dt_bias; const float* a_log; const float* d_skip; const float* ssd_norm_w; const float* ssd_w_out;
    const float* w_up; const float* w_down;
    float* out; unsigned char* ws;
};


__global__ void __launch_bounds__(NTHREADS, 2) mega(Params p) {
    extern __shared__ __attribute__((aligned(16))) unsigned char lds_raw[];
    LAS unsigned char* lds = (LAS unsigned char*)lds_raw;
    cg::grid_group grid = cg::this_grid();
    const int G = gridDim.x, wg = blockIdx.x;
    bf16_t* WA = (bf16_t*)(p.ws + OFF_WA); bf16_t* WB = (bf16_t*)(p.ws + OFF_WB);
    bf16_t* ACT = (bf16_t*)(p.ws + OFF_ACT); bf16_t* U_ACT = (bf16_t*)(p.ws + OFF_ACT + HID_BYTES); bf16_t* F_ACT = (bf16_t*)(p.ws + OFF_ACT + HID_BYTES);
    bf16_t* U_R2 = (bf16_t*)(p.ws + OFF_R2); bf16_t* MF_R2 = (bf16_t*)(p.ws + OFF_R2);
    float* ROT = (float*)(p.ws + OFF_ROT); bf16_t* HALO = (bf16_t*)(p.ws + OFF_HALO); float* DTV = (float*)(p.ws + OFF_DTV); float* ACV = (float*)(p.ws + OFF_ACV); bf16_t* CBG = (bf16_t*)(p.ws + OFF_CBG); bf16_t* PG = (bf16_t*)p.out; bf16_t* HB1 = (bf16_t*)p.out; bf16_t* HB2 = (bf16_t*)(p.ws + OFF_ACT + HID_BYTES + 67108864);

#define GEMM(KIND, ...) do { const pg8::Gemm gd = pg8::Gemm{__VA_ARGS__}; pg8::StaticOrder S; S.init(gd.M, gd.N, G, wg); pg8::gemm_phase<KIND>(lds, gd, S); GSYNC(); } while (0)
    unsigned* barw = (unsigned*)(p.ws + OFF_BAR);
    volatile LAS unsigned* bst = (volatile LAS unsigned*)(lds + LDS_STAGE);
    if (wg == 0) for (int i = threadIdx.x; i < XCD_BAR_WORDS; i += NTHREADS) barw[i] = 0u;
    if (threadIdx.x < 2) bst[threadIdx.x] = 0u;
    norm_pass(NormDesc{0, p.x, nullptr, nullptr, nullptr, p.nmp, U_R2, 0, 0}, wg, G);
    convert_w(ConvDesc{p.ret_w_in, WA, 2048, RIN, RIN, 1}, lds, wg, G);
    convert_w(ConvDesc{p.ret_w_out, WB, 4096, 2048, 2048, 0}, lds, wg, G);
    rot_table(ROT, wg, G);
    grid.sync();
    const XcdBarrier xb = xcd_barrier_post(barw, bst);
#define GSYNC() xcd_barrier(xb)
    GEMM(3, U_R2, WA, T, RIN, 2048, 2048, 3, ACT, RIN, ROT);
    ret_pre(ACT, PG, lds, wg, G); GSYNC();
    ret_scan(ACT, PG, lds, wg, G); GSYNC();
    ret_gn(ACT, p.ret_gn_w, wg, G); GSYNC();
    GEMM(1, ACT + 8192, WB, T, 2048, 4096, RIN, 1, MF_R2, 2048, nullptr);
    norm_pass(NormDesc{1, MF_R2, p.x, HB1, p.nmq, p.nfp, U_ACT, 0, 1}, wg, G);
    convert_w(ConvDesc{p.w_up, WA, 2048, DFF, DFF, 0}, lds, wg, G);
    convert_w(ConvDesc{p.w_down, WB, DFF, 2048, 2048, 0}, lds, wg, G);
    GSYNC();
    GEMM(2, U_ACT, WA, T, DFF, 2048, 2048, 2, ACT, DFF, nullptr);
    GEMM(1, ACT, WB, T, 2048, DFF, DFF, 1, F_ACT, 2048, nullptr);
    norm_pass(NormDesc{1, F_ACT, HB1, HB1, p.nfq, p.nmp + DM, U_R2, 1, 1}, wg, G);
    convert_w(ConvDesc{p.ssd_w_in, WA, 2048, SIN, SINP, 0}, lds, wg, G);
    convert_w(ConvDesc{p.ssd_w_out, WB, 4096, 2048, 2048, 0}, lds, wg, G);
    GSYNC();
    GEMM(1, U_R2, WA, T, SINP, 2048, 2048, 1, ACT, SINP, nullptr);
    ssd_pre(ACT, HALO, DTV, ACV, p.dt_bias, p.a_log, wg, G); GSYNC();
    ssd_conv(ACT, HALO, p.conv_w, p.conv_b, wg, G); GSYNC();
    ssd_cb(ACT, CBG, lds, wg, G); GSYNC();
    ssd_scan(ACT, CBG, DTV, ACV, p.d_skip, lds, wg, G); GSYNC();
    ssd_norm(ACT, p.ssd_norm_w, wg, G); GSYNC();
    GEMM(1, ACT + 4096, WB, T, 2048, 4096, SINP, 1, MF_R2, 2048, nullptr);
    norm_pass(NormDesc{1, MF_R2, HB1, HB2, p.nmq + DM, p.nfp + DM, U_ACT, 1, 1}, wg, G);
    convert_w(ConvDesc{p.w_up + (size_t)2048 * DFF, WA, 2048, DFF, DFF, 0}, lds, wg, G);
    convert_w(ConvDesc{p.w_down + (size_t)DFF * 2048, WB, DFF, 2048, 2048, 0}, lds, wg, G);
    GSYNC();
    GEMM(2, U_ACT, WA, T, DFF, 2048, 2048, 2, ACT, DFF, nullptr);
    GEMM(1, ACT, WB, T, 2048, DFF, DFF, 1, F_ACT, 2048, nullptr);
    norm_pass(NormDesc{2, F_ACT, HB2, p.out, p.nfq + DM, nullptr, nullptr, 1, 0}, wg, G);
#undef GEMM
#undef GSYNC
}

extern "C" void kernel_launch(void* const* d_in, const int* in_sizes, int n_in, void* d_out, int out_size, void* d_ws, size_t ws_size, hipStream_t stream) {
    static int grid_blocks = 0;
    if (!grid_blocks) {
        int dev = 0, cus = 0, per_cu = 0;
        hipGetDevice(&dev);
        hipDeviceGetAttribute(&cus, hipDeviceAttributeMultiprocessorCount, dev);
        hipFuncSetAttribute((const void*)mega, hipFuncAttributeMaxDynamicSharedMemorySize, LDS_BYTES);
        hipOccupancyMaxActiveBlocksPerMultiprocessor(&per_cu, (const void*)mega, NTHREADS, LDS_BYTES);
        if (per_cu < 1) per_cu = 1;
        grid_blocks = cus * per_cu;
        if (ws_size < WS_END) { fprintf(stderr, "kernel_launch: workspace too small: %zu < %zu\n", ws_size, (size_t)WS_END); grid_blocks = -1; }
    }
    if (grid_blocks < 0) return;
    Params p{};
    p.x = (const float*)d_in[0]; p.nmp = (const float*)d_in[1]; p.nmq = (const float*)d_in[2]; p.nfp = (const float*)d_in[3]; p.nfq = (const float*)d_in[4];
    p.ret_w_in = (const float*)d_in[5]; p.ret_gn_w = (const float*)d_in[6]; p.ret_w_out = (const float*)d_in[7];
    p.ssd_w_in = (const float*)d_in[8]; p.conv_w = (const float*)d_in[9]; p.conv_b = (const float*)d_in[10]; p.dt_bias = (const float*)d_in[11];
    p.a_log = (const float*)d_in[12]; p.d_skip = (const float*)d_in[13]; p.ssd_norm_w = (const float*)d_in[14]; p.ssd_w_out = (const float*)d_in[15];
    p.w_up = (const float*)d_in[16]; p.w_down = (const float*)d_in[17];
    p.out = (float*)d_out; p.ws = (unsigned char*)d_ws;
    void* args[] = {&p};
    hipError_t e = hipLaunchCooperativeKernel((const void*)mega, dim3(grid_blocks), dim3(NTHREADS), args, LDS_BYTES, stream);
    if (e != hipSuccess) fprintf(stderr, "cooperative launch failed: %s (grid %d)\n", hipGetErrorString(e), grid_blocks);
}
```

```cpp
#include <hip/hip_runtime.h>
#include <hip/hip_cooperative_groups.h>
#include <cstdio>
namespace cg = cooperative_groups;

#define LAS __attribute__((address_space(3)))
typedef unsigned short bf16_t;
typedef short bf16x8 __attribute__((ext_vector_type(8)));
typedef short s16x4 __attribute__((ext_vector_type(4)));
typedef float f32x4 __attribute__((ext_vector_type(4)));
typedef float f32x2 __attribute__((ext_vector_type(2)));
typedef unsigned u32x4 __attribute__((ext_vector_type(4)));
typedef unsigned u32x2 __attribute__((ext_vector_type(2)));

constexpr int T = 16384, DM = 2048, SEQ = 8192;
constexpr int RIN = 12288;
constexpr int SIN = 10304, SINP = 10496;
constexpr int DFF = 8192;
constexpr int NTHREADS = 512;
constexpr int LDS_STAGE = 131072;
constexpr int LDS_BYTES = LDS_STAGE + 16;

constexpr size_t OFF_WA = 0;
constexpr size_t OFF_WB = 50331648;
constexpr size_t OFF_ACT = OFF_WB + 33554432;
constexpr size_t ACT_BYTES = 402653184;
constexpr size_t HID_BYTES = 268435456;
constexpr size_t OFF_R2 = OFF_ACT + ACT_BYTES;
constexpr size_t R2_BYTES = 134217728;
constexpr size_t OFF_ROT = OFF_R2 + 67108864;
constexpr size_t OFF_HALO = OFF_R2 + 67108864;
constexpr size_t OFF_DTV = OFF_R2 + 67108864 + 16777216;
constexpr size_t OFF_ACV = OFF_DTV + 4194304;
constexpr size_t OFF_CBG = OFF_R2;
constexpr size_t OFF_BAR = OFF_R2 + 100663296;
constexpr size_t WS_END = OFF_R2 + R2_BYTES;

typedef __bf16 bf16x2v __attribute__((ext_vector_type(2)));
__device__ __forceinline__ unsigned cvt_pk_bf16(float lo, float hi) { const f32x2 v = {lo, hi}; const bf16x2v b = __builtin_convertvector(v, bf16x2v); return __builtin_bit_cast(unsigned, b); }
__device__ __forceinline__ unsigned pk2(float lo, float hi) { return cvt_pk_bf16(lo, hi); }
__device__ __forceinline__ unsigned f2bf(float f) { return (unsigned)__builtin_bit_cast(unsigned short, (__bf16)f); }
__device__ __forceinline__ float bflo(unsigned w) { return __uint_as_float(w << 16); }
__device__ __forceinline__ float bfhi(unsigned w) { return __uint_as_float(w & 0xffff0000u); }
__device__ __forceinline__ float bf2f(bf16_t b) { return __uint_as_float(((unsigned)b) << 16); }
__device__ __forceinline__ float wave_sum(float v) {
#pragma unroll
    for (int o = 32; o >= 1; o >>= 1) v += __shfl_xor(v, o);
    return v;
}
__device__ __forceinline__ int otid() { int t = threadIdx.x; asm volatile("" : "+v"(t)); return t; }
#define LDS_BARRIER() do { asm volatile("s_waitcnt lgkmcnt(0)" ::: "memory"); __builtin_amdgcn_s_barrier(); asm volatile("" ::: "memory"); } while (0)
__device__ __forceinline__ float silu(float x) { return x / (1.0f + __expf(-x)); }

__device__ __forceinline__ bf16x8 tr_frag(LAS unsigned char* img, int rs, int kbase, int n0, int lane) {
    const int g = lane >> 4, q = (lane & 15) >> 2, p = lane & 3;
    LAS unsigned char* a0 = img + (kbase + 8 * g + q) * rs + (n0 + 4 * p) * 2;
    s16x4 a = __builtin_amdgcn_ds_read_tr16_b64_v4i16((LAS s16x4*)a0);
    s16x4 b = __builtin_amdgcn_ds_read_tr16_b64_v4i16((LAS s16x4*)(a0 + 4 * rs));
    bf16x8 r = {a[0], a[1], a[2], a[3], b[0], b[1], b[2], b[3]};
    return r;
}

namespace pg8 {
constexpr int BM = 256, BK = 64, HALF = 128, HTB = HALF * BK * 2, STAGE_BYTES = 8 * HTB, NXCD = 8, WGM = 8;
__device__ __forceinline__ int lds_byte(int r, int c) { const int st = (r >> 4) * 2 + (c >> 5), rr = r & 15, cc = c & 31, ob = rr * 64 + cc * 2; return st * 1024 + (ob ^ (((ob >> 9) & 1) << 5)); }
__device__ __forceinline__ void stage_rc(int b, int& R, int& C) { const int st = b / 1024, sb = b % 1024, swz = sb ^ (((sb >> 9) & 1) << 5); R = (st >> 1) * 16 + swz / 64; C = (st & 1) * 32 + (swz % 64) / 2; }
__device__ __forceinline__ int perm32(int rho) { const int n = rho >> 4, i = rho & 15; return 8 * (i >> 2) + 4 * n + (i & 3); }
struct Unit { int pm, pn; };
struct Gemm { const bf16_t* A; const bf16_t* Bt; int M, N, K, lda; int kind; void* out; int ldc; const float* rot; };
struct StaticOrder {
    int nM, nN, nwg, G, c;
    __device__ void init(int M, int N, int G_, int c_) { nM = M / BM; nN = N / BM; nwg = nM * nN; G = G_; c = c_; }
    __device__ bool next(int i, Unit& u) const {
        const long L = (long)i * G + c; if (L >= nwg) return false;
        int wgid = (int)L; { const int q = nwg / NXCD, r = nwg % NXCD, xcd = wgid % NXCD, off = wgid / NXCD; wgid = (xcd < r ? xcd * (q + 1) : r * (q + 1) + (xcd - r) * q) + off; }
        const int nig = WGM * nN, gid = wgid / nig, fm = gid * WGM, gsz = (nM - fm) < WGM ? (nM - fm) : WGM;
        u.pm = fm + ((wgid % nig) % gsz); u.pn = (wgid % nig) / gsz; return true;
    }
};

template <int KIND> __device__ __forceinline__ void epilogue(const Gemm& g, const f32x4 (&acc)[2][2][4][2], const Unit& u, int wr, int wc, int fr, int fq) {
    if constexpr (KIND == 0) {
        float* C = (float*)g.out; const int ldc = g.ldc;
        const int row0 = u.pm * BM + wr * 64 + fr, col0 = u.pn * BM + wc * 32 + 4 * fq;
#pragma unroll
        for (int ai = 0; ai < 2; ++ai)
#pragma unroll
            for (int m = 0; m < 4; ++m) { float* rowp = C + (size_t)(row0 + ai * HALF + m * 16) * ldc + col0;
#pragma unroll
                for (int bj = 0; bj < 2; ++bj)
#pragma unroll
                    for (int n = 0; n < 2; ++n) *(f32x4*)(rowp + bj * HALF + n * 16) = acc[ai][bj][m][n]; }
    } else {
        bf16_t* O = (bf16_t*)g.out; const int ldc = g.ldc;
        const int row0 = u.pm * BM + wr * 64 + fr, col0 = u.pn * BM + wc * 32 + 8 * fq;
        const bool isrot = (KIND == 3) && (u.pn < 16);
        const float sc = (u.pn >= 8) ? 0.0625f : 1.0f;
        constexpr bool relu2 = (KIND == 2);
#pragma unroll
        for (int ai = 0; ai < 2; ++ai)
#pragma unroll
            for (int m = 0; m < 4; ++m) {
                const int row = row0 + ai * HALF + m * 16;
                bf16_t* rowp = O + (size_t)row * ldc + col0;
                const int pos = row & (SEQ - 1);
#pragma unroll
                for (int bj = 0; bj < 2; ++bj) {
                    f32x4 v0 = acc[ai][bj][m][0], v1 = acc[ai][bj][m][1];
                    if (relu2) {
#pragma unroll
                        for (int j = 0; j < 4; ++j) { const float a = fmaxf(v0[j], 0.f), b = fmaxf(v1[j], 0.f); v0[j] = a * a; v1[j] = b * b; }
                    }
                    if (isrot) {
                        const float* rp = g.rot + ((size_t)pos * 128 + 64 * bj + 16 * wc + 4 * fq) * 2;
                        const f32x4 c0 = *(const f32x4*)rp, c1 = *(const f32x4*)(rp + 4);
                        f32x4 r0, r1;
                        r0[0] = v0[0] * c0[0] - v0[1] * c0[1]; r0[1] = v0[0] * c0[1] + v0[1] * c0[0];
                        r0[2] = v0[2] * c0[2] - v0[3] * c0[3]; r0[3] = v0[2] * c0[3] + v0[3] * c0[2];
                        r1[0] = v1[0] * c1[0] - v1[1] * c1[1]; r1[1] = v1[0] * c1[1] + v1[1] * c1[0];
                        r1[2] = v1[2] * c1[2] - v1[3] * c1[3]; r1[3] = v1[2] * c1[3] + v1[3] * c1[2];
                        v0 = r0 * sc; v1 = r1 * sc;
                    }
                    u32x4 w; w.x = cvt_pk_bf16(v0[0], v0[1]); w.y = cvt_pk_bf16(v0[2], v0[3]); w.z = cvt_pk_bf16(v1[0], v1[1]); w.w = cvt_pk_bf16(v1[2], v1[3]);
                    *(u32x4*)(rowp + bj * HALF) = w;
                }
            }
    }
}

template <int KIND> __device__ __forceinline__ void gemm_phase(LAS unsigned char* lds, const Gemm g, const StaticOrder& S) {
    const int tid = otid(), wid = __builtin_amdgcn_readfirstlane(tid >> 6), lane = tid & 63, wr = wid >> 2, wc = wid & 3, fr = lane & 15, fq = lane >> 4;
    const int K = g.K, nt = K / BK, lda = g.lda;
    constexpr bool perm = KIND != 0;
    unsigned voffA[2], voffB[2];
#pragma unroll
    for (int i = 0; i < 2; ++i) { int R, C; stage_rc(tid * 16 + i * 8192, R, C); const int Rb = perm ? ((R & ~31) + perm32(R & 31)) : R;
        voffA[i] = (unsigned)(R * lda + C) * 2u; voffB[i] = (unsigned)(Rb * K + C) * 2u; }
    const size_t kstep = (size_t)(BK * 2);
    const size_t hstepA = (size_t)HALF * lda * 2, hstepB = (size_t)HALF * K * 2;
    const size_t tstepA = 2 * hstepA, tstepB = 2 * hstepB;
    const unsigned ldsw = (unsigned)wid * 1024u;
    const int aoff = lds_byte(wr * 64 + fr, fq * 8), boff = lds_byte(wc * 32 + fr, fq * 8);
#define PG8_SA(b, h) (((b) * 2 + (h)) * HTB)
#define PG8_SB(b, h) ((4 + (b) * 2 + (h)) * HTB)
#define PG8_STAGE(bufoff, gbase, voff) do { _Pragma("unroll") for (int _i = 0; _i < 2; ++_i) \
        __builtin_amdgcn_global_load_lds((const unsigned*)((const char*)(gbase) + (voff)[_i]), (LAS unsigned*)(lds + (bufoff) + ldsw + _i * 8192), 16, 0, 0); } while (0)
#define PG8_LDA(dst, b, h) do { _Pragma("unroll") for (int m = 0; m < 4; ++m) _Pragma("unroll") for (int k = 0; k < 2; ++k) dst[m][k] = *(const LAS bf16x8*)(lds + PG8_SA(b, h) + aoff + m * 2048 + k * 1024); } while (0)
#define PG8_LDB(dst, b, h) do { _Pragma("unroll") for (int n = 0; n < 2; ++n) _Pragma("unroll") for (int k = 0; k < 2; ++k) dst[n][k] = *(const LAS bf16x8*)(lds + PG8_SB(b, h) + boff + n * 2048 + k * 1024); } while (0)
#define PG8_MMA(ai, bj, At, Bt) do { __builtin_amdgcn_s_setprio(1); _Pragma("unroll") for (int m = 0; m < 4; ++m) _Pragma("unroll") for (int n = 0; n < 2; ++n) _Pragma("unroll") for (int k = 0; k < 2; ++k) \
        acc[ai][bj][m][n] = __builtin_amdgcn_mfma_f32_16x16x32_bf16(Bt[n][k], At[m][k], acc[ai][bj][m][n], 0, 0, 0); __builtin_amdgcn_s_setprio(0); } while (0)
#define PG8_WAIT_V(n) asm volatile("s_waitcnt vmcnt(" #n ")" ::: "memory")
#define PG8_WAIT_L(n) asm volatile("s_waitcnt lgkmcnt(" #n ")" ::: "memory")
#define PG8_BAR __builtin_amdgcn_s_barrier()
#define PG8_SCHED __builtin_amdgcn_sched_barrier(0)
    Unit cur, nxt; int ui = 0;
    if (!S.next(0, cur)) return;
    f32x4 acc[2][2][4][2];
#pragma unroll
    for (int a = 0; a < 2; ++a)
#pragma unroll
        for (int b = 0; b < 2; ++b)
#pragma unroll
            for (int m = 0; m < 4; ++m)
#pragma unroll
                for (int n = 0; n < 2; ++n) acc[a][b][m][n] = (f32x4){0.f, 0.f, 0.f, 0.f};
    bf16x8 At[4][2], B0[2][2], B1[2][2];
    const char* cA = (const char*)g.A + (size_t)cur.pm * tstepA; const char* cB = (const char*)g.Bt + (size_t)cur.pn * tstepB;
    PG8_STAGE(PG8_SB(0, 0), cB, voffB); PG8_STAGE(PG8_SA(0, 0), cA, voffA); PG8_STAGE(PG8_SB(0, 1), cB + hstepB, voffB); PG8_STAGE(PG8_SA(0, 1), cA + hstepA, voffA);
    if (wr == 1) PG8_BAR;
    PG8_WAIT_V(4); PG8_BAR;
    PG8_STAGE(PG8_SB(1, 0), cB + kstep, voffB); PG8_STAGE(PG8_SA(1, 0), cA + kstep, voffA); PG8_STAGE(PG8_SB(1, 1), cB + hstepB + kstep, voffB);
    PG8_WAIT_V(6); PG8_BAR;
    for (;;) {
        const bool has_next = S.next(ui + 1, nxt);
        const char* nA = has_next ? (const char*)g.A + (size_t)nxt.pm * tstepA : cA; const char* nB = has_next ? (const char*)g.Bt + (size_t)nxt.pn * tstepB : cB;
        for (int t = 0; t < nt; t += 2) {
            const bool last = (t == nt - 2);
            const char* a1 = cA + (size_t)(t + 1) * kstep;
            const char* a2 = last ? nA : cA + (size_t)(t + 2) * kstep; const char* b2 = last ? nB : cB + (size_t)(t + 2) * kstep;
            const char* a3 = a2 + kstep; const char* b3 = b2 + kstep;
            PG8_LDB(B0, 0, 0); PG8_SCHED; PG8_LDA(At, 0, 0); PG8_STAGE(PG8_SA(1, 1), a1 + hstepA, voffA);
            PG8_WAIT_L(8); PG8_BAR; PG8_WAIT_L(0); PG8_MMA(0, 0, At, B0); PG8_BAR; PG8_SCHED;
            PG8_LDB(B1, 0, 1); PG8_STAGE(PG8_SB(0, 0), b2, voffB);
            PG8_BAR; PG8_WAIT_L(0); PG8_MMA(0, 1, At, B1); PG8_BAR;
            PG8_LDA(At, 0, 1); PG8_STAGE(PG8_SA(0, 0), a2, voffA);
            PG8_BAR; PG8_WAIT_L(0); PG8_MMA(1, 0, At, B0); PG8_BAR; PG8_SCHED;
            PG8_STAGE(PG8_SB(0, 1), b2 + hstepB, voffB);
            PG8_WAIT_V(6); PG8_BAR; PG8_MMA(1, 1, At, B1); PG8_BAR;
            PG8_LDB(B0, 1, 0); PG8_SCHED; PG8_LDA(At, 1, 0); PG8_STAGE(PG8_SA(0, 1), a2 + hstepA, voffA);
            PG8_WAIT_L(8); PG8_BAR; PG8_WAIT_L(0); PG8_MMA(0, 0, At, B0); PG8_BAR; PG8_SCHED;
            PG8_LDB(B1, 1, 1); PG8_STAGE(PG8_SB(1, 0), b3, voffB);
            PG8_BAR; PG8_WAIT_L(0); PG8_MMA(0, 1, At, B1); PG8_BAR;
            PG8_LDA(At, 1, 1); PG8_STAGE(PG8_SA(1, 0), a3, voffA);
            PG8_BAR; PG8_WAIT_L(0); PG8_MMA(1, 0, At, B0); PG8_BAR; PG8_SCHED;
            PG8_STAGE(PG8_SB(1, 1), b3 + hstepB, voffB);
            PG8_WAIT_V(6); PG8_BAR; PG8_MMA(1, 1, At, B1); PG8_BAR;
        }
        epilogue<KIND>(g, acc, cur, wr, wc, fr, fq);
        if (!has_next) break;
#pragma unroll
        for (int a = 0; a < 2; ++a)
#pragma unroll
            for (int b = 0; b < 2; ++b)
#pragma unroll
                for (int m = 0; m < 4; ++m)
#pragma unroll
                    for (int n = 0; n < 2; ++n) acc[a][b][m][n] = (f32x4){0.f, 0.f, 0.f, 0.f};
        cur = nxt; cA = nA; cB = nB; ++ui;
    }
    PG8_WAIT_V(0);
    if (wr == 0) PG8_BAR;
    PG8_BAR;
#undef PG8_SA
#undef PG8_SB
#undef PG8_STAGE
#undef PG8_LDA
#undef PG8_LDB
#undef PG8_MMA
#undef PG8_WAIT_V
#undef PG8_WAIT_L
#undef PG8_BAR
#undef PG8_SCHED
}
}

struct ConvDesc { const float* src; bf16_t* dst; int K, Nsrc, Ndst, permq; };
__device__ __forceinline__ void convert_w(const ConvDesc& c, LAS unsigned char* lds, int wg, int G) {
    const int tid = otid();
    constexpr int RS = 144;
    const int nnt = c.Ndst / 128, ntile = (c.K / 64) * nnt;
    const int c4 = tid & 31, kq = tid >> 5;
    f32x4 r[4];
#define CW_LOAD(u_) do { const int nt_ = (u_) % nnt, kt_ = (u_) / nnt; const int col_ = nt_ * 128 + c4 * 4; \
        const float* sp_ = c.src + (size_t)(kt_ * 64 + kq * 4) * c.Nsrc + col_; const bool ok_ = col_ < c.Nsrc; \
        _Pragma("unroll") for (int i_ = 0; i_ < 4; ++i_) r[i_] = ok_ ? *(const f32x4*)(sp_ + (size_t)i_ * c.Nsrc) : (f32x4){0.f, 0.f, 0.f, 0.f}; } while (0)
    int u = wg;
    if (u < ntile) CW_LOAD(u);
    while (u < ntile) {
#pragma unroll
        for (int e = 0; e < 4; ++e) { u32x2 w; w.x = pk2(r[0][e], r[1][e]); w.y = pk2(r[2][e], r[3][e]); *(LAS u32x2*)(lds + (c4 * 4 + e) * RS + kq * 8) = w; }
        const int un = u + G;
        if (un < ntile) CW_LOAD(un);
        LDS_BARRIER();
        {
            const int nt = u % nnt, kt = u / nnt, n0 = nt * 128;
            const bool pm = c.permq && n0 < 4096;
#pragma unroll
            for (int i = 0; i < 2; ++i) { const int idx = i * 512 + tid, row = idx >> 3, kb = idx & 7;
                const u32x4 v = *(const LAS u32x4*)(lds + row * RS + kb * 16);
                const int drow = pm ? ((n0 & ~255) + 2 * row + ((n0 >> 7) & 1)) : (n0 + row);
                *(u32x4*)(c.dst + (size_t)drow * c.K + kt * 64 + kb * 8) = v; }
        }
        LDS_BARRIER();
        u = un;
    }
#undef CW_LOAD
}

struct NormDesc { int mode; const void* m; const void* hres; void* hout; const float* wpost; const float* wpre; bf16_t* ub; int hin_bf16, hout_bf16; };
__device__ __forceinline__ void norm_pass(const NormDesc& d, int wg, int G) {
    const int tid_ = otid(); const int wave = tid_ >> 6, lane = tid_ & 63;
    constexpr int NR = 2;
    for (int row0 = (wg * 8 + wave) * NR; row0 < T; row0 += G * 8 * NR) {
        float v[NR][4][8]; float ss[NR], r[NR], r2[NR];
#pragma unroll
        for (int q = 0; q < NR; ++q) {
            const size_t ro = (size_t)(row0 + q) * DM;
            if (d.mode == 0) {
#pragma unroll
                for (int i = 0; i < 4; ++i) { const int c = (i * 64 + lane) * 8; const f32x4 a = *(const f32x4*)((const float*)d.m + ro + c), b = *(const f32x4*)((const float*)d.m + ro + c + 4);
#pragma unroll
                    for (int e = 0; e < 4; ++e) { v[q][i][e] = a[e]; v[q][i][4 + e] = b[e]; } }
            } else {
#pragma unroll
                for (int i = 0; i < 4; ++i) { const int c = (i * 64 + lane) * 8; const u32x4 a = *(const u32x4*)((const bf16_t*)d.m + ro + c);
                    v[q][i][0] = bflo(a.x); v[q][i][1] = bfhi(a.x); v[q][i][2] = bflo(a.y); v[q][i][3] = bfhi(a.y); v[q][i][4] = bflo(a.z); v[q][i][5] = bfhi(a.z); v[q][i][6] = bflo(a.w); v[q][i][7] = bfhi(a.w); }
            }
        }
#pragma unroll
        for (int q = 0; q < NR; ++q) {
            float s = 0.f;
#pragma unroll
            for (int i = 0; i < 4; ++i)
#pragma unroll
                for (int e = 0; e < 8; ++e) s += v[q][i][e] * v[q][i][e];
            ss[q] = s;
        }
#pragma unroll
        for (int q = 0; q < NR; ++q) { ss[q] = wave_sum(ss[q]); r[q] = rsqrtf(ss[q] * (1.0f / DM) + 1e-6f); r2[q] = r[q]; }
        if (d.mode != 0) {
            float s2[NR];
#pragma unroll
            for (int q = 0; q < NR; ++q) {
                const size_t ro = (size_t)(row0 + q) * DM;
                float s = 0.f;
#pragma unroll
                for (int i = 0; i < 4; ++i) { const int c = (i * 64 + lane) * 8;
                    const f32x4 w0 = *(const f32x4*)(d.wpost + c), w1 = *(const f32x4*)(d.wpost + c + 4);
                    f32x4 h0, h1;
                    if (d.hin_bf16) { const u32x4 hv = *(const u32x4*)((const bf16_t*)d.hres + ro + c); h0[0] = bflo(hv.x); h0[1] = bfhi(hv.x); h0[2] = bflo(hv.y); h0[3] = bfhi(hv.y); h1[0] = bflo(hv.z); h1[1] = bfhi(hv.z); h1[2] = bflo(hv.w); h1[3] = bfhi(hv.w); }
                    else { h0 = *(const f32x4*)((const float*)d.hres + ro + c); h1 = *(const f32x4*)((const float*)d.hres + ro + c + 4); }
                    f32x4 o0, o1;
#pragma unroll
                    for (int e = 0; e < 4; ++e) { o0[e] = h0[e] + v[q][i][e] * r[q] * w0[e]; o1[e] = h1[e] + v[q][i][4 + e] * r[q] * w1[e]; v[q][i][e] = o0[e]; v[q][i][4 + e] = o1[e]; s += o0[e] * o0[e] + o1[e] * o1[e]; }
                    if (d.hout_bf16) { u32x4 hw; hw.x = pk2(o0[0], o0[1]); hw.y = pk2(o0[2], o0[3]); hw.z = pk2(o1[0], o1[1]); hw.w = pk2(o1[2], o1[3]); *(u32x4*)((bf16_t*)d.hout + ro + c) = hw; }
                    else { *(f32x4*)((float*)d.hout + ro + c) = o0; *(f32x4*)((float*)d.hout + ro + c + 4) = o1; } }
                s2[q] = s;
            }
            if (d.mode == 1) {
#pragma unroll
                for (int q = 0; q < NR; ++q) { s2[q] = wave_sum(s2[q]); r2[q] = rsqrtf(s2[q] * (1.0f / DM) + 1e-6f); }
            }
        }
        if (d.mode != 2) {
#pragma unroll
            for (int q = 0; q < NR; ++q) {
                const size_t ro = (size_t)(row0 + q) * DM;
#pragma unroll
                for (int i = 0; i < 4; ++i) { const int c = (i * 64 + lane) * 8;
                    const f32x4 w0 = *(const f32x4*)(d.wpre + c), w1 = *(const f32x4*)(d.wpre + c + 4);
                    u32x4 o; o.x = pk2(v[q][i][0] * r2[q] * w0[0], v[q][i][1] * r2[q] * w0[1]); o.y = pk2(v[q][i][2] * r2[q] * w0[2], v[q][i][3] * r2[q] * w0[3]);
                    o.z = pk2(v[q][i][4] * r2[q] * w1[0], v[q][i][5] * r2[q] * w1[1]); o.w = pk2(v[q][i][6] * r2[q] * w1[2], v[q][i][7] * r2[q] * w1[3]);
                    *(u32x4*)(d.ub + ro + c) = o; }
            }
        }
    }
}

__device__ __forceinline__ void rot_table(float* rot, int wg, int G) {
    for (int e = wg * NTHREADS + otid(); e < SEQ * 128; e += G * NTHREADS) {
        const int pos = e >> 7, jf = e & 127;
        const float inv = exp2f(-(float)jf * (13.287712379549449f / 128.0f));
        const float ang = (float)pos * inv;
        const double a = (double)ang; const double k = rint(a * 0.15915494309189535); const float rf = (float)(a - k * 6.283185307179586);
        f32x2 cs; cs.x = cosf(rf); cs.y = sinf(rf);
        *(f32x2*)(rot + 2 * (size_t)e) = cs;
    }
}

__device__ __forceinline__ void ret_pre(const bf16_t* proj, bf16_t* Pg, LAS unsigned char* lds, int wg, int G) {
    const int tid = otid(), lane = tid & 63, wid = __builtin_amdgcn_readfirstlane(tid >> 6), fr = lane & 15, fq = lane >> 4;
    constexpr int QS = 528;
    LAS unsigned char* Qs = lds; LAS unsigned char* Ks = lds + 33792;
    const int lm = wid >> 1, c2 = wid & 1;
    u32x4 rq[4], rk[4];
    int u = wg;
    if (u < 2048) {
        const bf16_t* qb = proj + (size_t)((u >> 3) * 64) * RIN + (u & 7) * 256;
#pragma unroll
        for (int i = 0; i < 4; ++i) { const int idx = i * 512 + tid, row = idx >> 5, ch = idx & 31; rq[i] = *(const u32x4*)(qb + (size_t)row * RIN + ch * 8); rk[i] = *(const u32x4*)(qb + 2048 + (size_t)row * RIN + ch * 8); }
    }
    for (; u < 2048; u += G) {
        const int h = u & 7, t0 = (u >> 3) * 64;
#pragma unroll
        for (int i = 0; i < 4; ++i) { const int idx = i * 512 + tid, row = idx >> 5, ch = idx & 31; *(LAS u32x4*)(Qs + row * QS + ch * 16) = rq[i]; *(LAS u32x4*)(Ks + row * QS + ch * 16) = rk[i]; }
        LDS_BARRIER();
        const int un = u + G;
        if (un < 2048) {
            const bf16_t* qb = proj + (size_t)((un >> 3) * 64) * RIN + (un & 7) * 256;
#pragma unroll
            for (int i = 0; i < 4; ++i) { const int idx = i * 512 + tid, row = idx >> 5, ch = idx & 31; rq[i] = *(const u32x4*)(qb + (size_t)row * RIN + ch * 8); rk[i] = *(const u32x4*)(qb + 2048 + (size_t)row * RIN + ch * 8); }
        }
        const float lg = log1pf(-exp2f(-5.0f - (float)h));
        f32x4 aP0 = {0.f, 0.f, 0.f, 0.f}, aP1 = {0.f, 0.f, 0.f, 0.f};
#pragma unroll
        for (int ks = 0; ks < 8; ++ks) {
            const bf16x8 a = *(const LAS bf16x8*)(Qs + (lm * 16 + fr) * QS + ks * 64 + fq * 16);
            const bf16x8 b0 = *(const LAS bf16x8*)(Ks + ((c2 * 2 + 0) * 16 + fr) * QS + ks * 64 + fq * 16);
            const bf16x8 b1 = *(const LAS bf16x8*)(Ks + ((c2 * 2 + 1) * 16 + fr) * QS + ks * 64 + fq * 16);
            aP0 = __builtin_amdgcn_mfma_f32_16x16x32_bf16(a, b0, aP0, 0, 0, 0);
            aP1 = __builtin_amdgcn_mfma_f32_16x16x32_bf16(a, b1, aP1, 0, 0, 0);
        }
#pragma unroll
        for (int j = 0; j < 4; ++j) { const int l = lm * 16 + fq * 4 + j;
            const int m0 = (c2 * 2 + 0) * 16 + fr, m1 = m0 + 16;
            const int d0 = l > m0 ? l - m0 : m0 - l, d1 = l > m1 ? l - m1 : m1 - l;
            bf16_t* pp = Pg + ((size_t)(t0 + l) * 8 + h) * 64;
            pp[m0] = (bf16_t)f2bf(aP0[j] * expf((float)d0 * lg));
            pp[m1] = (bf16_t)f2bf(aP1[j] * expf((float)d1 * lg)); }
        LDS_BARRIER();
    }
}

__device__ __forceinline__ void ret_scan(bf16_t* proj, const bf16_t* Pg, LAS unsigned char* lds, int wg, int G) {
    const int tid = otid(), lane = tid & 63, wid = __builtin_amdgcn_readfirstlane(tid >> 6), fr = lane & 15, fq = lane >> 4;
    constexpr int QS = 528, VS = 80, PS = 144;
    LAS unsigned char* Qs = lds; LAS unsigned char* Ks = lds + 33792; LAS unsigned char* Vs = lds + 67584; LAS unsigned char* Vz = lds + 72704;
    LAS unsigned char* Ps = lds + 77824; LAS unsigned char* St0 = lds + 87040;
    const int lm = wid >> 1, c2 = wid & 1;
    for (int unit = wg; unit < 256; unit += G) {
        const int xc = unit & 7, ii = unit >> 3, bh = xc * 2 + (ii >> 4), vs = ii & 15, b = bh >> 3, h = bh & 7;
        const float lg = log1pf(-exp2f(-5.0f - (float)h));
        float xi[4];
#pragma unroll
        for (int j = 0; j < 4; ++j) { const int l = lm * 16 + fq * 4 + j; xi[j] = expf((float)(l + 1) * lg); }
        const float cdecay = expf(64.0f * lg);
        const int vrow = (tid & 255) >> 2, vch = tid & 3;
        const float zeta = expf((float)(63 - vrow) * lg);
        const int prow = tid >> 3, pch = tid & 7;
        f32x4 accS[2][2];
#pragma unroll
        for (int a = 0; a < 2; ++a)
#pragma unroll
            for (int c = 0; c < 2; ++c) accS[a][c] = (f32x4){0.f, 0.f, 0.f, 0.f};
        for (int i = tid; i < 16896 / 4; i += NTHREADS) ((LAS unsigned*)St0)[i] = 0u;
        const bf16_t* qb = proj + (size_t)(b * SEQ) * RIN + h * 256;
        const bf16_t* kb = qb + 2048;
        bf16_t* vb = proj + (size_t)(b * SEQ) * RIN + 4096 + h * 512 + vs * 32;
        const bf16_t* pb = Pg + ((size_t)(b * SEQ + prow) * 8 + h) * 64 + pch * 8;
        u32x4 rq[2][4], rk[2][4], rv[2], rp[2];
#define RET_LOAD(S_, cc_) do { const size_t ro_ = (size_t)(cc_) * 64 * RIN; \
            _Pragma("unroll") for (int i = 0; i < 4; ++i) { const int idx = i * 512 + tid, row = idx >> 5, ch = idx & 31; rq[S_][i] = *(const u32x4*)(qb + ro_ + (size_t)row * RIN + ch * 8); rk[S_][i] = *(const u32x4*)(kb + ro_ + (size_t)row * RIN + ch * 8); } \
            if (tid < 256) rv[S_] = *(const u32x4*)(vb + ro_ + (size_t)vrow * RIN + vch * 8); \
            rp[S_] = *(const u32x4*)(pb + (size_t)(cc_) * 64 * 512); } while (0)
        rv[0] = (u32x4){0u, 0u, 0u, 0u}; rv[1] = rv[0];
        RET_LOAD(0, 0); RET_LOAD(1, 1);
        for (int c0 = 0; c0 < 128; c0 += 2) {
#pragma unroll
          for (int par = 0; par < 2; ++par) {
            const int c = c0 + par;
            LAS unsigned char* Stc = St0 + par * 16896; LAS unsigned char* Stn = St0 + (par ^ 1) * 16896;
#pragma unroll
            for (int i = 0; i < 4; ++i) { const int idx = i * 512 + tid, row = idx >> 5, ch = idx & 31; *(LAS u32x4*)(Qs + row * QS + ch * 16) = rq[par][i]; *(LAS u32x4*)(Ks + row * QS + ch * 16) = rk[par][i]; }
            if (tid < 256) {
                const u32x4 rvv = rv[par];
                *(LAS u32x4*)(Vs + vrow * VS + vch * 16) = rvv;
                u32x4 z; z.x = pk2(bflo(rvv.x) * zeta, bfhi(rvv.x) * zeta); z.y = pk2(bflo(rvv.y) * zeta, bfhi(rvv.y) * zeta);
                z.z = pk2(bflo(rvv.z) * zeta, bfhi(rvv.z) * zeta); z.w = pk2(bflo(rvv.w) * zeta, bfhi(rvv.w) * zeta);
                *(LAS u32x4*)(Vz + vrow * VS + vch * 16) = z;
            }
            *(LAS u32x4*)(Ps + prow * PS + pch * 16) = rp[par];
            LDS_BARRIER();
            if (c + 2 < 128) RET_LOAD(par, c + 2);
            f32x4 aX0 = {0.f, 0.f, 0.f, 0.f}, aX1 = {0.f, 0.f, 0.f, 0.f}, aI = {0.f, 0.f, 0.f, 0.f};
#pragma unroll
            for (int ks = 0; ks < 8; ks += 2) {
                const bf16x8 a0 = *(const LAS bf16x8*)(Qs + (lm * 16 + fr) * QS + ks * 64 + fq * 16);
                const bf16x8 s0 = *(const LAS bf16x8*)(Stc + (c2 * 16 + fr) * QS + ks * 64 + fq * 16);
                const bf16x8 a1 = *(const LAS bf16x8*)(Qs + (lm * 16 + fr) * QS + (ks + 1) * 64 + fq * 16);
                const bf16x8 s1 = *(const LAS bf16x8*)(Stc + (c2 * 16 + fr) * QS + (ks + 1) * 64 + fq * 16);
                aX0 = __builtin_amdgcn_mfma_f32_16x16x32_bf16(a0, s0, aX0, 0, 0, 0);
                aX1 = __builtin_amdgcn_mfma_f32_16x16x32_bf16(a1, s1, aX1, 0, 0, 0);
            }
#pragma unroll
            for (int ks = 0; ks < 2; ++ks) {
                const bf16x8 a = *(const LAS bf16x8*)(Ps + (lm * 16 + fr) * PS + ks * 64 + fq * 16);
                const bf16x8 bv = tr_frag(Vs, VS, ks * 32, c2 * 16, lane);
                aI = __builtin_amdgcn_mfma_f32_16x16x32_bf16(a, bv, aI, 0, 0, 0);
            }
            {
                bf16_t* ob = vb + (size_t)(c * 64) * RIN + c2 * 16 + fr;
#pragma unroll
                for (int j = 0; j < 4; ++j) { const int l = lm * 16 + fq * 4 + j; ob[(size_t)l * RIN] = (bf16_t)f2bf(aI[j] + (aX0[j] + aX1[j]) * xi[j]); }
            }
#pragma unroll
            for (int a = 0; a < 2; ++a)
#pragma unroll
                for (int cc = 0; cc < 2; ++cc) accS[a][cc] *= cdecay;
#pragma unroll
            for (int ks = 0; ks < 2; ++ks) {
                const bf16x8 ad0 = tr_frag(Ks, QS, ks * 32, (wid * 2 + 0) * 16, lane);
                const bf16x8 ad1 = tr_frag(Ks, QS, ks * 32, (wid * 2 + 1) * 16, lane);
                const bf16x8 bv0 = tr_frag(Vz, VS, ks * 32, 0, lane);
                const bf16x8 bv1 = tr_frag(Vz, VS, ks * 32, 16, lane);
                accS[0][0] = __builtin_amdgcn_mfma_f32_16x16x32_bf16(ad0, bv0, accS[0][0], 0, 0, 0);
                accS[0][1] = __builtin_amdgcn_mfma_f32_16x16x32_bf16(ad0, bv1, accS[0][1], 0, 0, 0);
                accS[1][0] = __builtin_amdgcn_mfma_f32_16x16x32_bf16(ad1, bv0, accS[1][0], 0, 0, 0);
                accS[1][1] = __builtin_amdgcn_mfma_f32_16x16x32_bf16(ad1, bv1, accS[1][1], 0, 0, 0);
            }
#pragma unroll
            for (int a = 0; a < 2; ++a)
#pragma unroll
                for (int cc = 0; cc < 2; ++cc) {
                    u32x2 w; w.x = pk2(accS[a][cc][0], accS[a][cc][1]); w.y = pk2(accS[a][cc][2], accS[a][cc][3]);
                    *(LAS u32x2*)(Stn + (cc * 16 + fr) * QS + ((wid * 2 + a) * 16 + fq * 4) * 2) = w;
                }
            LDS_BARRIER();
          }
        }
#undef RET_LOAD
    }
}

__device__ __forceinline__ void ret_gn(bf16_t* proj, const float* gnw, int wg, int G) {
    const int tid_ = otid(); const int wave = tid_ >> 6, lane = tid_ & 63;
    constexpr int NP = 4;
    for (int pair0 = (wg * 8 + wave) * NP; pair0 < T * 8; pair0 += G * 8 * NP) {
        u32x4 ov[NP], gv[NP];
#pragma unroll
        for (int q = 0; q < NP; ++q) { const int pair = pair0 + q, t = pair >> 3, h = pair & 7;
            const bf16_t* op = proj + (size_t)t * RIN + 4096 + h * 512 + lane * 8; ov[q] = *(const u32x4*)op; gv[q] = *(const u32x4*)(op + 4096); }
#pragma unroll
        for (int q = 0; q < NP; ++q) { const int pair = pair0 + q, t = pair >> 3, h = pair & 7;
            bf16_t* gp = proj + (size_t)t * RIN + 8192 + h * 512 + lane * 8;
            float o[8] = {bflo(ov[q].x), bfhi(ov[q].x), bflo(ov[q].y), bfhi(ov[q].y), bflo(ov[q].z), bfhi(ov[q].z), bflo(ov[q].w), bfhi(ov[q].w)};
            float g[8] = {bflo(gv[q].x), bfhi(gv[q].x), bflo(gv[q].y), bfhi(gv[q].y), bflo(gv[q].z), bfhi(gv[q].z), bflo(gv[q].w), bfhi(gv[q].w)};
            float s = 0.f;
#pragma unroll
            for (int e = 0; e < 8; ++e) s += o[e];
            const float mu = wave_sum(s) * (1.0f / 512.0f);
            float qq = 0.f;
#pragma unroll
            for (int e = 0; e < 8; ++e) { o[e] -= mu; qq += o[e] * o[e]; }
            const float rstd = rsqrtf(wave_sum(qq) * (1.0f / 512.0f) + 1e-5f);
            const f32x4 w0 = *(const f32x4*)(gnw + h * 512 + lane * 8), w1 = *(const f32x4*)(gnw + h * 512 + lane * 8 + 4);
            float y[8];
#pragma unroll
            for (int e = 0; e < 8; ++e) y[e] = silu(g[e]) * (o[e] * rstd) * (e < 4 ? w0[e & 3] : w1[e & 3]);
            u32x4 w; w.x = pk2(y[0], y[1]); w.y = pk2(y[2], y[3]); w.z = pk2(y[4], y[5]); w.w = pk2(y[6], y[7]);
            *(u32x4*)gp = w; }
    }
}

__device__ __forceinline__ void ssd_pre(const bf16_t* proj, bf16_t* halo, float* dtv, float* acv, const float* dt_bias, const float* a_log, int wg, int G) {
    const int tid = otid();
    const int gt = wg * NTHREADS + tid, gs = G * NTHREADS;
    for (int e = gt; e < 256 * 3 * 768; e += gs) {
        const int oc = e % 768, r = (e / 768) % 3, ck = e / (768 * 3);
        const u32x4 v = *(const u32x4*)(proj + (size_t)(ck * 64 + 61 + r) * SINP + 4096 + oc * 8);
        *(u32x4*)(halo + ((size_t)ck * 3 + r) * 6144 + oc * 8) = v;
    }
    const int wave = tid >> 6, lane = tid & 63;
    for (int task = wg * 8 + wave; task < 256 * 64; task += G * 8) {
        const int ck = task >> 6, hd = task & 63;
        const float x = bf2f(proj[(size_t)(ck * 64 + lane) * SINP + 10240 + hd]) + dt_bias[hd];
        const float dt = x > 20.f ? x : log1pf(expf(x));
        float sa = dt * (-expf(a_log[hd]));
#pragma unroll
        for (int o = 1; o < 64; o <<= 1) { const float tt = __shfl_up(sa, o); if (lane >= o) sa += tt; }
        dtv[(size_t)task * 64 + lane] = dt; acv[(size_t)task * 64 + lane] = sa;
    }
}
__device__ __forceinline__ void ssd_cb(bf16_t* proj, const bf16_t* halo, const float* cw, const float* cbias, bf16_t* CBg, LAS unsigned char* lds, int wg, int G) {
    const int tid = otid(), lane = tid & 63, wid = __builtin_amdgcn_readfirstlane(tid >> 6), fr = lane & 15, fq = lane >> 4;
    constexpr int CS = 272;
    LAS unsigned char* Cs = lds; LAS unsigned char* Bs = lds + 17408; LAS unsigned char* RB = lds + 34816; LAS unsigned char* RC = lds + 53248;
    LAS float* Wl = (LAS float*)(lds + 71680);
    const int lm = wid >> 1, c2 = wid & 1;
    u32x4 rc[2], rb[2], rh; f32x4 rw;
    const int hm = tid / 48, hr = (tid % 48) >> 4, hch = tid & 15;
#define CB_LOAD(u_) do { const int g_ = (u_) & 7, bc_ = (u_) >> 3; const bf16_t* bb_ = proj + (size_t)(bc_ * 64) * SINP + 8192 + g_ * 128; \
        _Pragma("unroll") for (int i = 0; i < 2; ++i) { const int idx = i * 512 + tid, row = idx >> 4, ch = idx & 15; rb[i] = *(const u32x4*)(bb_ + (size_t)row * SINP + ch * 8); rc[i] = *(const u32x4*)(bb_ + 1024 + (size_t)row * SINP + ch * 8); } \
        rh = (u32x4){0u, 0u, 0u, 0u}; \
        if (tid < 96 && (bc_ & 127) != 0) rh = *(const u32x4*)(halo + ((size_t)(bc_ - 1) * 3 + hr) * 6144 + 4096 + hm * 1024 + g_ * 128 + hch * 8); \
        if (tid < 320) { const int m_ = tid / 160, q_ = tid % 160, tp_ = q_ >> 5, c4_ = q_ & 31; const int col_ = 4096 + m_ * 1024 + g_ * 128 + c4_ * 4; \
            rw = tp_ < 4 ? *(const f32x4*)(cw + tp_ * 6144 + col_) : *(const f32x4*)(cbias + col_); } } while (0)
    int u = wg;
    if (u < 2048) CB_LOAD(u);
    for (; u < 2048; u += G) {
        const int g = u & 7, t0 = (u >> 3) * 64;
#pragma unroll
        for (int i = 0; i < 2; ++i) { const int idx = i * 512 + tid, row = idx >> 4, ch = idx & 15; *(LAS u32x4*)(RC + (row + 3) * CS + ch * 16) = rc[i]; *(LAS u32x4*)(RB + (row + 3) * CS + ch * 16) = rb[i]; }
        if (tid < 96) *(LAS u32x4*)((hm ? RC : RB) + hr * CS + hch * 16) = rh;
        if (tid < 320) { const int m_ = tid / 160, q_ = tid % 160; *(LAS f32x4*)(Wl + m_ * 640 + (q_ >> 5) * 128 + (q_ & 31) * 4) = rw; }
        LDS_BARRIER();
        const int un = u + G;
        if (un < 2048) CB_LOAD(un);
#pragma unroll
        for (int mtx = 0; mtx < 2; ++mtx) {
            LAS unsigned char* R = mtx ? RC : RB; LAS unsigned char* O = mtx ? Cs : Bs;
            const LAS float* wl = Wl + mtx * 640;
#pragma unroll
            for (int i = 0; i < 2; ++i) {
                const int idx = i * 512 + tid, row = idx >> 4, ch = idx & 15;
                float acc8[8];
                { const f32x4 b0 = *(const LAS f32x4*)(wl + 512 + ch * 8), b1 = *(const LAS f32x4*)(wl + 512 + ch * 8 + 4);
#pragma unroll
                  for (int e = 0; e < 4; ++e) { acc8[e] = b0[e]; acc8[4 + e] = b1[e]; } }
#pragma unroll
                for (int tp = 0; tp < 4; ++tp) {
                    const u32x4 xv = *(const LAS u32x4*)(R + (row + tp) * CS + ch * 16);
                    const f32x4 w0 = *(const LAS f32x4*)(wl + tp * 128 + ch * 8), w1 = *(const LAS f32x4*)(wl + tp * 128 + ch * 8 + 4);
                    acc8[0] += w0[0] * bflo(xv.x); acc8[1] += w0[1] * bfhi(xv.x); acc8[2] += w0[2] * bflo(xv.y); acc8[3] += w0[3] * bfhi(xv.y);
                    acc8[4] += w1[0] * bflo(xv.z); acc8[5] += w1[1] * bfhi(xv.z); acc8[6] += w1[2] * bflo(xv.w); acc8[7] += w1[3] * bfhi(xv.w);
                }
                u32x4 o; o.x = pk2(silu(acc8[0]), silu(acc8[1])); o.y = pk2(silu(acc8[2]), silu(acc8[3])); o.z = pk2(silu(acc8[4]), silu(acc8[5])); o.w = pk2(silu(acc8[6]), silu(acc8[7]));
                *(LAS u32x4*)(O + row * CS + ch * 16) = o;
                *(u32x4*)(proj + (size_t)(t0 + row) * SINP + 8192 + mtx * 1024 + g * 128 + ch * 8) = o;
            }
        }
        LDS_BARRIER();
        f32x4 aW0 = {0.f, 0.f, 0.f, 0.f}, aW1 = {0.f, 0.f, 0.f, 0.f};
#pragma unroll
        for (int ks = 0; ks < 4; ++ks) {
            const bf16x8 a = *(const LAS bf16x8*)(Cs + (lm * 16 + fr) * CS + ks * 64 + fq * 16);
            const bf16x8 b0 = *(const LAS bf16x8*)(Bs + ((c2 * 2 + 0) * 16 + fr) * CS + ks * 64 + fq * 16);
            const bf16x8 b1 = *(const LAS bf16x8*)(Bs + ((c2 * 2 + 1) * 16 + fr) * CS + ks * 64 + fq * 16);
            aW0 = __builtin_amdgcn_mfma_f32_16x16x32_bf16(a, b0, aW0, 0, 0, 0);
            aW1 = __builtin_amdgcn_mfma_f32_16x16x32_bf16(a, b1, aW1, 0, 0, 0);
        }
#pragma unroll
        for (int j = 0; j < 4; ++j) { const int l = lm * 16 + fq * 4 + j;
            bf16_t* pp = CBg + ((size_t)(t0 + l) * 8 + g) * 64 + (c2 * 2) * 16 + fr;
            pp[0] = (bf16_t)f2bf(aW0[j]); pp[16] = (bf16_t)f2bf(aW1[j]); }
        LDS_BARRIER();
    }
#undef CB_LOAD
}

__device__ __forceinline__ void ssd_scan(bf16_t* proj, const bf16_t* halo, const float* cw, const float* cbias, const bf16_t* CBg, const float* dtv, const float* acv, const float* d_skip, LAS unsigned char* lds, int wg, int G) {
    const int tid = otid(), lane = tid & 63, wid = __builtin_amdgcn_readfirstlane(tid >> 6), fr = lane & 15, fq = lane >> 4;
    constexpr int CS = 272, XS = 80, WS = 144;
    LAS unsigned char* Cs = lds; LAS unsigned char* Bs = lds + 17408; LAS unsigned char* Xs = lds + 34816; LAS unsigned char* Xw = lds + 39936; LAS unsigned char* Zs = lds + 45056;
    LAS unsigned char* Ws = lds + 50176; LAS unsigned char* Sts0 = lds + 59392; LAS float* acum = (LAS float*)(lds + 76800);
    LAS float* Wx = (LAS float*)(lds + 77056);
    const int lm = wid >> 1, c2 = wid & 1;
    for (int unit = wg; unit < 256; unit += G) {
        const int grp = unit & 7, ii = unit >> 3, b = ii >> 4, hd = grp * 8 + ((ii & 15) >> 1), ph = ii & 1;
        const float dsk = d_skip[hd];
        f32x4 accT[2];
        accT[0] = (f32x4){0.f, 0.f, 0.f, 0.f}; accT[1] = (f32x4){0.f, 0.f, 0.f, 0.f};
        for (int i = tid; i < 8704 / 4; i += NTHREADS) ((LAS unsigned*)Sts0)[i] = 0u;
        const bf16_t* base = proj + (size_t)(b * SEQ) * SINP;
        const bf16_t* bb = base + 8192 + grp * 128;
        const bf16_t* cbp = base + 9216 + grp * 128;
        bf16_t* xb = (bf16_t*)base + 4096 + hd * 64 + ph * 32;
        const bf16_t* zb = base + hd * 64 + ph * 32;
        const int xrow = (tid & 255) >> 2, xch = tid & 3;
        const int wrow = tid >> 3, ws0 = (tid & 7) * 8;
        if (tid < 40) { const int tp = tid >> 3, c4 = tid & 7; const int col = hd * 64 + ph * 32 + c4 * 4; *(LAS f32x4*)(Wx + tp * 32 + c4 * 4) = tp < 4 ? *(const f32x4*)(cw + tp * 6144 + col) : *(const f32x4*)(cbias + col); }
        const bf16_t* hxb = halo + (size_t)(b * 128) * 3 * 6144 + hd * 64 + ph * 32 + xch * 8;
        const bf16_t* cgp = CBg + ((size_t)(b * SEQ + wrow) * 8 + grp) * 64 + ws0;
        const float* dtp = dtv + ((size_t)(b * 128) * 64 + hd) * 64;
        const float* acp = acv + ((size_t)(b * 128) * 64 + hd) * 64;
        u32x4 rc[2][2], rb[2][2], rxz[2], rcb[2], rxh[2][3]; f32x4 rds[2][2], ras[2][2]; float ral[2], rax[2], rdx[2], rat[2], ra0[2] = {0.f, 0.f};
#define SSD_PREFETCH(S_, cc_) do { const size_t ro_ = (size_t)(cc_) * 64 * SINP; \
            _Pragma("unroll") for (int i = 0; i < 2; ++i) { const int idx = i * 512 + tid, row = idx >> 4, ch = idx & 15; rc[S_][i] = *(const u32x4*)(cbp + ro_ + (size_t)row * SINP + ch * 8); rb[S_][i] = *(const u32x4*)(bb + ro_ + (size_t)row * SINP + ch * 8); } \
            rxz[S_] = *(const u32x4*)((tid < 256 ? (const bf16_t*)xb : zb) + ro_ + (size_t)xrow * SINP + xch * 8); \
            if (tid < 256) { _Pragma("unroll") for (int k_ = 1; k_ <= 3; ++k_) { const int r_ = xrow - k_; \
                rxh[S_][k_ - 1] = r_ >= 0 ? *(const u32x4*)(xb + ro_ + (size_t)r_ * SINP + xch * 8) : ((cc_) > 0 ? *(const u32x4*)(hxb + ((size_t)((cc_) - 1) * 3 + (3 + r_)) * 6144) : (u32x4){0u, 0u, 0u, 0u}); } } \
            rcb[S_] = *(const u32x4*)(cgp + (size_t)(cc_) * 64 * 512); \
            const float* d_ = dtp + (size_t)(cc_) * 4096; const float* a_ = acp + (size_t)(cc_) * 4096; \
            rds[S_][0] = *(const f32x4*)(d_ + ws0); rds[S_][1] = *(const f32x4*)(d_ + ws0 + 4); ras[S_][0] = *(const f32x4*)(a_ + ws0); ras[S_][1] = *(const f32x4*)(a_ + ws0 + 4); \
            ral[S_] = a_[wrow]; rax[S_] = a_[xrow]; rdx[S_] = d_[xrow]; rat[S_] = a_[63]; if (tid < 64) ra0[S_] = a_[tid]; } while (0)
        LDS_BARRIER();
        SSD_PREFETCH(0, 0);
        for (int c0 = 0; c0 < 128; c0 += 2) {
#pragma unroll
          for (int par = 0; par < 2; ++par) {
            const int c = c0 + par;
            LAS unsigned char* Stc = Sts0 + par * 8704; LAS unsigned char* Stn = Sts0 + (par ^ 1) * 8704;
#pragma unroll
            for (int i = 0; i < 2; ++i) { const int idx = i * 512 + tid, row = idx >> 4, ch = idx & 15; *(LAS u32x4*)(Cs + row * CS + ch * 16) = rc[0][i]; *(LAS u32x4*)(Bs + row * CS + ch * 16) = rb[0][i]; }
            if (tid >= 256) *(LAS u32x4*)(Zs + xrow * XS + xch * 16) = rxz[0];
            else {
                float xc[8];
                { const f32x4 b0 = *(const LAS f32x4*)(Wx + 128 + xch * 8), b1 = *(const LAS f32x4*)(Wx + 128 + xch * 8 + 4);
#pragma unroll
                  for (int e = 0; e < 4; ++e) { xc[e] = b0[e]; xc[4 + e] = b1[e]; } }
#pragma unroll
                for (int tp = 0; tp < 4; ++tp) {
                    const u32x4 xv = tp == 3 ? rxz[0] : rxh[0][2 - tp];
                    const f32x4 w0 = *(const LAS f32x4*)(Wx + tp * 32 + xch * 8), w1 = *(const LAS f32x4*)(Wx + tp * 32 + xch * 8 + 4);
                    xc[0] += w0[0] * bflo(xv.x); xc[1] += w0[1] * bfhi(xv.x); xc[2] += w0[2] * bflo(xv.y); xc[3] += w0[3] * bfhi(xv.y);
                    xc[4] += w1[0] * bflo(xv.z); xc[5] += w1[1] * bfhi(xv.z); xc[6] += w1[2] * bflo(xv.w); xc[7] += w1[3] * bfhi(xv.w);
                }
#pragma unroll
                for (int e = 0; e < 8; ++e) xc[e] = silu(xc[e]);
                u32x4 xo; xo.x = pk2(xc[0], xc[1]); xo.y = pk2(xc[2], xc[3]); xo.z = pk2(xc[4], xc[5]); xo.w = pk2(xc[6], xc[7]);
                *(LAS u32x4*)(Xs + xrow * XS + xch * 16) = xo;
                const float f = rdx[0] * expf(rat[0] - rax[0]);
                u32x4 z; z.x = pk2(bflo(xo.x) * f, bfhi(xo.x) * f); z.y = pk2(bflo(xo.y) * f, bfhi(xo.y) * f); z.z = pk2(bflo(xo.z) * f, bfhi(xo.z) * f); z.w = pk2(bflo(xo.w) * f, bfhi(xo.w) * f);
                *(LAS u32x4*)(Xw + xrow * XS + xch * 16) = z;
            }
            {
                const u32x4 rcv = rcb[0];
                const float cv[8] = {bflo(rcv.x), bfhi(rcv.x), bflo(rcv.y), bfhi(rcv.y), bflo(rcv.z), bfhi(rcv.z), bflo(rcv.w), bfhi(rcv.w)};
                float wv[8];
#pragma unroll
                for (int e = 0; e < 8; ++e) { const float as = e < 4 ? ras[0][0][e & 3] : ras[0][1][e & 3], ds = e < 4 ? rds[0][0][e & 3] : rds[0][1][e & 3];
                    wv[e] = (wrow >= ws0 + e) ? cv[e] * expf(ral[0] - as) * ds : 0.f; }
                u32x4 w; w.x = pk2(wv[0], wv[1]); w.y = pk2(wv[2], wv[3]); w.z = pk2(wv[4], wv[5]); w.w = pk2(wv[6], wv[7]);
                *(LAS u32x4*)(Ws + wrow * WS + ws0 * 2) = w;
            }
            if (tid < 64) acum[tid] = ra0[0];
            LDS_BARRIER();
            if (c + 1 < 128) SSD_PREFETCH(0, c + 1);
            const float atot = acum[63];
            float al[4];
#pragma unroll
            for (int j = 0; j < 4; ++j) al[j] = acum[lm * 16 + fq * 4 + j];
            f32x4 aY0 = {0.f, 0.f, 0.f, 0.f}, aY1 = {0.f, 0.f, 0.f, 0.f}, aD = {0.f, 0.f, 0.f, 0.f};
#pragma unroll
            for (int ks = 0; ks < 4; ks += 2) {
                const bf16x8 a0 = *(const LAS bf16x8*)(Cs + (lm * 16 + fr) * CS + ks * 64 + fq * 16);
                const bf16x8 s0 = *(const LAS bf16x8*)(Stc + (c2 * 16 + fr) * CS + ks * 64 + fq * 16);
                const bf16x8 a1 = *(const LAS bf16x8*)(Cs + (lm * 16 + fr) * CS + (ks + 1) * 64 + fq * 16);
                const bf16x8 s1 = *(const LAS bf16x8*)(Stc + (c2 * 16 + fr) * CS + (ks + 1) * 64 + fq * 16);
                aY0 = __builtin_amdgcn_mfma_f32_16x16x32_bf16(a0, s0, aY0, 0, 0, 0);
                aY1 = __builtin_amdgcn_mfma_f32_16x16x32_bf16(a1, s1, aY1, 0, 0, 0);
            }
#pragma unroll
            for (int ks = 0; ks < 2; ++ks) {
                const bf16x8 a = *(const LAS bf16x8*)(Ws + (lm * 16 + fr) * WS + ks * 64 + fq * 16);
                const bf16x8 bx = tr_frag(Xs, XS, ks * 32, c2 * 16, lane);
                aD = __builtin_amdgcn_mfma_f32_16x16x32_bf16(a, bx, aD, 0, 0, 0);
            }
            {
                const int pc = c2 * 16 + fr;
                bf16_t* ob = xb + (size_t)(c * 64) * SINP + pc;
#pragma unroll
                for (int j = 0; j < 4; ++j) { const int l = lm * 16 + fq * 4 + j;
                    const float xv = bf2f(*(const LAS bf16_t*)(Xs + l * XS + pc * 2)), zv = bf2f(*(const LAS bf16_t*)(Zs + l * XS + pc * 2));
                    const float y = aD[j] + (aY0[j] + aY1[j]) * expf(al[j]) + dsk * xv;
                    ob[(size_t)l * SINP] = (bf16_t)f2bf(y * silu(zv)); }
            }
            const float sdec = expf(atot);
            accT[0] *= sdec; accT[1] *= sdec;
#pragma unroll
            for (int ks = 0; ks < 2; ++ks) {
                const bf16x8 an_ = tr_frag(Bs, CS, ks * 32, wid * 16, lane);
                const bf16x8 bp0 = tr_frag(Xw, XS, ks * 32, 0, lane);
                const bf16x8 bp1 = tr_frag(Xw, XS, ks * 32, 16, lane);
                accT[0] = __builtin_amdgcn_mfma_f32_16x16x32_bf16(an_, bp0, accT[0], 0, 0, 0);
                accT[1] = __builtin_amdgcn_mfma_f32_16x16x32_bf16(an_, bp1, accT[1], 0, 0, 0);
            }
#pragma unroll
            for (int pi = 0; pi < 2; ++pi) {
                u32x2 w; w.x = pk2(accT[pi][0], accT[pi][1]); w.y = pk2(accT[pi][2], accT[pi][3]);
                *(LAS u32x2*)(Stn + (pi * 16 + fr) * CS + (wid * 16 + fq * 4) * 2) = w;
            }
            LDS_BARRIER();
          }
        }
#undef SSD_PREFETCH
    }
}

__device__ __forceinline__ void ssd_norm(bf16_t* proj, const float* nw, int wg, int G) {
    const int tid_ = otid(); const int wave = tid_ >> 6, lane = tid_ & 63;
    constexpr int NP = 4;
    for (int pair0 = (wg * 8 + wave) * NP; pair0 < T * 8; pair0 += G * 8 * NP) {
        u32x4 yv[NP];
#pragma unroll
        for (int q = 0; q < NP; ++q) { const int pair = pair0 + q, t = pair >> 3, gr = pair & 7; yv[q] = *(const u32x4*)(proj + (size_t)t * SINP + 4096 + gr * 512 + lane * 8); }
#pragma unroll
        for (int q = 0; q < NP; ++q) { const int pair = pair0 + q, t = pair >> 3, gr = pair & 7;
            bf16_t* yp = proj + (size_t)t * SINP + 4096 + gr * 512 + lane * 8;
            float y[8] = {bflo(yv[q].x), bfhi(yv[q].x), bflo(yv[q].y), bfhi(yv[q].y), bflo(yv[q].z), bfhi(yv[q].z), bflo(yv[q].w), bfhi(yv[q].w)};
            float qq = 0.f;
#pragma unroll
            for (int e = 0; e < 8; ++e) qq += y[e] * y[e];
            const float r = rsqrtf(wave_sum(qq) * (1.0f / 512.0f) + 1e-6f);
            const f32x4 w0 = *(const f32x4*)(nw + gr * 512 + lane * 8), w1 = *(const f32x4*)(nw + gr * 512 + lane * 8 + 4);
            u32x4 w; w.x = pk2(y[0] * r * w0[0], y[1] * r * w0[1]); w.y = pk2(y[2] * r * w0[2], y[3] * r * w0[3]);
            w.z = pk2(y[4] * r * w1[0], y[5] * r * w1[1]); w.w = pk2(y[6] * r * w1[2], y[7] * r * w1[3]);
            *(u32x4*)yp = w; }
    }
}

#define XB_TMO      128
#define XB_XCNT(j)  (256  + 64 * (j))
#define XB_XSUB(j)  (1280 + 64 * (j))
#define XB_XGEN(j)  (2304 + 64 * (j))
#define XB_TOP      3328
#define XB_TOPGEN   3392
#define XCD_BAR_WORDS 3456
#define XB_SPIN_CAP (1u << 18)
__device__ __forceinline__ unsigned xb_ld(unsigned* p)              { return __hip_atomic_load(p, __ATOMIC_RELAXED, __HIP_MEMORY_SCOPE_AGENT); }
__device__ __forceinline__ unsigned xb_add(unsigned* p, unsigned v) { return __hip_atomic_fetch_add(p, v, __ATOMIC_RELAXED, __HIP_MEMORY_SCOPE_AGENT); }
__device__ __forceinline__ unsigned xb_xcc_id() { return (unsigned)__builtin_amdgcn_s_getreg((3 << 11) | 20) & 0xFu; }
#define XB_SPIN(cond, bar) do { unsigned _sp = 0; while (cond) { __builtin_amdgcn_s_sleep(1); \
    if ((++_sp & 255u) == 0u) { if (xb_ld(&(bar)[XB_TMO])) break; if (_sp > XB_SPIN_CAP) { atomicAdd(&(bar)[XB_TMO], 1u); break; } } } } while (0)
struct XcdBarrier { unsigned* bar; unsigned x; volatile LAS unsigned* st; };
__device__ __forceinline__ XcdBarrier xcd_barrier_post(unsigned* bar, volatile LAS unsigned* st) {
    XcdBarrier b; b.bar = bar; b.x = xb_xcc_id(); b.st = st;
    if (threadIdx.x == 0) (void)xb_add(&bar[XB_XCNT(b.x)], 1u);
    return b;
}
__device__ __forceinline__ void xcd_barrier_complete(unsigned* bar, unsigned x, unsigned& nloc, unsigned& nx) {
    const unsigned G = gridDim.x * gridDim.y * gridDim.z;
    unsigned sum, cnt, mine, sp = 0u;
    for (;;) {
        sum = 0u; cnt = 0u; mine = 0u;
#pragma unroll
        for (unsigned j = 0; j < 16; ++j) { const unsigned c = xb_ld(&bar[XB_XCNT(j)]); sum += c; cnt += (c > 0u) ? 1u : 0u; mine = (j == x) ? c : mine; }
        if (sum == G) break;
        __builtin_amdgcn_s_sleep(1);
        if ((++sp & 255u) == 0u) { if (xb_ld(&bar[XB_TMO])) break; if (sp > XB_SPIN_CAP) { atomicAdd(&bar[XB_TMO], 1u); break; } }
    }
    nloc = mine > 0u ? mine : 1u; nx = cnt > 0u ? cnt : 1u;
}
__device__ __forceinline__ void xcd_barrier(const XcdBarrier& b) {
    asm volatile("s_waitcnt vmcnt(0)" ::: "memory");
    __syncthreads();
    if (threadIdx.x == 0) {
        unsigned* bar = b.bar;
        __builtin_amdgcn_s_waitcnt(0);
        unsigned nloc = b.st[0], nx = b.st[1];
        if (nloc == 0u) { xcd_barrier_complete(bar, b.x, nloc, nx); b.st[0] = nloc; b.st[1] = nx; }
        const unsigned old = xb_add(&bar[XB_XSUB(b.x)], 1u);
        const unsigned gen = old / nloc;
        if (old + 1u == (gen + 1u) * nloc) {
            __builtin_amdgcn_fence(__ATOMIC_RELEASE, "agent");
            asm volatile("s_waitcnt vmcnt(0)" ::: "memory");
            const unsigned og = xb_add(&bar[XB_TOP], 1u);
            const unsigned tg = og / nx;
            if (og + 1u == (tg + 1u) * nx) xb_add(&bar[XB_TOPGEN], 1u);
            else XB_SPIN(xb_ld(&bar[XB_TOPGEN]) == tg, bar);
            __builtin_amdgcn_fence(__ATOMIC_ACQUIRE, "agent");
            xb_add(&bar[XB_XGEN(b.x)], 1u);
            asm volatile("s_waitcnt vmcnt(0)" ::: "memory");
        } else {
            XB_SPIN(xb_ld(&bar[XB_XGEN(b.x)]) == gen, bar);
            __builtin_amdgcn_fence(__ATOMIC_ACQUIRE, "agent");
            asm volatile("s_waitcnt vmcnt(0)" ::: "memory");
        }
    }
    __syncthreads();
}

struct Params {
    const float* x; const float* nmp; const float* nmq; const float* nfp; const float* nfq;
    const float* ret_w_in; const float* ret_gn_w; const float* ret_w_out;
    const float* ssd_w_in; const float* conv_w; const float* conv_b; const float* dt_bias; const float* a_log; const float* d_skip; const float* ssd_norm_w; const float* ssd_w_out;
    const float* w_up; const float* w_down;
    float* out; unsigned char* ws;
};


__global__ void __launch_bounds__(NTHREADS, 2) mega(Params p) {
    extern __shared__ __attribute__((aligned(16))) unsigned char lds_raw[];
    LAS unsigned char* lds = (LAS unsigned char*)lds_raw;
    cg::grid_group grid = cg::this_grid();
    const int G = gridDim.x, wg = blockIdx.x;
    bf16_t* WA = (bf16_t*)(p.ws + OFF_WA); bf16_t* WB = (bf16_t*)(p.ws + OFF_WB);
    bf16_t* ACT = (bf16_t*)(p.ws + OFF_ACT); bf16_t* U_ACT = (bf16_t*)(p.ws + OFF_ACT + HID_BYTES); bf16_t* F_ACT = (bf16_t*)(p.ws + OFF_ACT + HID_BYTES);
    bf16_t* U_R2 = (bf16_t*)(p.ws + OFF_R2); bf16_t* MF_R2 = (bf16_t*)(p.ws + OFF_R2);
    float* ROT = (float*)(p.ws + OFF_ROT); bf16_t* HALO = (bf16_t*)(p.ws + OFF_HALO); float* DTV = (float*)(p.ws + OFF_DTV); float* ACV = (float*)(p.ws + OFF_ACV); bf16_t* CBG = (bf16_t*)(p.ws + OFF_CBG); bf16_t* PG = (bf16_t*)p.out; bf16_t* HB1 = (bf16_t*)p.out; bf16_t* HB2 = (bf16_t*)(p.ws + OFF_ACT + HID_BYTES + 67108864);

#define GEMM(KIND, ...) do { const pg8::Gemm gd = pg8::Gemm{__VA_ARGS__}; pg8::StaticOrder S; S.init(gd.M, gd.N, G, wg); pg8::gemm_phase<KIND>(lds, gd, S); GSYNC(); } while (0)
    unsigned* barw = (unsigned*)(p.ws + OFF_BAR);
    volatile LAS unsigned* bst = (volatile LAS unsigned*)(lds + LDS_STAGE);
    if (wg == 0) for (int i = threadIdx.x; i < XCD_BAR_WORDS; i += NTHREADS) barw[i] = 0u;
    if (threadIdx.x < 2) bst[threadIdx.x] = 0u;
    norm_pass(NormDesc{0, p.x, nullptr, nullptr, nullptr, p.nmp, U_R2, 0, 0}, wg, G);
    convert_w(ConvDesc{p.ret_w_in, WA, 2048, RIN, RIN, 1}, lds, wg, G);
    convert_w(ConvDesc{p.ret_w_out, WB, 4096, 2048, 2048, 0}, lds, wg, G);
    rot_table(ROT, wg, G);
    grid.sync();
    const XcdBarrier xb = xcd_barrier_post(barw, bst);
#define GSYNC() xcd_barrier(xb)
    GEMM(3, U_R2, WA, T, RIN, 2048, 2048, 3, ACT, RIN, ROT);
    ret_pre(ACT, PG, lds, wg, G); GSYNC();
    ret_scan(ACT, PG, lds, wg, G); GSYNC();
    ret_gn(ACT, p.ret_gn_w, wg, G); GSYNC();
    GEMM(1, ACT + 8192, WB, T, 2048, 4096, RIN, 1, MF_R2, 2048, nullptr);
    norm_pass(NormDesc{1, MF_R2, p.x, HB1, p.nmq, p.nfp, U_ACT, 0, 1}, wg, G);
    convert_w(ConvDesc{p.w_up, WA, 2048, DFF, DFF, 0}, lds, wg, G);
    convert_w(ConvDesc{p.w_down, WB, DFF, 2048, 2048, 0}, lds, wg, G);
    GSYNC();
    GEMM(2, U_ACT, WA, T, DFF, 2048, 2048, 2, ACT, DFF, nullptr);
    GEMM(1, ACT, WB, T, 2048, DFF, DFF, 1, F_ACT, 2048, nullptr);
    norm_pass(NormDesc{1, F_ACT, HB1, HB1, p.nfq, p.nmp + DM, U_R2, 1, 1}, wg, G);
    convert_w(ConvDesc{p.ssd_w_in, WA, 2048, SIN, SINP, 0}, lds, wg, G);
    convert_w(ConvDesc{p.ssd_w_out, WB, 4096, 2048, 2048, 0}, lds, wg, G);
    GSYNC();
    GEMM(1, U_R2, WA, T, SINP, 2048, 2048, 1, ACT, SINP, nullptr);
    ssd_pre(ACT, HALO, DTV, ACV, p.dt_bias, p.a_log, wg, G); GSYNC();
    ssd_cb(ACT, HALO, p.conv_w, p.conv_b, CBG, lds, wg, G); GSYNC();
    ssd_scan(ACT, HALO, p.conv_w, p.conv_b, CBG, DTV, ACV, p.d_skip, lds, wg, G); GSYNC();
    ssd_norm(ACT, p.ssd_norm_w, wg, G); GSYNC();
    GEMM(1, ACT + 4096, WB, T, 2048, 4096, SINP, 1, MF_R2, 2048, nullptr);
    norm_pass(NormDesc{1, MF_R2, HB1, HB2, p.nmq + DM, p.nfp + DM, U_ACT, 1, 1}, wg, G);
    convert_w(ConvDesc{p.w_up + (size_t)2048 * DFF, WA, 2048, DFF, DFF, 0}, lds, wg, G);
    convert_w(ConvDesc{p.w_down + (size_t)DFF * 2048, WB, DFF, 2048, 2048, 0}, lds, wg, G);
    GSYNC();
    GEMM(2, U_ACT, WA, T, DFF, 2048, 2048, 2, ACT, DFF, nullptr);
    GEMM(1, ACT, WB, T, 2048, DFF, DFF, 1, F_ACT, 2048, nullptr);
    norm_pass(NormDesc{2, F_ACT, HB2, p.out, p.nfq + DM, nullptr, nullptr, 1, 0}, wg, G);
#undef GEMM
#undef GSYNC
}

extern "C" void kernel_launch(void* const* d_in, const int* in_sizes, int n_in, void* d_out, int out_size, void* d_ws, size_t ws_size, hipStream_t stream) {
    static int grid_blocks = 0;
    if (!grid_blocks) {
        int dev = 0, cus = 0, per_cu = 0;
        hipGetDevice(&dev);
        hipDeviceGetAttribute(&cus, hipDeviceAttributeMultiprocessorCount, dev);
        hipFuncSetAttribute((const void*)mega, hipFuncAttributeMaxDynamicSharedMemorySize, LDS_BYTES);
        hipOccupancyMaxActiveBlocksPerMultiprocessor(&per_cu, (const void*)mega, NTHREADS, LDS_BYTES);
        if (per_cu < 1) per_cu = 1;
        grid_blocks = cus * per_cu;
        if (ws_size < WS_END) { fprintf(stderr, "kernel_launch: workspace too small: %zu < %zu\n", ws_size, (size_t)WS_END); grid_blocks = -1; }
    }
    if (grid_blocks < 0) return;
    Params p{};
    p.x = (const float*)d_in[0]; p.nmp = (const float*)d_in[1]; p.nmq = (const float*)d_in[2]; p.nfp = (const float*)d_in[3]; p.nfq = (const float*)d_in[4];
    p.ret_w_in = (const float*)d_in[5]; p.ret_gn_w = (const float*)d_in[6]; p.ret_w_out = (const float*)d_in[7];
    p.ssd_w_in = (const float*)d_in[8]; p.conv_w = (const float*)d_in[9]; p.conv_b = (const float*)d_in[10]; p.dt_bias = (const float*)d_in[11];
    p.a_log = (const float*)d_in[12]; p.d_skip = (const float*)d_in[13]; p.ssd_norm_w = (const float*)d_in[14]; p.ssd_w_out = (const float*)d_in[15];
    p.w_up = (const float*)d_in[16]; p.w_down = (const float*)d_in[17];
    p.out = (float*)d_out; p.ws = (unsigned char*)d_ws;
    void* args[] = {&p};
    hipError_t e = hipLaunchCooperativeKernel((const void*)mega, dim3(grid_blocks), dim3(NTHREADS), args, LDS_BYTES, stream);
    if (e != hipSuccess) fprintf(stderr, "cooperative launch failed: %s (grid %d)\n", hipGetErrorString(e), grid_blocks);
}
```

```cpp
#include <hip/hip_runtime.h>
#include <hip/hip_cooperative_groups.h>
#include <cstdio>
namespace cg = cooperative_groups;

#define LAS __attribute__((address_space(3)))
typedef unsigned short bf16_t;
typedef short bf16x8 __attribute__((ext_vector_type(8)));
typedef short s16x4 __attribute__((ext_vector_type(4)));
typedef float f32x4 __attribute__((ext_vector_type(4)));
typedef float f32x2 __attribute__((ext_vector_type(2)));
typedef unsigned u32x4 __attribute__((ext_vector_type(4)));
typedef unsigned u32x2 __attribute__((ext_vector_type(2)));

constexpr int T = 16384, DM = 2048, SEQ = 8192;
constexpr int RIN = 12288;
constexpr int SIN = 10304, SINP = 10496, SINW = 10368, SING = 10240;
constexpr int DFF = 8192;
constexpr int NTHREADS = 512;
constexpr int LDS_STAGE = 131072;
constexpr int LDS_BYTES = LDS_STAGE + 16;

constexpr size_t OFF_WA = 0;
constexpr size_t OFF_WB = 50331648;
constexpr size_t OFF_ACT = OFF_WB + 33554432;
constexpr size_t ACT_BYTES = 402653184;
constexpr size_t HID_BYTES = 268435456;
constexpr size_t OFF_R2 = OFF_ACT + ACT_BYTES;
constexpr size_t R2_BYTES = 134217728;
constexpr size_t OFF_ROT = OFF_R2 + 67108864;
constexpr size_t OFF_HALO = OFF_R2 + 67108864;
constexpr size_t OFF_DTV = OFF_R2 + 67108864 + 16777216;
constexpr size_t OFF_ACV = OFF_DTV + 4194304;
constexpr size_t OFF_CBG = OFF_R2 + 109051904;
constexpr size_t OFF_BAR = OFF_R2 + 100663296;
constexpr size_t WS_END = OFF_R2 + R2_BYTES;

typedef __bf16 bf16x2v __attribute__((ext_vector_type(2)));
__device__ __forceinline__ unsigned cvt_pk_bf16(float lo, float hi) { const f32x2 v = {lo, hi}; const bf16x2v b = __builtin_convertvector(v, bf16x2v); return __builtin_bit_cast(unsigned, b); }
__device__ __forceinline__ unsigned pk2(float lo, float hi) { return cvt_pk_bf16(lo, hi); }
__device__ __forceinline__ unsigned f2bf(float f) { return (unsigned)__builtin_bit_cast(unsigned short, (__bf16)f); }
__device__ __forceinline__ float bflo(unsigned w) { return __uint_as_float(w << 16); }
__device__ __forceinline__ float bfhi(unsigned w) { return __uint_as_float(w & 0xffff0000u); }
__device__ __forceinline__ float bf2f(bf16_t b) { return __uint_as_float(((unsigned)b) << 16); }
__device__ __forceinline__ float wave_sum(float v) {
#pragma unroll
    for (int o = 32; o >= 1; o >>= 1) v += __shfl_xor(v, o);
    return v;
}
__device__ __forceinline__ int otid() { int t = threadIdx.x; asm volatile("" : "+v"(t)); return t; }
#define LDS_BARRIER() do { asm volatile("s_waitcnt lgkmcnt(0)" ::: "memory"); __builtin_amdgcn_s_barrier(); asm volatile("" ::: "memory"); } while (0)
__device__ __forceinline__ float silu(float x) { return x * __builtin_amdgcn_rcpf(1.0f + __expf(-x)); }

__device__ __forceinline__ bf16x8 tr_frag(LAS unsigned char* img, int rs, int kbase, int n0, int lane) {
    const int g = lane >> 4, q = (lane & 15) >> 2, p = lane & 3;
    LAS unsigned char* a0 = img + (kbase + 8 * g + q) * rs + (n0 + 4 * p) * 2;
    s16x4 a = __builtin_amdgcn_ds_read_tr16_b64_v4i16((LAS s16x4*)a0);
    s16x4 b = __builtin_amdgcn_ds_read_tr16_b64_v4i16((LAS s16x4*)(a0 + 4 * rs));
    bf16x8 r = {a[0], a[1], a[2], a[3], b[0], b[1], b[2], b[3]};
    return r;
}

namespace pg8 {
constexpr int BM = 256, BK = 64, HALF = 128, HTB = HALF * BK * 2, STAGE_BYTES = 8 * HTB, NXCD = 8, WGM = 8;
__device__ __forceinline__ int lds_byte(int r, int c) { const int st = (r >> 4) * 2 + (c >> 5), rr = r & 15, cc = c & 31, ob = rr * 64 + cc * 2; return st * 1024 + (ob ^ (((ob >> 9) & 1) << 5)); }
__device__ __forceinline__ void stage_rc(int b, int& R, int& C) { const int st = b / 1024, sb = b % 1024, swz = sb ^ (((sb >> 9) & 1) << 5); R = (st >> 1) * 16 + swz / 64; C = (st & 1) * 32 + (swz % 64) / 2; }
__device__ __forceinline__ int perm32(int rho) { const int n = rho >> 4, i = rho & 15; return 8 * (i >> 2) + 4 * n + (i & 3); }
struct Unit { int pm, pn; };
struct Gemm { const bf16_t* A; const bf16_t* Bt; int M, N, K, lda; int kind; void* out; int ldc; const float* rot; };
struct StaticOrder {
    int nM, nN, nwg, G, c;
    __device__ void init(int M, int N, int G_, int c_) { nM = M / BM; nN = N / BM; nwg = nM * nN; G = G_; c = c_; }
    __device__ bool next(int i, Unit& u) const {
        const long L = (long)i * G + c; if (L >= nwg) return false;
        int wgid = (int)L; { const int q = nwg / NXCD, r = nwg % NXCD, xcd = wgid % NXCD, off = wgid / NXCD; wgid = (xcd < r ? xcd * (q + 1) : r * (q + 1) + (xcd - r) * q) + off; }
        const int nig = WGM * nN, gid = wgid / nig, fm = gid * WGM, gsz = (nM - fm) < WGM ? (nM - fm) : WGM;
        u.pm = fm + ((wgid % nig) % gsz); u.pn = (wgid % nig) / gsz; return true;
    }
};

template <int KIND> __device__ __forceinline__ void epilogue(const Gemm& g, const f32x4 (&acc)[2][2][4][2], const Unit& u, int wr, int wc, int fr, int fq) {
    if constexpr (KIND == 0) {
        float* C = (float*)g.out; const int ldc = g.ldc;
        const int row0 = u.pm * BM + wr * 64 + fr, col0 = u.pn * BM + wc * 32 + 4 * fq;
#pragma unroll
        for (int ai = 0; ai < 2; ++ai)
#pragma unroll
            for (int m = 0; m < 4; ++m) { float* rowp = C + (size_t)(row0 + ai * HALF + m * 16) * ldc + col0;
#pragma unroll
                for (int bj = 0; bj < 2; ++bj)
#pragma unroll
                    for (int n = 0; n < 2; ++n) *(f32x4*)(rowp + bj * HALF + n * 16) = acc[ai][bj][m][n]; }
    } else {
        bf16_t* O = (bf16_t*)g.out; const int ldc = g.ldc;
        const int row0 = u.pm * BM + wr * 64 + fr, col0 = u.pn * BM + wc * 32 + 8 * fq;
        const bool isrot = (KIND == 3) && (u.pn < 16);
        const float sc = (u.pn >= 8) ? 0.0625f : 1.0f;
        constexpr bool relu2 = (KIND == 2);
#pragma unroll
        for (int ai = 0; ai < 2; ++ai)
#pragma unroll
            for (int m = 0; m < 4; ++m) {
                const int row = row0 + ai * HALF + m * 16;
                bf16_t* rowp = O + (size_t)row * ldc + col0;
                const int pos = row & (SEQ - 1);
#pragma unroll
                for (int bj = 0; bj < 2; ++bj) {
                    f32x4 v0 = acc[ai][bj][m][0], v1 = acc[ai][bj][m][1];
                    if (relu2) {
#pragma unroll
                        for (int j = 0; j < 4; ++j) { const float a = fmaxf(v0[j], 0.f), b = fmaxf(v1[j], 0.f); v0[j] = a * a; v1[j] = b * b; }
                    }
                    if (isrot) {
                        const float* rp = g.rot + ((size_t)pos * 128 + 64 * bj + 16 * wc + 4 * fq) * 2;
                        const f32x4 c0 = *(const f32x4*)rp, c1 = *(const f32x4*)(rp + 4);
                        f32x4 r0, r1;
                        r0[0] = v0[0] * c0[0] - v0[1] * c0[1]; r0[1] = v0[0] * c0[1] + v0[1] * c0[0];
                        r0[2] = v0[2] * c0[2] - v0[3] * c0[3]; r0[3] = v0[2] * c0[3] + v0[3] * c0[2];
                        r1[0] = v1[0] * c1[0] - v1[1] * c1[1]; r1[1] = v1[0] * c1[1] + v1[1] * c1[0];
                        r1[2] = v1[2] * c1[2] - v1[3] * c1[3]; r1[3] = v1[2] * c1[3] + v1[3] * c1[2];
                        v0 = r0 * sc; v1 = r1 * sc;
                    }
                    u32x4 w; w.x = cvt_pk_bf16(v0[0], v0[1]); w.y = cvt_pk_bf16(v0[2], v0[3]); w.z = cvt_pk_bf16(v1[0], v1[1]); w.w = cvt_pk_bf16(v1[2], v1[3]);
                    *(u32x4*)(rowp + bj * HALF) = w;
                    if constexpr (KIND == 5) {
                        if (m == 3 && fr >= 13 && u.pn >= 16) *(u32x4*)((bf16_t*)g.rot + ((size_t)(row >> 6) * 3 + (fr - 13)) * 6144 + (col0 - 4096) + bj * HALF) = w;
                    }
                }
            }
    }
}

template <int KIND> __device__ __forceinline__ void gemm_phase(LAS unsigned char* lds, const Gemm g, const StaticOrder& S) {
    const int tid = otid(), wid = __builtin_amdgcn_readfirstlane(tid >> 6), lane = tid & 63, wr = wid >> 2, wc = wid & 3, fr = lane & 15, fq = lane >> 4;
    const int K = g.K, nt = K / BK, lda = g.lda;
    constexpr bool perm = KIND != 0;
    unsigned voffA[2], voffB[2];
#pragma unroll
    for (int i = 0; i < 2; ++i) { int R, C; stage_rc(tid * 16 + i * 8192, R, C); const int Rb = perm ? ((R & ~31) + perm32(R & 31)) : R;
        voffA[i] = (unsigned)(R * lda + C) * 2u; voffB[i] = (unsigned)(Rb * K + C) * 2u; }
    const size_t kstep = (size_t)(BK * 2);
    const size_t hstepA = (size_t)HALF * lda * 2, hstepB = (size_t)HALF * K * 2;
    const size_t tstepA = 2 * hstepA, tstepB = 2 * hstepB;
    const unsigned ldsw = (unsigned)wid * 1024u;
    const int aoff = lds_byte(wr * 64 + fr, fq * 8), boff = lds_byte(wc * 32 + fr, fq * 8);
#define PG8_SA(b, h) (((b) * 2 + (h)) * HTB)
#define PG8_SB(b, h) ((4 + (b) * 2 + (h)) * HTB)
#define PG8_STAGE(bufoff, gbase, voff) do { _Pragma("unroll") for (int _i = 0; _i < 2; ++_i) \
        __builtin_amdgcn_global_load_lds((const unsigned*)((const char*)(gbase) + (voff)[_i]), (LAS unsigned*)(lds + (bufoff) + ldsw + _i * 8192), 16, 0, 0); } while (0)
#define PG8_LDA(dst, b, h) do { _Pragma("unroll") for (int m = 0; m < 4; ++m) _Pragma("unroll") for (int k = 0; k < 2; ++k) dst[m][k] = *(const LAS bf16x8*)(lds + PG8_SA(b, h) + aoff + m * 2048 + k * 1024); } while (0)
#define PG8_LDB(dst, b, h) do { _Pragma("unroll") for (int n = 0; n < 2; ++n) _Pragma("unroll") for (int k = 0; k < 2; ++k) dst[n][k] = *(const LAS bf16x8*)(lds + PG8_SB(b, h) + boff + n * 2048 + k * 1024); } while (0)
#define PG8_MMA(ai, bj, At, Bt) do { __builtin_amdgcn_s_setprio(1); _Pragma("unroll") for (int m = 0; m < 4; ++m) _Pragma("unroll") for (int n = 0; n < 2; ++n) _Pragma("unroll") for (int k = 0; k < 2; ++k) \
        acc[ai][bj][m][n] = __builtin_amdgcn_mfma_f32_16x16x32_bf16(Bt[n][k], At[m][k], acc[ai][bj][m][n], 0, 0, 0); __builtin_amdgcn_s_setprio(0); } while (0)
#define PG8_WAIT_V(n) asm volatile("s_waitcnt vmcnt(" #n ")" ::: "memory")
#define PG8_WAIT_L(n) asm volatile("s_waitcnt lgkmcnt(" #n ")" ::: "memory")
#define PG8_BAR __builtin_amdgcn_s_barrier()
#define PG8_SCHED __builtin_amdgcn_sched_barrier(0)
    Unit cur, nxt; int ui = 0;
    if (!S.next(0, cur)) return;
    f32x4 acc[2][2][4][2];
#pragma unroll
    for (int a = 0; a < 2; ++a)
#pragma unroll
        for (int b = 0; b < 2; ++b)
#pragma unroll
            for (int m = 0; m < 4; ++m)
#pragma unroll
                for (int n = 0; n < 2; ++n) acc[a][b][m][n] = (f32x4){0.f, 0.f, 0.f, 0.f};
    bf16x8 At[4][2], B0[2][2], B1[2][2];
    const char* cA = (const char*)g.A + (size_t)cur.pm * tstepA; const char* cB = (const char*)g.Bt + (size_t)cur.pn * tstepB;
    PG8_STAGE(PG8_SB(0, 0), cB, voffB); PG8_STAGE(PG8_SA(0, 0), cA, voffA); PG8_STAGE(PG8_SB(0, 1), cB + hstepB, voffB); PG8_STAGE(PG8_SA(0, 1), cA + hstepA, voffA);
    if (wr == 1) PG8_BAR;
    PG8_WAIT_V(4); PG8_BAR;
    PG8_STAGE(PG8_SB(1, 0), cB + kstep, voffB); PG8_STAGE(PG8_SA(1, 0), cA + kstep, voffA); PG8_STAGE(PG8_SB(1, 1), cB + hstepB + kstep, voffB);
    PG8_WAIT_V(6); PG8_BAR;
    for (;;) {
        const bool has_next = S.next(ui + 1, nxt);
        const char* nA = has_next ? (const char*)g.A + (size_t)nxt.pm * tstepA : cA; const char* nB = has_next ? (const char*)g.Bt + (size_t)nxt.pn * tstepB : cB;
        for (int t = 0; t < nt; t += 2) {
            const bool last = (t == nt - 2);
            const char* a1 = cA + (size_t)(t + 1) * kstep;
            const char* a2 = last ? nA : cA + (size_t)(t + 2) * kstep; const char* b2 = last ? nB : cB + (size_t)(t + 2) * kstep;
            const char* a3 = a2 + kstep; const char* b3 = b2 + kstep;
            PG8_LDB(B0, 0, 0); PG8_SCHED; PG8_LDA(At, 0, 0); PG8_STAGE(PG8_SA(1, 1), a1 + hstepA, voffA);
            PG8_WAIT_L(8); PG8_BAR; PG8_WAIT_L(0); PG8_MMA(0, 0, At, B0); PG8_BAR; PG8_SCHED;
            PG8_LDB(B1, 0, 1); PG8_STAGE(PG8_SB(0, 0), b2, voffB);
            PG8_BAR; PG8_WAIT_L(0); PG8_MMA(0, 1, At, B1); PG8_BAR;
            PG8_LDA(At, 0, 1); PG8_STAGE(PG8_SA(0, 0), a2, voffA);
            PG8_BAR; PG8_WAIT_L(0); PG8_MMA(1, 0, At, B0); PG8_BAR; PG8_SCHED;
            PG8_STAGE(PG8_SB(0, 1), b2 + hstepB, voffB);
            PG8_WAIT_V(6); PG8_BAR; PG8_MMA(1, 1, At, B1); PG8_BAR;
            PG8_LDB(B0, 1, 0); PG8_SCHED; PG8_LDA(At, 1, 0); PG8_STAGE(PG8_SA(0, 1), a2 + hstepA, voffA);
            PG8_WAIT_L(8); PG8_BAR; PG8_WAIT_L(0); PG8_MMA(0, 0, At, B0); PG8_BAR; PG8_SCHED;
            PG8_LDB(B1, 1, 1); PG8_STAGE(PG8_SB(1, 0), b3, voffB);
            PG8_BAR; PG8_WAIT_L(0); PG8_MMA(0, 1, At, B1); PG8_BAR;
            PG8_LDA(At, 1, 1); PG8_STAGE(PG8_SA(1, 0), a3, voffA);
            PG8_BAR; PG8_WAIT_L(0); PG8_MMA(1, 0, At, B0); PG8_BAR; PG8_SCHED;
            PG8_STAGE(PG8_SB(1, 1), b3 + hstepB, voffB);
            PG8_WAIT_V(6); PG8_BAR; PG8_MMA(1, 1, At, B1); PG8_BAR;
        }
        epilogue<KIND>(g, acc, cur, wr, wc, fr, fq);
        if (!has_next) break;
#pragma unroll
        for (int a = 0; a < 2; ++a)
#pragma unroll
            for (int b = 0; b < 2; ++b)
#pragma unroll
                for (int m = 0; m < 4; ++m)
#pragma unroll
                    for (int n = 0; n < 2; ++n) acc[a][b][m][n] = (f32x4){0.f, 0.f, 0.f, 0.f};
        cur = nxt; cA = nA; cB = nB; ++ui;
    }
    PG8_WAIT_V(0);
    if (wr == 0) PG8_BAR;
    PG8_BAR;
#undef PG8_SA
#undef PG8_SB
#undef PG8_STAGE
#undef PG8_LDA
#undef PG8_LDB
#undef PG8_MMA
#undef PG8_WAIT_V
#undef PG8_WAIT_L
#undef PG8_BAR
#undef PG8_SCHED
}
}

struct ConvDesc { const float* src; bf16_t* dst; int K, Nsrc, Ndst, permq; };
__device__ __forceinline__ void convert_w(const ConvDesc& c, LAS unsigned char* lds, int wg, int G) {
    const int tid = otid();
    constexpr int RS = 144;
    const int nnt = c.Ndst / 128, ntile = (c.K / 64) * nnt;
    const int c4 = tid & 31, kq = tid >> 5;
    f32x4 r[4];
#define CW_LOAD(u_) do { const int nt_ = (u_) % nnt, kt_ = (u_) / nnt; const int col_ = nt_ * 128 + c4 * 4; \
        const float* sp_ = c.src + (size_t)(kt_ * 64 + kq * 4) * c.Nsrc + col_; const bool ok_ = col_ < c.Nsrc; \
        _Pragma("unroll") for (int i_ = 0; i_ < 4; ++i_) r[i_] = ok_ ? *(const f32x4*)(sp_ + (size_t)i_ * c.Nsrc) : (f32x4){0.f, 0.f, 0.f, 0.f}; } while (0)
    int u = wg;
    if (u < ntile) CW_LOAD(u);
    while (u < ntile) {
#pragma unroll
        for (int e = 0; e < 4; ++e) { u32x2 w; w.x = pk2(r[0][e], r[1][e]); w.y = pk2(r[2][e], r[3][e]); *(LAS u32x2*)(lds + (c4 * 4 + e) * RS + kq * 8) = w; }
        const int un = u + G;
        if (un < ntile) CW_LOAD(un);
        LDS_BARRIER();
        {
            const int nt = u % nnt, kt = u / nnt, n0 = nt * 128;
            const bool pm = c.permq && n0 < 4096;
#pragma unroll
            for (int i = 0; i < 2; ++i) { const int idx = i * 512 + tid, row = idx >> 3, kb = idx & 7;
                const u32x4 v = *(const LAS u32x4*)(lds + row * RS + kb * 16);
                const int drow = pm ? ((n0 & ~255) + 2 * row + ((n0 >> 7) & 1)) : (n0 + row);
                *(u32x4*)(c.dst + (size_t)drow * c.K + kt * 64 + kb * 8) = v; }
        }
        LDS_BARRIER();
        u = un;
    }
#undef CW_LOAD
}

struct NormDesc { int mode; const void* m; const void* hres; void* hout; const float* wpost; const float* wpre; bf16_t* ub; int hin_bf16, hout_bf16; };
__device__ __forceinline__ void norm_pass(const NormDesc& d, int wg, int G) {
    const int tid_ = otid(); const int wave = tid_ >> 6, lane = tid_ & 63;
    constexpr int NR = 2;
    for (int row0 = (wg * 8 + wave) * NR; row0 < T; row0 += G * 8 * NR) {
        float v[NR][4][8]; float ss[NR], r[NR], r2[NR];
#pragma unroll
        for (int q = 0; q < NR; ++q) {
            const size_t ro = (size_t)(row0 + q) * DM;
            if (d.mode == 0) {
#pragma unroll
                for (int i = 0; i < 4; ++i) { const int c = (i * 64 + lane) * 8; const f32x4 a = *(const f32x4*)((const float*)d.m + ro + c), b = *(const f32x4*)((const float*)d.m + ro + c + 4);
#pragma unroll
                    for (int e = 0; e < 4; ++e) { v[q][i][e] = a[e]; v[q][i][4 + e] = b[e]; } }
            } else {
#pragma unroll
                for (int i = 0; i < 4; ++i) { const int c = (i * 64 + lane) * 8; const u32x4 a = *(const u32x4*)((const bf16_t*)d.m + ro + c);
                    v[q][i][0] = bflo(a.x); v[q][i][1] = bfhi(a.x); v[q][i][2] = bflo(a.y); v[q][i][3] = bfhi(a.y); v[q][i][4] = bflo(a.z); v[q][i][5] = bfhi(a.z); v[q][i][6] = bflo(a.w); v[q][i][7] = bfhi(a.w); }
            }
        }
#pragma unroll
        for (int q = 0; q < NR; ++q) {
            float s = 0.f;
#pragma unroll
            for (int i = 0; i < 4; ++i)
#pragma unroll
                for (int e = 0; e < 8; ++e) s += v[q][i][e] * v[q][i][e];
            ss[q] = s;
        }
#pragma unroll
        for (int q = 0; q < NR; ++q) { ss[q] = wave_sum(ss[q]); r[q] = rsqrtf(ss[q] * (1.0f / DM) + 1e-6f); r2[q] = r[q]; }
        if (d.mode != 0) {
            float s2[NR];
#pragma unroll
            for (int q = 0; q < NR; ++q) {
                const size_t ro = (size_t)(row0 + q) * DM;
                float s = 0.f;
#pragma unroll
                for (int i = 0; i < 4; ++i) { const int c = (i * 64 + lane) * 8;
                    const f32x4 w0 = *(const f32x4*)(d.wpost + c), w1 = *(const f32x4*)(d.wpost + c + 4);
                    f32x4 h0, h1;
                    if (d.hin_bf16) { const u32x4 hv = *(const u32x4*)((const bf16_t*)d.hres + ro + c); h0[0] = bflo(hv.x); h0[1] = bfhi(hv.x); h0[2] = bflo(hv.y); h0[3] = bfhi(hv.y); h1[0] = bflo(hv.z); h1[1] = bfhi(hv.z); h1[2] = bflo(hv.w); h1[3] = bfhi(hv.w); }
                    else { h0 = *(const f32x4*)((const float*)d.hres + ro + c); h1 = *(const f32x4*)((const float*)d.hres + ro + c + 4); }
                    f32x4 o0, o1;
#pragma unroll
                    for (int e = 0; e < 4; ++e) { o0[e] = h0[e] + v[q][i][e] * r[q] * w0[e]; o1[e] = h1[e] + v[q][i][4 + e] * r[q] * w1[e]; v[q][i][e] = o0[e]; v[q][i][4 + e] = o1[e]; s += o0[e] * o0[e] + o1[e] * o1[e]; }
                    if (d.hout_bf16) { u32x4 hw; hw.x = pk2(o0[0], o0[1]); hw.y = pk2(o0[2], o0[3]); hw.z = pk2(o1[0], o1[1]); hw.w = pk2(o1[2], o1[3]); *(u32x4*)((bf16_t*)d.hout + ro + c) = hw; }
                    else { *(f32x4*)((float*)d.hout + ro + c) = o0; *(f32x4*)((float*)d.hout + ro + c + 4) = o1; } }
                s2[q] = s;
            }
            if (d.mode == 1) {
#pragma unroll
                for (int q = 0; q < NR; ++q) { s2[q] = wave_sum(s2[q]); r2[q] = rsqrtf(s2[q] * (1.0f / DM) + 1e-6f); }
            }
        }
        if (d.mode != 2) {
#pragma unroll
            for (int q = 0; q < NR; ++q) {
                const size_t ro = (size_t)(row0 + q) * DM;
#pragma unroll
                for (int i = 0; i < 4; ++i) { const int c = (i * 64 + lane) * 8;
                    const f32x4 w0 = *(const f32x4*)(d.wpre + c), w1 = *(const f32x4*)(d.wpre + c + 4);
                    u32x4 o; o.x = pk2(v[q][i][0] * r2[q] * w0[0], v[q][i][1] * r2[q] * w0[1]); o.y = pk2(v[q][i][2] * r2[q] * w0[2], v[q][i][3] * r2[q] * w0[3]);
                    o.z = pk2(v[q][i][4] * r2[q] * w1[0], v[q][i][5] * r2[q] * w1[1]); o.w = pk2(v[q][i][6] * r2[q] * w1[2], v[q][i][7] * r2[q] * w1[3]);
                    *(u32x4*)(d.ub + ro + c) = o; }
            }
        }
    }
}

__device__ __forceinline__ void rot_table(float* rot, int wg, int G) {
    for (int e = wg * NTHREADS + otid(); e < SEQ * 128; e += G * NTHREADS) {
        const int pos = e >> 7, jf = e & 127;
        const float inv = exp2f(-(float)jf * (13.287712379549449f / 128.0f));
        const float ang = (float)pos * inv;
        const double a = (double)ang; const double k = rint(a * 0.15915494309189535); const float rf = (float)(a - k * 6.283185307179586);
        f32x2 cs; cs.x = cosf(rf); cs.y = sinf(rf);
        *(f32x2*)(rot + 2 * (size_t)e) = cs;
    }
}

__device__ __forceinline__ void ret_pre(const bf16_t* proj, bf16_t* Pg, LAS unsigned char* lds, int wg, int G) {
    const int tid = otid(), lane = tid & 63, wid = __builtin_amdgcn_readfirstlane(tid >> 6), fr = lane & 15, fq = lane >> 4;
    constexpr int QS = 528;
    LAS unsigned char* Qs = lds; LAS unsigned char* Ks = lds + 33792;
    const int lm = wid >> 1, c2 = wid & 1;
    u32x4 rq[4], rk[4];
    int u = wg;
    if (u < 2048) {
        const bf16_t* qb = proj + (size_t)((u >> 3) * 64) * RIN + (u & 7) * 256;
#pragma unroll
        for (int i = 0; i < 4; ++i) { const int idx = i * 512 + tid, row = idx >> 5, ch = idx & 31; rq[i] = *(const u32x4*)(qb + (size_t)row * RIN + ch * 8); rk[i] = *(const u32x4*)(qb + 2048 + (size_t)row * RIN + ch * 8); }
    }
    for (; u < 2048; u += G) {
        const int h = u & 7, t0 = (u >> 3) * 64;
#pragma unroll
        for (int i = 0; i < 4; ++i) { const int idx = i * 512 + tid, row = idx >> 5, ch = idx & 31; *(LAS u32x4*)(Qs + row * QS + ch * 16) = rq[i]; *(LAS u32x4*)(Ks + row * QS + ch * 16) = rk[i]; }
        LDS_BARRIER();
        const int un = u + G;
        if (un < 2048) {
            const bf16_t* qb = proj + (size_t)((un >> 3) * 64) * RIN + (un & 7) * 256;
#pragma unroll
            for (int i = 0; i < 4; ++i) { const int idx = i * 512 + tid, row = idx >> 5, ch = idx & 31; rq[i] = *(const u32x4*)(qb + (size_t)row * RIN + ch * 8); rk[i] = *(const u32x4*)(qb + 2048 + (size_t)row * RIN + ch * 8); }
        }
        const float lg = log1pf(-exp2f(-5.0f - (float)h));
        f32x4 aP0 = {0.f, 0.f, 0.f, 0.f}, aP1 = {0.f, 0.f, 0.f, 0.f};
#pragma unroll
        for (int ks = 0; ks < 8; ++ks) {
            const bf16x8 a = *(const LAS bf16x8*)(Qs + (lm * 16 + fr) * QS + ks * 64 + fq * 16);
            const bf16x8 b0 = *(const LAS bf16x8*)(Ks + ((c2 * 2 + 0) * 16 + fr) * QS + ks * 64 + fq * 16);
            const bf16x8 b1 = *(const LAS bf16x8*)(Ks + ((c2 * 2 + 1) * 16 + fr) * QS + ks * 64 + fq * 16);
            aP0 = __builtin_amdgcn_mfma_f32_16x16x32_bf16(a, b0, aP0, 0, 0, 0);
            aP1 = __builtin_amdgcn_mfma_f32_16x16x32_bf16(a, b1, aP1, 0, 0, 0);
        }
#pragma unroll
        for (int j = 0; j < 4; ++j) { const int l = lm * 16 + fq * 4 + j;
            const int m0 = (c2 * 2 + 0) * 16 + fr, m1 = m0 + 16;
            const int d0 = l > m0 ? l - m0 : m0 - l, d1 = l > m1 ? l - m1 : m1 - l;
            bf16_t* pp = Pg + ((size_t)(t0 + l) * 8 + h) * 64;
            pp[m0] = (bf16_t)f2bf(aP0[j] * expf((float)d0 * lg));
            pp[m1] = (bf16_t)f2bf(aP1[j] * expf((float)d1 * lg)); }
        LDS_BARRIER();
    }
}

__device__ __forceinline__ void ret_scan(bf16_t* proj, const bf16_t* Pg, LAS unsigned char* lds, int wg, int G) {
    const int tid = otid(), lane = tid & 63, wid = __builtin_amdgcn_readfirstlane(tid >> 6), fr = lane & 15, fq = lane >> 4;
    constexpr int QS = 528, VS = 80, PS = 144;
    LAS unsigned char* Qs = lds; LAS unsigned char* Ks = lds + 33792; LAS unsigned char* Vs = lds + 67584; LAS unsigned char* Vz = lds + 72704;
    LAS unsigned char* Ps = lds + 77824; LAS unsigned char* St0 = lds + 87040;
    const int lm = wid >> 1, c2 = wid & 1;
    for (int unit = wg; unit < 256; unit += G) {
        const int xc = unit & 7, ii = unit >> 3, bh = xc * 2 + (ii >> 4), vs = ii & 15, b = bh >> 3, h = bh & 7;
        const float lg = log1pf(-exp2f(-5.0f - (float)h));
        float xi[4];
#pragma unroll
        for (int j = 0; j < 4; ++j) { const int l = lm * 16 + fq * 4 + j; xi[j] = expf((float)(l + 1) * lg); }
        const float cdecay = expf(64.0f * lg);
        const int vrow = (tid & 255) >> 2, vch = tid & 3;
        const float zeta = expf((float)(63 - vrow) * lg);
        const int prow = tid >> 3, pch = tid & 7;
        f32x4 accS[2][2];
#pragma unroll
        for (int a = 0; a < 2; ++a)
#pragma unroll
            for (int c = 0; c < 2; ++c) accS[a][c] = (f32x4){0.f, 0.f, 0.f, 0.f};
        for (int i = tid; i < 16896 / 4; i += NTHREADS) ((LAS unsigned*)St0)[i] = 0u;
        const bf16_t* qb = proj + (size_t)(b * SEQ) * RIN + h * 256;
        const bf16_t* kb = qb + 2048;
        bf16_t* vb = proj + (size_t)(b * SEQ) * RIN + 4096 + h * 512 + vs * 32;
        const bf16_t* pb = Pg + ((size_t)(b * SEQ + prow) * 8 + h) * 64 + pch * 8;
        u32x4 rq[2][4], rk[2][4], rv[2], rp[2];
#define RET_LOAD(S_, cc_) do { const size_t ro_ = (size_t)(cc_) * 64 * RIN; \
            _Pragma("unroll") for (int i = 0; i < 4; ++i) { const int idx = i * 512 + tid, row = idx >> 5, ch = idx & 31; rq[S_][i] = *(const u32x4*)(qb + ro_ + (size_t)row * RIN + ch * 8); rk[S_][i] = *(const u32x4*)(kb + ro_ + (size_t)row * RIN + ch * 8); } \
            if (tid < 256) rv[S_] = *(const u32x4*)(vb + ro_ + (size_t)vrow * RIN + vch * 8); \
            rp[S_] = *(const u32x4*)(pb + (size_t)(cc_) * 64 * 512); } while (0)
        rv[0] = (u32x4){0u, 0u, 0u, 0u}; rv[1] = rv[0];
        RET_LOAD(0, 0); RET_LOAD(1, 1);
        for (int c0 = 0; c0 < 128; c0 += 2) {
#pragma unroll
          for (int par = 0; par < 2; ++par) {
            const int c = c0 + par;
            LAS unsigned char* Stc = St0 + par * 16896; LAS unsigned char* Stn = St0 + (par ^ 1) * 16896;
#pragma unroll
            for (int i = 0; i < 4; ++i) { const int idx = i * 512 + tid, row = idx >> 5, ch = idx & 31; *(LAS u32x4*)(Qs + row * QS + ch * 16) = rq[par][i]; *(LAS u32x4*)(Ks + row * QS + ch * 16) = rk[par][i]; }
            if (tid < 256) {
                const u32x4 rvv = rv[par];
                *(LAS u32x4*)(Vs + vrow * VS + vch * 16) = rvv;
                u32x4 z; z.x = pk2(bflo(rvv.x) * zeta, bfhi(rvv.x) * zeta); z.y = pk2(bflo(rvv.y) * zeta, bfhi(rvv.y) * zeta);
                z.z = pk2(bflo(rvv.z) * zeta, bfhi(rvv.z) * zeta); z.w = pk2(bflo(rvv.w) * zeta, bfhi(rvv.w) * zeta);
                *(LAS u32x4*)(Vz + vrow * VS + vch * 16) = z;
            }
            *(LAS u32x4*)(Ps + prow * PS + pch * 16) = rp[par];
            LDS_BARRIER();
            if (c + 2 < 128) RET_LOAD(par, c + 2);
            f32x4 aX0 = {0.f, 0.f, 0.f, 0.f}, aX1 = {0.f, 0.f, 0.f, 0.f}, aI = {0.f, 0.f, 0.f, 0.f};
#pragma unroll
            for (int ks = 0; ks < 8; ks += 2) {
                const bf16x8 a0 = *(const LAS bf16x8*)(Qs + (lm * 16 + fr) * QS + ks * 64 + fq * 16);
                const bf16x8 s0 = *(const LAS bf16x8*)(Stc + (c2 * 16 + fr) * QS + ks * 64 + fq * 16);
                const bf16x8 a1 = *(const LAS bf16x8*)(Qs + (lm * 16 + fr) * QS + (ks + 1) * 64 + fq * 16);
                const bf16x8 s1 = *(const LAS bf16x8*)(Stc + (c2 * 16 + fr) * QS + (ks + 1) * 64 + fq * 16);
                aX0 = __builtin_amdgcn_mfma_f32_16x16x32_bf16(a0, s0, aX0, 0, 0, 0);
                aX1 = __builtin_amdgcn_mfma_f32_16x16x32_bf16(a1, s1, aX1, 0, 0, 0);
            }
#pragma unroll
            for (int ks = 0; ks < 2; ++ks) {
                const bf16x8 a = *(const LAS bf16x8*)(Ps + (lm * 16 + fr) * PS + ks * 64 + fq * 16);
                const bf16x8 bv = tr_frag(Vs, VS, ks * 32, c2 * 16, lane);
                aI = __builtin_amdgcn_mfma_f32_16x16x32_bf16(a, bv, aI, 0, 0, 0);
            }
            {
                bf16_t* ob = vb + (size_t)(c * 64) * RIN + c2 * 16 + fr;
#pragma unroll
                for (int j = 0; j < 4; ++j) { const int l = lm * 16 + fq * 4 + j; ob[(size_t)l * RIN] = (bf16_t)f2bf(aI[j] + (aX0[j] + aX1[j]) * xi[j]); }
            }
#pragma unroll
            for (int a = 0; a < 2; ++a)
#pragma unroll
                for (int cc = 0; cc < 2; ++cc) accS[a][cc] *= cdecay;
#pragma unroll
            for (int ks = 0; ks < 2; ++ks) {
                const bf16x8 ad0 = tr_frag(Ks, QS, ks * 32, (wid * 2 + 0) * 16, lane);
                const bf16x8 ad1 = tr_frag(Ks, QS, ks * 32, (wid * 2 + 1) * 16, lane);
                const bf16x8 bv0 = tr_frag(Vz, VS, ks * 32, 0, lane);
                const bf16x8 bv1 = tr_frag(Vz, VS, ks * 32, 16, lane);
                accS[0][0] = __builtin_amdgcn_mfma_f32_16x16x32_bf16(ad0, bv0, accS[0][0], 0, 0, 0);
                accS[0][1] = __builtin_amdgcn_mfma_f32_16x16x32_bf16(ad0, bv1, accS[0][1], 0, 0, 0);
                accS[1][0] = __builtin_amdgcn_mfma_f32_16x16x32_bf16(ad1, bv0, accS[1][0], 0, 0, 0);
                accS[1][1] = __builtin_amdgcn_mfma_f32_16x16x32_bf16(ad1, bv1, accS[1][1], 0, 0, 0);
            }
#pragma unroll
            for (int a = 0; a < 2; ++a)
#pragma unroll
                for (int cc = 0; cc < 2; ++cc) {
                    u32x2 w; w.x = pk2(accS[a][cc][0], accS[a][cc][1]); w.y = pk2(accS[a][cc][2], accS[a][cc][3]);
                    *(LAS u32x2*)(Stn + (cc * 16 + fr) * QS + ((wid * 2 + a) * 16 + fq * 4) * 2) = w;
                }
            LDS_BARRIER();
          }
        }
#undef RET_LOAD
    }
}

__device__ __forceinline__ void ret_gn(bf16_t* proj, const float* gnw, int wg, int G) {
    const int tid_ = otid(); const int wave = tid_ >> 6, lane = tid_ & 63;
    constexpr int NP = 4;
    for (int pair0 = (wg * 8 + wave) * NP; pair0 < T * 8; pair0 += G * 8 * NP) {
        u32x4 ov[NP], gv[NP];
#pragma unroll
        for (int q = 0; q < NP; ++q) { const int pair = pair0 + q, t = pair >> 3, h = pair & 7;
            const bf16_t* op = proj + (size_t)t * RIN + 4096 + h * 512 + lane * 8; ov[q] = *(const u32x4*)op; gv[q] = *(const u32x4*)(op + 4096); }
#pragma unroll
        for (int q = 0; q < NP; ++q) { const int pair = pair0 + q, t = pair >> 3, h = pair & 7;
            bf16_t* gp = proj + (size_t)t * RIN + 8192 + h * 512 + lane * 8;
            float o[8] = {bflo(ov[q].x), bfhi(ov[q].x), bflo(ov[q].y), bfhi(ov[q].y), bflo(ov[q].z), bfhi(ov[q].z), bflo(ov[q].w), bfhi(ov[q].w)};
            float g[8] = {bflo(gv[q].x), bfhi(gv[q].x), bflo(gv[q].y), bfhi(gv[q].y), bflo(gv[q].z), bfhi(gv[q].z), bflo(gv[q].w), bfhi(gv[q].w)};
            float s = 0.f;
#pragma unroll
            for (int e = 0; e < 8; ++e) s += o[e];
            const float mu = wave_sum(s) * (1.0f / 512.0f);
            float qq = 0.f;
#pragma unroll
            for (int e = 0; e < 8; ++e) { o[e] -= mu; qq += o[e] * o[e]; }
            const float rstd = rsqrtf(wave_sum(qq) * (1.0f / 512.0f) + 1e-5f);
            const f32x4 w0 = *(const f32x4*)(gnw + h * 512 + lane * 8), w1 = *(const f32x4*)(gnw + h * 512 + lane * 8 + 4);
            float y[8];
#pragma unroll
            for (int e = 0; e < 8; ++e) y[e] = silu(g[e]) * (o[e] * rstd) * (e < 4 ? w0[e & 3] : w1[e & 3]);
            u32x4 w; w.x = pk2(y[0], y[1]); w.y = pk2(y[2], y[3]); w.z = pk2(y[4], y[5]); w.w = pk2(y[6], y[7]);
            *(u32x4*)gp = w; }
    }
}

__device__ __forceinline__ void ssd_dt(const bf16_t* U, const bf16_t* Wdt, const float* dt_bias, const float* a_log, float* dtv, float* acv, LAS unsigned char* lds, int wg, int G) {
    const int tid = otid(), lane = tid & 63, wid = __builtin_amdgcn_readfirstlane(tid >> 6), fr = lane & 15, fq = lane >> 4;
    constexpr int QS = 528;
    LAS unsigned char* As = lds; LAS unsigned char* Bs = lds + 33792;
    LAS float* dtl = (LAS float*)(lds + 67584);
    const int lm = wid >> 1, c2 = wid & 1;
    for (int ck = wg; ck < 256; ck += G) {
        const bf16_t* ab = U + (size_t)(ck * 64) * DM;
        u32x4 ra[4], rb[4];
#define DT_LOAD(sl_) do { _Pragma("unroll") for (int i = 0; i < 4; ++i) { const int idx = i * 512 + tid, row = idx >> 5, ch = idx & 31; \
            ra[i] = *(const u32x4*)(ab + (size_t)row * DM + (sl_) * 256 + ch * 8); rb[i] = *(const u32x4*)(Wdt + (size_t)row * DM + (sl_) * 256 + ch * 8); } } while (0)
        DT_LOAD(0);
        f32x4 a0 = {0.f, 0.f, 0.f, 0.f}, a1 = {0.f, 0.f, 0.f, 0.f};
        for (int sl = 0; sl < 8; ++sl) {
#pragma unroll
            for (int i = 0; i < 4; ++i) { const int idx = i * 512 + tid, row = idx >> 5, ch = idx & 31; *(LAS u32x4*)(As + row * QS + ch * 16) = ra[i]; *(LAS u32x4*)(Bs + row * QS + ch * 16) = rb[i]; }
            LDS_BARRIER();
            if (sl + 1 < 8) DT_LOAD(sl + 1);
#pragma unroll
            for (int ks = 0; ks < 8; ++ks) {
                const bf16x8 a = *(const LAS bf16x8*)(As + (lm * 16 + fr) * QS + ks * 64 + fq * 16);
                const bf16x8 b0 = *(const LAS bf16x8*)(Bs + ((c2 * 2 + 0) * 16 + fr) * QS + ks * 64 + fq * 16);
                const bf16x8 b1 = *(const LAS bf16x8*)(Bs + ((c2 * 2 + 1) * 16 + fr) * QS + ks * 64 + fq * 16);
                a0 = __builtin_amdgcn_mfma_f32_16x16x32_bf16(a, b0, a0, 0, 0, 0);
                a1 = __builtin_amdgcn_mfma_f32_16x16x32_bf16(a, b1, a1, 0, 0, 0);
            }
            LDS_BARRIER();
        }
#undef DT_LOAD
        {
            const int h0 = (c2 * 2 + 0) * 16 + fr, h1 = h0 + 16;
            const float b0 = dt_bias[h0], b1 = dt_bias[h1];
            f32x4 d0, d1;
#pragma unroll
            for (int j = 0; j < 4; ++j) { const float x0 = a0[j] + b0, x1 = a1[j] + b1; d0[j] = x0 > 20.f ? x0 : log1pf(expf(x0)); d1[j] = x1 > 20.f ? x1 : log1pf(expf(x1)); }
            *(LAS f32x4*)(dtl + h0 * 64 + lm * 16 + fq * 4) = d0;
            *(LAS f32x4*)(dtl + h1 * 64 + lm * 16 + fq * 4) = d1;
        }
        LDS_BARRIER();
#pragma unroll
        for (int hh = 0; hh < 8; ++hh) {
            const int hd = wid * 8 + hh;
            const float dt = dtl[hd * 64 + lane];
            float sa = dt * (-expf(a_log[hd]));
#pragma unroll
            for (int o = 1; o < 64; o <<= 1) { const float tt = __shfl_up(sa, o); if (lane >= o) sa += tt; }
            dtv[((size_t)ck * 64 + hd) * 64 + lane] = dt; acv[((size_t)ck * 64 + hd) * 64 + lane] = sa;
        }
        LDS_BARRIER();
    }
}

__device__ __forceinline__ void ssd_cb(bf16_t* proj, const bf16_t* halo, const float* cw, const float* cbias, bf16_t* CBg, LAS unsigned char* lds, int wg, int G) {
    const int tid = otid(), lane = tid & 63, wid = __builtin_amdgcn_readfirstlane(tid >> 6), fr = lane & 15, fq = lane >> 4;
    constexpr int CS = 272;
    LAS unsigned char* Cs = lds; LAS unsigned char* Bs = lds + 17408; LAS unsigned char* RB = lds + 34816; LAS unsigned char* RC = lds + 53248;
    LAS float* Wl = (LAS float*)(lds + 71680);
    const int lm = wid >> 1, c2 = wid & 1;
    u32x4 rc[2], rb[2], rh; f32x4 rw;
    const int hm = tid / 48, hr = (tid % 48) >> 4, hch = tid & 15;
#define CB_LOAD(u_) do { const int g_ = (u_) & 7, bc_ = (u_) >> 3; const bf16_t* bb_ = proj + (size_t)(bc_ * 64) * SINP + 8192 + g_ * 128; \
        _Pragma("unroll") for (int i = 0; i < 2; ++i) { const int idx = i * 512 + tid, row = idx >> 4, ch = idx & 15; rb[i] = *(const u32x4*)(bb_ + (size_t)row * SINP + ch * 8); rc[i] = *(const u32x4*)(bb_ + 1024 + (size_t)row * SINP + ch * 8); } \
        rh = (u32x4){0u, 0u, 0u, 0u}; \
        if (tid < 96 && (bc_ & 127) != 0) rh = *(const u32x4*)(halo + ((size_t)(bc_ - 1) * 3 + hr) * 6144 + 4096 + hm * 1024 + g_ * 128 + hch * 8); \
        if (tid < 320) { const int m_ = tid / 160, q_ = tid % 160, tp_ = q_ >> 5, c4_ = q_ & 31; const int col_ = 4096 + m_ * 1024 + g_ * 128 + c4_ * 4; \
            rw = tp_ < 4 ? *(const f32x4*)(cw + tp_ * 6144 + col_) : *(const f32x4*)(cbias + col_); } } while (0)
    int u = wg;
    if (u < 2048) CB_LOAD(u);
    for (; u < 2048; u += G) {
        const int g = u & 7, t0 = (u >> 3) * 64;
#pragma unroll
        for (int i = 0; i < 2; ++i) { const int idx = i * 512 + tid, row = idx >> 4, ch = idx & 15; *(LAS u32x4*)(RC + (row + 3) * CS + ch * 16) = rc[i]; *(LAS u32x4*)(RB + (row + 3) * CS + ch * 16) = rb[i]; }
        if (tid < 96) *(LAS u32x4*)((hm ? RC : RB) + hr * CS + hch * 16) = rh;
        if (tid < 320) { const int m_ = tid / 160, q_ = tid % 160; *(LAS f32x4*)(Wl + m_ * 640 + (q_ >> 5) * 128 + (q_ & 31) * 4) = rw; }
        LDS_BARRIER();
        const int un = u + G;
        if (un < 2048) CB_LOAD(un);
#pragma unroll
        for (int mtx = 0; mtx < 2; ++mtx) {
            LAS unsigned char* R = mtx ? RC : RB; LAS unsigned char* O = mtx ? Cs : Bs;
            const LAS float* wl = Wl + mtx * 640;
#pragma unroll
            for (int i = 0; i < 2; ++i) {
                const int idx = i * 512 + tid, row = idx >> 4, ch = idx & 15;
                float acc8[8];
                { const f32x4 b0 = *(const LAS f32x4*)(wl + 512 + ch * 8), b1 = *(const LAS f32x4*)(wl + 512 + ch * 8 + 4);
#pragma unroll
                  for (int e = 0; e < 4; ++e) { acc8[e] = b0[e]; acc8[4 + e] = b1[e]; } }
#pragma unroll
                for (int tp = 0; tp < 4; ++tp) {
                    const u32x4 xv = *(const LAS u32x4*)(R + (row + tp) * CS + ch * 16);
                    const f32x4 w0 = *(const LAS f32x4*)(wl + tp * 128 + ch * 8), w1 = *(const LAS f32x4*)(wl + tp * 128 + ch * 8 + 4);
                    acc8[0] += w0[0] * bflo(xv.x); acc8[1] += w0[1] * bfhi(xv.x); acc8[2] += w0[2] * bflo(xv.y); acc8[3] += w0[3] * bfhi(xv.y);
                    acc8[4] += w1[0] * bflo(xv.z); acc8[5] += w1[1] * bfhi(xv.z); acc8[6] += w1[2] * bflo(xv.w); acc8[7] += w1[3] * bfhi(xv.w);
                }
                u32x4 o; o.x = pk2(silu(acc8[0]), silu(acc8[1])); o.y = pk2(silu(acc8[2]), silu(acc8[3])); o.z = pk2(silu(acc8[4]), silu(acc8[5])); o.w = pk2(silu(acc8[6]), silu(acc8[7]));
                *(LAS u32x4*)(O + row * CS + ch * 16) = o;
                *(u32x4*)(proj + (size_t)(t0 + row) * SINP + 8192 + mtx * 1024 + g * 128 + ch * 8) = o;
            }
        }
        LDS_BARRIER();
        f32x4 aW0 = {0.f, 0.f, 0.f, 0.f}, aW1 = {0.f, 0.f, 0.f, 0.f};
#pragma unroll
        for (int ks = 0; ks < 4; ++ks) {
            const bf16x8 a = *(const LAS bf16x8*)(Cs + (lm * 16 + fr) * CS + ks * 64 + fq * 16);
            const bf16x8 b0 = *(const LAS bf16x8*)(Bs + ((c2 * 2 + 0) * 16 + fr) * CS + ks * 64 + fq * 16);
            const bf16x8 b1 = *(const LAS bf16x8*)(Bs + ((c2 * 2 + 1) * 16 + fr) * CS + ks * 64 + fq * 16);
            aW0 = __builtin_amdgcn_mfma_f32_16x16x32_bf16(a, b0, aW0, 0, 0, 0);
            aW1 = __builtin_amdgcn_mfma_f32_16x16x32_bf16(a, b1, aW1, 0, 0, 0);
        }
#pragma unroll
        for (int j = 0; j < 4; ++j) { const int l = lm * 16 + fq * 4 + j;
            bf16_t* pp = CBg + ((size_t)(t0 + l) * 8 + g) * 64 + (c2 * 2) * 16 + fr;
            pp[0] = (bf16_t)f2bf(aW0[j]); pp[16] = (bf16_t)f2bf(aW1[j]); }
        LDS_BARRIER();
    }
#undef CB_LOAD
}

__device__ __forceinline__ void ssd_scan(bf16_t* proj, const bf16_t* halo, const float* cw, const float* cbias, const bf16_t* CBg, const float* dtv, const float* acv, const float* d_skip, LAS unsigned char* lds, int wg, int G) {
    const int tid = otid(), lane = tid & 63, wid = __builtin_amdgcn_readfirstlane(tid >> 6), fr = lane & 15, fq = lane >> 4;
    constexpr int CS = 272, XS = 80, WS = 144;
    LAS unsigned char* Cs = lds; LAS unsigned char* Bs = lds + 17408; LAS unsigned char* Xs = lds + 34816; LAS unsigned char* Xw = lds + 39936; LAS unsigned char* Zs = lds + 45056;
    LAS unsigned char* Ws = lds + 50176; LAS unsigned char* Sts0 = lds + 59392; LAS float* acum = (LAS float*)(lds + 76800);
    LAS float* Wx = (LAS float*)(lds + 77056);
    const int lm = wid >> 1, c2 = wid & 1;
    for (int unit = wg; unit < 256; unit += G) {
        const int grp = unit & 7, ii = unit >> 3, b = ii >> 4, hd = grp * 8 + ((ii & 15) >> 1), ph = ii & 1;
        const float dsk = d_skip[hd];
        f32x4 accT[2];
        accT[0] = (f32x4){0.f, 0.f, 0.f, 0.f}; accT[1] = (f32x4){0.f, 0.f, 0.f, 0.f};
        for (int i = tid; i < 8704 / 4; i += NTHREADS) ((LAS unsigned*)Sts0)[i] = 0u;
        const bf16_t* base = proj + (size_t)(b * SEQ) * SINP;
        const bf16_t* bb = base + 8192 + grp * 128;
        const bf16_t* cbp = base + 9216 + grp * 128;
        bf16_t* xb = (bf16_t*)base + 4096 + hd * 64 + ph * 32;
        const bf16_t* zb = base + hd * 64 + ph * 32;
        const int xrow = (tid & 255) >> 2, xch = tid & 3;
        const int wrow = tid >> 3, ws0 = (tid & 7) * 8;
        if (tid < 40) { const int tp = tid >> 3, c4 = tid & 7; const int col = hd * 64 + ph * 32 + c4 * 4; *(LAS f32x4*)(Wx + tp * 32 + c4 * 4) = tp < 4 ? *(const f32x4*)(cw + tp * 6144 + col) : *(const f32x4*)(cbias + col); }
        const bf16_t* hxb = halo + (size_t)(b * 128) * 3 * 6144 + hd * 64 + ph * 32 + xch * 8;
        const bf16_t* cgp = CBg + ((size_t)(b * SEQ + wrow) * 8 + grp) * 64 + ws0;
        const float* dtp = dtv + ((size_t)(b * 128) * 64 + hd) * 64;
        const float* acp = acv + ((size_t)(b * 128) * 64 + hd) * 64;
        u32x4 rc[2][2], rb[2][2], rxz[2], rcb[2], rxh[2][3]; f32x4 rds[2][2], ras[2][2]; float ral[2], rax[2], rdx[2], rat[2], ra0[2] = {0.f, 0.f};
#define SSD_PREFETCH(S_, cc_) do { const size_t ro_ = (size_t)(cc_) * 64 * SINP; \
            _Pragma("unroll") for (int i = 0; i < 2; ++i) { const int idx = i * 512 + tid, row = idx >> 4, ch = idx & 15; rc[S_][i] = *(const u32x4*)(cbp + ro_ + (size_t)row * SINP + ch * 8); rb[S_][i] = *(const u32x4*)(bb + ro_ + (size_t)row * SINP + ch * 8); } \
            rxz[S_] = *(const u32x4*)((tid < 256 ? (const bf16_t*)xb : zb) + ro_ + (size_t)xrow * SINP + xch * 8); \
            if (tid < 256) { _Pragma("unroll") for (int k_ = 1; k_ <= 3; ++k_) { const int r_ = xrow - k_; \
                rxh[S_][k_ - 1] = r_ >= 0 ? *(const u32x4*)(xb + ro_ + (size_t)r_ * SINP + xch * 8) : ((cc_) > 0 ? *(const u32x4*)(hxb + ((size_t)((cc_) - 1) * 3 + (3 + r_)) * 6144) : (u32x4){0u, 0u, 0u, 0u}); } } \
            rcb[S_] = *(const u32x4*)(cgp + (size_t)(cc_) * 64 * 512); \
            const float* d_ = dtp + (size_t)(cc_) * 4096; const float* a_ = acp + (size_t)(cc_) * 4096; \
            rds[S_][0] = *(const f32x4*)(d_ + ws0); rds[S_][1] = *(const f32x4*)(d_ + ws0 + 4); ras[S_][0] = *(const f32x4*)(a_ + ws0); ras[S_][1] = *(const f32x4*)(a_ + ws0 + 4); \
            ral[S_] = a_[wrow]; rax[S_] = a_[xrow]; rdx[S_] = d_[xrow]; rat[S_] = a_[63]; if (tid < 64) ra0[S_] = a_[tid]; } while (0)
        LDS_BARRIER();
        SSD_PREFETCH(0, 0);
        for (int c0 = 0; c0 < 128; c0 += 2) {
#pragma unroll
          for (int par = 0; par < 2; ++par) {
            const int c = c0 + par;
            LAS unsigned char* Stc = Sts0 + par * 8704; LAS unsigned char* Stn = Sts0 + (par ^ 1) * 8704;
#pragma unroll
            for (int i = 0; i < 2; ++i) { const int idx = i * 512 + tid, row = idx >> 4, ch = idx & 15; *(LAS u32x4*)(Cs + row * CS + ch * 16) = rc[0][i]; *(LAS u32x4*)(Bs + row * CS + ch * 16) = rb[0][i]; }
            if (tid >= 256) *(LAS u32x4*)(Zs + xrow * XS + xch * 16) = rxz[0];
            else {
                float xc[8];
                { const f32x4 b0 = *(const LAS f32x4*)(Wx + 128 + xch * 8), b1 = *(const LAS f32x4*)(Wx + 128 + xch * 8 + 4);
#pragma unroll
                  for (int e = 0; e < 4; ++e) { xc[e] = b0[e]; xc[4 + e] = b1[e]; } }
#pragma unroll
                for (int tp = 0; tp < 4; ++tp) {
                    const u32x4 xv = tp == 3 ? rxz[0] : rxh[0][2 - tp];
                    const f32x4 w0 = *(const LAS f32x4*)(Wx + tp * 32 + xch * 8), w1 = *(const LAS f32x4*)(Wx + tp * 32 + xch * 8 + 4);
                    xc[0] += w0[0] * bflo(xv.x); xc[1] += w0[1] * bfhi(xv.x); xc[2] += w0[2] * bflo(xv.y); xc[3] += w0[3] * bfhi(xv.y);
                    xc[4] += w1[0] * bflo(xv.z); xc[5] += w1[1] * bfhi(xv.z); xc[6] += w1[2] * bflo(xv.w); xc[7] += w1[3] * bfhi(xv.w);
                }
#pragma unroll
                for (int e = 0; e < 8; ++e) xc[e] = silu(xc[e]);
                u32x4 xo; xo.x = pk2(xc[0], xc[1]); xo.y = pk2(xc[2], xc[3]); xo.z = pk2(xc[4], xc[5]); xo.w = pk2(xc[6], xc[7]);
                *(LAS u32x4*)(Xs + xrow * XS + xch * 16) = xo;
                const float f = rdx[0] * __expf(rat[0] - rax[0]);
                u32x4 z; z.x = pk2(bflo(xo.x) * f, bfhi(xo.x) * f); z.y = pk2(bflo(xo.y) * f, bfhi(xo.y) * f); z.z = pk2(bflo(xo.z) * f, bfhi(xo.z) * f); z.w = pk2(bflo(xo.w) * f, bfhi(xo.w) * f);
                *(LAS u32x4*)(Xw + xrow * XS + xch * 16) = z;
            }
            {
                const u32x4 rcv = rcb[0];
                const float cv[8] = {bflo(rcv.x), bfhi(rcv.x), bflo(rcv.y), bfhi(rcv.y), bflo(rcv.z), bfhi(rcv.z), bflo(rcv.w), bfhi(rcv.w)};
                float wv[8];
#pragma unroll
                for (int e = 0; e < 8; ++e) { const float as = e < 4 ? ras[0][0][e & 3] : ras[0][1][e & 3], ds = e < 4 ? rds[0][0][e & 3] : rds[0][1][e & 3];
                    wv[e] = (wrow >= ws0 + e) ? cv[e] * __expf(ral[0] - as) * ds : 0.f; }
                u32x4 w; w.x = pk2(wv[0], wv[1]); w.y = pk2(wv[2], wv[3]); w.z = pk2(wv[4], wv[5]); w.w = pk2(wv[6], wv[7]);
                *(LAS u32x4*)(Ws + wrow * WS + ws0 * 2) = w;
            }
            if (tid < 64) acum[tid] = ra0[0];
            LDS_BARRIER();
            if (c + 1 < 128) SSD_PREFETCH(0, c + 1);
            const float atot = acum[63];
            float al[4];
#pragma unroll
            for (int j = 0; j < 4; ++j) al[j] = acum[lm * 16 + fq * 4 + j];
            f32x4 aY0 = {0.f, 0.f, 0.f, 0.f}, aY1 = {0.f, 0.f, 0.f, 0.f}, aD = {0.f, 0.f, 0.f, 0.f};
#pragma unroll
            for (int ks = 0; ks < 4; ks += 2) {
                const bf16x8 a0 = *(const LAS bf16x8*)(Cs + (lm * 16 + fr) * CS + ks * 64 + fq * 16);
                const bf16x8 s0 = *(const LAS bf16x8*)(Stc + (c2 * 16 + fr) * CS + ks * 64 + fq * 16);
                const bf16x8 a1 = *(const LAS bf16x8*)(Cs + (lm * 16 + fr) * CS + (ks + 1) * 64 + fq * 16);
                const bf16x8 s1 = *(const LAS bf16x8*)(Stc + (c2 * 16 + fr) * CS + (ks + 1) * 64 + fq * 16);
                aY0 = __builtin_amdgcn_mfma_f32_16x16x32_bf16(a0, s0, aY0, 0, 0, 0);
                aY1 = __builtin_amdgcn_mfma_f32_16x16x32_bf16(a1, s1, aY1, 0, 0, 0);
            }
#pragma unroll
            for (int ks = 0; ks < 2; ++ks) {
                const bf16x8 a = *(const LAS bf16x8*)(Ws + (lm * 16 + fr) * WS + ks * 64 + fq * 16);
                const bf16x8 bx = tr_frag(Xs, XS, ks * 32, c2 * 16, lane);
                aD = __builtin_amdgcn_mfma_f32_16x16x32_bf16(a, bx, aD, 0, 0, 0);
            }
            {
                const int pc = c2 * 16 + fr;
                bf16_t* ob = xb + (size_t)(c * 64) * SINP + pc;
#pragma unroll
                for (int j = 0; j < 4; ++j) { const int l = lm * 16 + fq * 4 + j;
                    const float xv = bf2f(*(const LAS bf16_t*)(Xs + l * XS + pc * 2)), zv = bf2f(*(const LAS bf16_t*)(Zs + l * XS + pc * 2));
                    const float y = aD[j] + (aY0[j] + aY1[j]) * __expf(al[j]) + dsk * xv;
                    ob[(size_t)l * SINP] = (bf16_t)f2bf(y * silu(zv)); }
            }
            const float sdec = __expf(atot);
            accT[0] *= sdec; accT[1] *= sdec;
#pragma unroll
            for (int ks = 0; ks < 2; ++ks) {
                const bf16x8 an_ = tr_frag(Bs, CS, ks * 32, wid * 16, lane);
                const bf16x8 bp0 = tr_frag(Xw, XS, ks * 32, 0, lane);
                const bf16x8 bp1 = tr_frag(Xw, XS, ks * 32, 16, lane);
                accT[0] = __builtin_amdgcn_mfma_f32_16x16x32_bf16(an_, bp0, accT[0], 0, 0, 0);
                accT[1] = __builtin_amdgcn_mfma_f32_16x16x32_bf16(an_, bp1, accT[1], 0, 0, 0);
            }
#pragma unroll
            for (int pi = 0; pi < 2; ++pi) {
                u32x2 w; w.x = pk2(accT[pi][0], accT[pi][1]); w.y = pk2(accT[pi][2], accT[pi][3]);
                *(LAS u32x2*)(Stn + (pi * 16 + fr) * CS + (wid * 16 + fq * 4) * 2) = w;
            }
            LDS_BARRIER();
          }
        }
#undef SSD_PREFETCH
    }
}

__device__ __forceinline__ void ssd_norm(bf16_t* proj, const float* nw, int wg, int G) {
    const int tid_ = otid(); const int wave = tid_ >> 6, lane = tid_ & 63;
    constexpr int NP = 4;
    for (int pair0 = (wg * 8 + wave) * NP; pair0 < T * 8; pair0 += G * 8 * NP) {
        u32x4 yv[NP];
#pragma unroll
        for (int q = 0; q < NP; ++q) { const int pair = pair0 + q, t = pair >> 3, gr = pair & 7; yv[q] = *(const u32x4*)(proj + (size_t)t * SINP + 4096 + gr * 512 + lane * 8); }
#pragma unroll
        for (int q = 0; q < NP; ++q) { const int pair = pair0 + q, t = pair >> 3, gr = pair & 7;
            bf16_t* yp = proj + (size_t)t * SINP + 4096 + gr * 512 + lane * 8;
            float y[8] = {bflo(yv[q].x), bfhi(yv[q].x), bflo(yv[q].y), bfhi(yv[q].y), bflo(yv[q].z), bfhi(yv[q].z), bflo(yv[q].w), bfhi(yv[q].w)};
            float qq = 0.f;
#pragma unroll
            for (int e = 0; e < 8; ++e) qq += y[e] * y[e];
            const float r = rsqrtf(wave_sum(qq) * (1.0f / 512.0f) + 1e-6f);
            const f32x4 w0 = *(const f32x4*)(nw + gr * 512 + lane * 8), w1 = *(const f32x4*)(nw + gr * 512 + lane * 8 + 4);
            u32x4 w; w.x = pk2(y[0] * r * w0[0], y[1] * r * w0[1]); w.y = pk2(y[2] * r * w0[2], y[3] * r * w0[3]);
            w.z = pk2(y[4] * r * w1[0], y[5] * r * w1[1]); w.w = pk2(y[6] * r * w1[2], y[7] * r * w1[3]);
            *(u32x4*)yp = w; }
    }
}

#define XB_TMO      128
#define XB_XCNT(j)  (256  + 64 * (j))
#define XB_XSUB(j)  (1280 + 64 * (j))
#define XB_XGEN(j)  (2304 + 64 * (j))
#define XB_TOP      3328
#define XB_TOPGEN   3392
#define XCD_BAR_WORDS 3456
#define XB_SPIN_CAP (1u << 18)
__device__ __forceinline__ unsigned xb_ld(unsigned* p)              { return __hip_atomic_load(p, __ATOMIC_RELAXED, __HIP_MEMORY_SCOPE_AGENT); }
__device__ __forceinline__ unsigned xb_add(unsigned* p, unsigned v) { return __hip_atomic_fetch_add(p, v, __ATOMIC_RELAXED, __HIP_MEMORY_SCOPE_AGENT); }
__device__ __forceinline__ unsigned xb_xcc_id() { return (unsigned)__builtin_amdgcn_s_getreg((3 << 11) | 20) & 0xFu; }
#define XB_SPIN(cond, bar) do { unsigned _sp = 0; while (cond) { __builtin_amdgcn_s_sleep(1); \
    if ((++_sp & 255u) == 0u) { if (xb_ld(&(bar)[XB_TMO])) break; if (_sp > XB_SPIN_CAP) { atomicAdd(&(bar)[XB_TMO], 1u); break; } } } } while (0)
struct XcdBarrier { unsigned* bar; unsigned x; volatile LAS unsigned* st; };
__device__ __forceinline__ XcdBarrier xcd_barrier_post(unsigned* bar, volatile LAS unsigned* st) {
    XcdBarrier b; b.bar = bar; b.x = xb_xcc_id(); b.st = st;
    if (threadIdx.x == 0) (void)xb_add(&bar[XB_XCNT(b.x)], 1u);
    return b;
}
__device__ __forceinline__ void xcd_barrier_complete(unsigned* bar, unsigned x, unsigned& nloc, unsigned& nx) {
    const unsigned G = gridDim.x * gridDim.y * gridDim.z;
    unsigned sum, cnt, mine, sp = 0u;
    for (;;) {
        sum = 0u; cnt = 0u; mine = 0u;
#pragma unroll
        for (unsigned j = 0; j < 16; ++j) { const unsigned c = xb_ld(&bar[XB_XCNT(j)]); sum += c; cnt += (c > 0u) ? 1u : 0u; mine = (j == x) ? c : mine; }
        if (sum == G) break;
        __builtin_amdgcn_s_sleep(1);
        if ((++sp & 255u) == 0u) { if (xb_ld(&bar[XB_TMO])) break; if (sp > XB_SPIN_CAP) { atomicAdd(&bar[XB_TMO], 1u); break; } }
    }
    nloc = mine > 0u ? mine : 1u; nx = cnt > 0u ? cnt : 1u;
}
__device__ __forceinline__ void xcd_barrier(const XcdBarrier& b) {
    asm volatile("s_waitcnt vmcnt(0)" ::: "memory");
    __syncthreads();
    if (threadIdx.x == 0) {
        unsigned* bar = b.bar;
        __builtin_amdgcn_s_waitcnt(0);
        unsigned nloc = b.st[0], nx = b.st[1];
        if (nloc == 0u) { xcd_barrier_complete(bar, b.x, nloc, nx); b.st[0] = nloc; b.st[1] = nx; }
        const unsigned old = xb_add(&bar[XB_XSUB(b.x)], 1u);
        const unsigned gen = old / nloc;
        if (old + 1u == (gen + 1u) * nloc) {
            __builtin_amdgcn_fence(__ATOMIC_RELEASE, "agent");
            asm volatile("s_waitcnt vmcnt(0)" ::: "memory");
            const unsigned og = xb_add(&bar[XB_TOP], 1u);
            const unsigned tg = og / nx;
            if (og + 1u == (tg + 1u) * nx) xb_add(&bar[XB_TOPGEN], 1u);
            else XB_SPIN(xb_ld(&bar[XB_TOPGEN]) == tg, bar);
            __builtin_amdgcn_fence(__ATOMIC_ACQUIRE, "agent");
            xb_add(&bar[XB_XGEN(b.x)], 1u);
            asm volatile("s_waitcnt vmcnt(0)" ::: "memory");
        } else {
            XB_SPIN(xb_ld(&bar[XB_XGEN(b.x)]) == gen, bar);
            __builtin_amdgcn_fence(__ATOMIC_ACQUIRE, "agent");
            asm volatile("s_waitcnt vmcnt(0)" ::: "memory");
        }
    }
    __syncthreads();
}

struct Params {
    const float* x; const float* nmp; const float* nmq; const float* nfp; const float* nfq;
    const float* ret_w_in; const float* ret_gn_w; const float* ret_w_out;
    const float* ssd_w_in; const float* conv_w; const float* conv_b; const float* dt_bias; const float* a_log; const float* d_skip; const float* ssd_norm_w; const float* ssd_w_out;
    const float* w_up; const float* w_down;
    float* out; unsigned char* ws;
};


__global__ void __launch_bounds__(NTHREADS, 2) mega(Params p) {
    extern __shared__ __attribute__((aligned(16))) unsigned char lds_raw[];
    LAS unsigned char* lds = (LAS unsigned char*)lds_raw;
    cg::grid_group grid = cg::this_grid();
    const int G = gridDim.x, wg = blockIdx.x;
    bf16_t* WA = (bf16_t*)(p.ws + OFF_WA); bf16_t* WB = (bf16_t*)(p.ws + OFF_WB);
    bf16_t* ACT = (bf16_t*)(p.ws + OFF_ACT); bf16_t* U_ACT = (bf16_t*)(p.ws + OFF_ACT + HID_BYTES); bf16_t* F_ACT = (bf16_t*)(p.ws + OFF_ACT + HID_BYTES);
    bf16_t* U_R2 = (bf16_t*)(p.ws + OFF_R2); bf16_t* MF_R2 = (bf16_t*)(p.ws + OFF_R2);
    float* ROT = (float*)(p.ws + OFF_ROT); bf16_t* HALO = (bf16_t*)(p.ws + OFF_HALO); float* DTV = (float*)(p.ws + OFF_DTV); float* ACV = (float*)(p.ws + OFF_ACV); bf16_t* CBG = (bf16_t*)(p.ws + OFF_CBG); bf16_t* PG = (bf16_t*)p.out; bf16_t* HB1 = (bf16_t*)p.out; bf16_t* HB2 = (bf16_t*)(p.ws + OFF_ACT + HID_BYTES + 67108864);

#define GEMM(KIND, ...) do { const pg8::Gemm gd = pg8::Gemm{__VA_ARGS__}; pg8::StaticOrder S; S.init(gd.M, gd.N, G, wg); pg8::gemm_phase<KIND>(lds, gd, S); GSYNC(); } while (0)
    unsigned* barw = (unsigned*)(p.ws + OFF_BAR);
    volatile LAS unsigned* bst = (volatile LAS unsigned*)(lds + LDS_STAGE);
    if (wg == 0) for (int i = threadIdx.x; i < XCD_BAR_WORDS; i += NTHREADS) barw[i] = 0u;
    if (threadIdx.x < 2) bst[threadIdx.x] = 0u;
    norm_pass(NormDesc{0, p.x, nullptr, nullptr, nullptr, p.nmp, U_R2, 0, 0}, wg, G);
    convert_w(ConvDesc{p.ret_w_in, WA, 2048, RIN, RIN, 1}, lds, wg, G);
    convert_w(ConvDesc{p.ret_w_out, WB, 4096, 2048, 2048, 0}, lds, wg, G);
    rot_table(ROT, wg, G);
    grid.sync();
    const XcdBarrier xb = xcd_barrier_post(barw, bst);
#define GSYNC() xcd_barrier(xb)
    GEMM(3, U_R2, WA, T, RIN, 2048, 2048, 3, ACT, RIN, ROT);
    ret_pre(ACT, PG, lds, wg, G); GSYNC();
    ret_scan(ACT, PG, lds, wg, G); GSYNC();
    ret_gn(ACT, p.ret_gn_w, wg, G); GSYNC();
    GEMM(1, ACT + 8192, WB, T, 2048, 4096, RIN, 1, MF_R2, 2048, nullptr);
    norm_pass(NormDesc{1, MF_R2, p.x, HB1, p.nmq, p.nfp, U_ACT, 0, 1}, wg, G);
    convert_w(ConvDesc{p.w_up, WA, 2048, DFF, DFF, 0}, lds, wg, G);
    convert_w(ConvDesc{p.w_down, WB, DFF, 2048, 2048, 0}, lds, wg, G);
    GSYNC();
    GEMM(2, U_ACT, WA, T, DFF, 2048, 2048, 2, ACT, DFF, nullptr);
    GEMM(1, ACT, WB, T, 2048, DFF, DFF, 1, F_ACT, 2048, nullptr);
    norm_pass(NormDesc{1, F_ACT, HB1, HB1, p.nfq, p.nmp + DM, U_R2, 1, 1}, wg, G);
    convert_w(ConvDesc{p.ssd_w_in, WA, 2048, SIN, SINW, 0}, lds, wg, G);
    convert_w(ConvDesc{p.ssd_w_out, WB, 4096, 2048, 2048, 0}, lds, wg, G);
    GSYNC();
    GEMM(5, U_R2, WA, T, SING, 2048, 2048, 5, ACT, SINP, (const float*)HALO);
    ssd_dt(U_R2, WA + (size_t)SING * 2048, p.dt_bias, p.a_log, DTV, ACV, lds, wg, G);
    ssd_cb(ACT, HALO, p.conv_w, p.conv_b, CBG, lds, wg, G); GSYNC();
    ssd_scan(ACT, HALO, p.conv_w, p.conv_b, CBG, DTV, ACV, p.d_skip, lds, wg, G); GSYNC();
    ssd_norm(ACT, p.ssd_norm_w, wg, G); GSYNC();
    GEMM(1, ACT + 4096, WB, T, 2048, 4096, SINP, 1, MF_R2, 2048, nullptr);
    norm_pass(NormDesc{1, MF_R2, HB1, HB2, p.nmq + DM, p.nfp + DM, U_ACT, 1, 1}, wg, G);
    convert_w(ConvDesc{p.w_up + (size_t)2048 * DFF, WA, 2048, DFF, DFF, 0}, lds, wg, G);
    convert_w(ConvDesc{p.w_down + (size_t)DFF * 2048, WB, DFF, 2048, 2048, 0}, lds, wg, G);
    GSYNC();
    GEMM(2, U_ACT, WA, T, DFF, 2048, 2048, 2, ACT, DFF, nullptr);
    GEMM(1, ACT, WB, T, 2048, DFF, DFF, 1, F_ACT, 2048, nullptr);
    norm_pass(NormDesc{2, F_ACT, HB2, p.out, p.nfq + DM, nullptr, nullptr, 1, 0}, wg, G);
#undef GEMM
#undef GSYNC
}

extern "C" void kernel_launch(void* const* d_in, const int* in_sizes, int n_in, void* d_out, int out_size, void* d_ws, size_t ws_size, hipStream_t stream) {
    static int grid_blocks = 0;
    if (!grid_blocks) {
        int dev = 0, cus = 0, per_cu = 0;
        hipGetDevice(&dev);
        hipDeviceGetAttribute(&cus, hipDeviceAttributeMultiprocessorCount, dev);
        hipFuncSetAttribute((const void*)mega, hipFuncAttributeMaxDynamicSharedMemorySize, LDS_BYTES);
        hipOccupancyMaxActiveBlocksPerMultiprocessor(&per_cu, (const void*)mega, NTHREADS, LDS_BYTES);
        if (per_cu < 1) per_cu = 1;
        grid_blocks = cus * per_cu;
        if (ws_size < WS_END) { fprintf(stderr, "kernel_launch: workspace too small: %zu < %zu\n", ws_size, (size_t)WS_END); grid_blocks = -1; }
    }
    if (grid_blocks < 0) return;
    Params p{};
    p.x = (const float*)d_in[0]; p.nmp = (const float*)d_in[1]; p.nmq = (const float*)d_in[2]; p.nfp = (const float*)d_in[3]; p.nfq = (const float*)d_in[4];
    p.ret_w_in = (const float*)d_in[5]; p.ret_gn_w = (const float*)d_in[6]; p.ret_w_out = (const float*)d_in[7];
    p.ssd_w_in = (const float*)d_in[8]; p.conv_w = (const float*)d_in[9]; p.conv_b = (const float*)d_in[10]; p.dt_bias = (const float*)d_in[11];
    p.a_log = (const float*)d_in[12]; p.d_skip = (const float*)d_in[13]; p.ssd_norm_w = (const float*)d_in[14]; p.ssd_w_out = (const float*)d_in[15];
    p.w_up = (const float*)d_in[16]; p.w_down = (const float*)d_in[17];
    p.out = (float*)d_out; p.ws = (unsigned char*)d_ws;
    void* args[] = {&p};
    hipError_t e = hipLaunchCooperativeKernel((const void*)mega, dim3(grid_blocks), dim3(NTHREADS), args, LDS_BYTES, stream);
    if (e != hipSuccess) fprintf(stderr, "cooperative launch failed: %s (grid %d)\n", hipGetErrorString(e), grid_blocks);
}
```

```cpp
#include <hip/hip_runtime.h>
#include <hip/hip_cooperative_groups.h>
#include <cstdio>
namespace cg = cooperative_groups;

#define LAS __attribute__((address_space(3)))
typedef unsigned short bf16_t;
typedef short bf16x8 __attribute__((ext_vector_type(8)));
typedef short s16x4 __attribute__((ext_vector_type(4)));
typedef float f32x4 __attribute__((ext_vector_type(4)));
typedef float f32x2 __attribute__((ext_vector_type(2)));
typedef unsigned u32x4 __attribute__((ext_vector_type(4)));
typedef unsigned u32x2 __attribute__((ext_vector_type(2)));

constexpr int T = 16384, DM = 2048, SEQ = 8192;
constexpr int RIN = 12288;
constexpr int SIN = 10304, SINP = 10496, SINW = 10368, SING = 10240;
constexpr int DFF = 8192;
constexpr int NTHREADS = 512;
constexpr int LDS_STAGE = 131072;
constexpr int LDS_BYTES = LDS_STAGE + 16;

constexpr size_t OFF_WA = 0;
constexpr size_t OFF_WB = 50331648;
constexpr size_t OFF_ACT = OFF_WB + 33554432;
constexpr size_t ACT_BYTES = 402653184;
constexpr size_t HID_BYTES = 268435456;
constexpr size_t OFF_R2 = OFF_ACT + ACT_BYTES;
constexpr size_t R2_BYTES = 134217728;
constexpr size_t OFF_ROT = OFF_R2 + 67108864;
constexpr size_t OFF_HALO = OFF_R2 + 67108864;
constexpr size_t OFF_DTV = OFF_R2 + 67108864 + 16777216;
constexpr size_t OFF_ACV = OFF_DTV + 4194304;
constexpr size_t OFF_CBG = OFF_R2 + 109051904;
constexpr size_t OFF_BAR = OFF_R2 + 100663296;
constexpr size_t WS_END = OFF_R2 + R2_BYTES;

typedef __bf16 bf16x2v __attribute__((ext_vector_type(2)));
__device__ __forceinline__ unsigned cvt_pk_bf16(float lo, float hi) { const f32x2 v = {lo, hi}; const bf16x2v b = __builtin_convertvector(v, bf16x2v); return __builtin_bit_cast(unsigned, b); }
__device__ __forceinline__ unsigned pk2(float lo, float hi) { return cvt_pk_bf16(lo, hi); }
__device__ __forceinline__ unsigned f2bf(float f) { return (unsigned)__builtin_bit_cast(unsigned short, (__bf16)f); }
__device__ __forceinline__ float bflo(unsigned w) { return __uint_as_float(w << 16); }
__device__ __forceinline__ float bfhi(unsigned w) { return __uint_as_float(w & 0xffff0000u); }
__device__ __forceinline__ float bf2f(bf16_t b) { return __uint_as_float(((unsigned)b) << 16); }
__device__ __forceinline__ float wave_sum(float v) {
#pragma unroll
    for (int o = 32; o >= 1; o >>= 1) v += __shfl_xor(v, o);
    return v;
}
__device__ __forceinline__ int otid() { int t = threadIdx.x; asm volatile("" : "+v"(t)); return t; }
#define LDS_BARRIER() do { asm volatile("s_waitcnt lgkmcnt(0)" ::: "memory"); __builtin_amdgcn_s_barrier(); asm volatile("" ::: "memory"); } while (0)
__device__ __forceinline__ float silu(float x) { return x * __builtin_amdgcn_rcpf(1.0f + __expf(-x)); }

__device__ __forceinline__ bf16x8 tr_frag(LAS unsigned char* img, int rs, int kbase, int n0, int lane) {
    const int g = lane >> 4, q = (lane & 15) >> 2, p = lane & 3;
    LAS unsigned char* a0 = img + (kbase + 8 * g + q) * rs + (n0 + 4 * p) * 2;
    s16x4 a = __builtin_amdgcn_ds_read_tr16_b64_v4i16((LAS s16x4*)a0);
    s16x4 b = __builtin_amdgcn_ds_read_tr16_b64_v4i16((LAS s16x4*)(a0 + 4 * rs));
    bf16x8 r = {a[0], a[1], a[2], a[3], b[0], b[1], b[2], b[3]};
    return r;
}

namespace pg8 {
constexpr int BM = 256, BK = 64, HALF = 128, HTB = HALF * BK * 2, STAGE_BYTES = 8 * HTB, NXCD = 8, WGM = 8;
__device__ __forceinline__ int lds_byte(int r, int c) { const int st = (r >> 4) * 2 + (c >> 5), rr = r & 15, cc = c & 31, ob = rr * 64 + cc * 2; return st * 1024 + (ob ^ (((ob >> 9) & 1) << 5)); }
__device__ __forceinline__ void stage_rc(int b, int& R, int& C) { const int st = b / 1024, sb = b % 1024, swz = sb ^ (((sb >> 9) & 1) << 5); R = (st >> 1) * 16 + swz / 64; C = (st & 1) * 32 + (swz % 64) / 2; }
__device__ __forceinline__ int perm32(int rho) { const int n = rho >> 4, i = rho & 15; return 8 * (i >> 2) + 4 * n + (i & 3); }
struct Unit { int pm, pn; };
struct Gemm { const bf16_t* A; const bf16_t* Bt; int M, N, K, lda; int kind; void* out; int ldc; const float* rot; };
struct StaticOrder {
    int nM, nN, nwg, G, c;
    __device__ void init(int M, int N, int G_, int c_) { nM = M / BM; nN = N / BM; nwg = nM * nN; G = G_; c = c_; }
    __device__ bool next(int i, Unit& u) const {
        const long L = (long)i * G + c; if (L >= nwg) return false;
        int wgid = (int)L; { const int q = nwg / NXCD, r = nwg % NXCD, xcd = wgid % NXCD, off = wgid / NXCD; wgid = (xcd < r ? xcd * (q + 1) : r * (q + 1) + (xcd - r) * q) + off; }
        const int nig = WGM * nN, gid = wgid / nig, fm = gid * WGM, gsz = (nM - fm) < WGM ? (nM - fm) : WGM;
        u.pm = fm + ((wgid % nig) % gsz); u.pn = (wgid % nig) / gsz; return true;
    }
};

template <int KIND> __device__ __forceinline__ void epilogue(const Gemm& g, const f32x4 (&acc)[2][2][4][2], const Unit& u, int wr, int wc, int fr, int fq) {
    if constexpr (KIND == 0) {
        float* C = (float*)g.out; const int ldc = g.ldc;
        const int row0 = u.pm * BM + wr * 64 + fr, col0 = u.pn * BM + wc * 32 + 4 * fq;
#pragma unroll
        for (int ai = 0; ai < 2; ++ai)
#pragma unroll
            for (int m = 0; m < 4; ++m) { float* rowp = C + (size_t)(row0 + ai * HALF + m * 16) * ldc + col0;
#pragma unroll
                for (int bj = 0; bj < 2; ++bj)
#pragma unroll
                    for (int n = 0; n < 2; ++n) *(f32x4*)(rowp + bj * HALF + n * 16) = acc[ai][bj][m][n]; }
    } else {
        bf16_t* O = (bf16_t*)g.out; const int ldc = g.ldc;
        const int row0 = u.pm * BM + wr * 64 + fr, col0 = u.pn * BM + wc * 32 + 8 * fq;
        const bool isrot = (KIND == 3) && (u.pn < 16);
        const float sc = (u.pn >= 8) ? 0.0625f : 1.0f;
        constexpr bool relu2 = (KIND == 2);
#pragma unroll
        for (int ai = 0; ai < 2; ++ai)
#pragma unroll
            for (int m = 0; m < 4; ++m) {
                const int row = row0 + ai * HALF + m * 16;
                bf16_t* rowp = O + (size_t)row * ldc + col0;
                const int pos = row & (SEQ - 1);
#pragma unroll
                for (int bj = 0; bj < 2; ++bj) {
                    f32x4 v0 = acc[ai][bj][m][0], v1 = acc[ai][bj][m][1];
                    if (relu2) {
#pragma unroll
                        for (int j = 0; j < 4; ++j) { const float a = fmaxf(v0[j], 0.f), b = fmaxf(v1[j], 0.f); v0[j] = a * a; v1[j] = b * b; }
                    }
                    if (isrot) {
                        const float* rp = g.rot + ((size_t)pos * 128 + 64 * bj + 16 * wc + 4 * fq) * 2;
                        const f32x4 c0 = *(const f32x4*)rp, c1 = *(const f32x4*)(rp + 4);
                        f32x4 r0, r1;
                        r0[0] = v0[0] * c0[0] - v0[1] * c0[1]; r0[1] = v0[0] * c0[1] + v0[1] * c0[0];
                        r0[2] = v0[2] * c0[2] - v0[3] * c0[3]; r0[3] = v0[2] * c0[3] + v0[3] * c0[2];
                        r1[0] = v1[0] * c1[0] - v1[1] * c1[1]; r1[1] = v1[0] * c1[1] + v1[1] * c1[0];
                        r1[2] = v1[2] * c1[2] - v1[3] * c1[3]; r1[3] = v1[2] * c1[3] + v1[3] * c1[2];
                        v0 = r0 * sc; v1 = r1 * sc;
                    }
                    u32x4 w; w.x = cvt_pk_bf16(v0[0], v0[1]); w.y = cvt_pk_bf16(v0[2], v0[3]); w.z = cvt_pk_bf16(v1[0], v1[1]); w.w = cvt_pk_bf16(v1[2], v1[3]);
                    *(u32x4*)(rowp + bj * HALF) = w;
                    if constexpr (KIND == 5) {
                        if (m == 3 && fr >= 13 && u.pn >= 16) *(u32x4*)((bf16_t*)g.rot + ((size_t)(row >> 6) * 3 + (fr - 13)) * 6144 + (col0 - 4096) + bj * HALF) = w;
                    }
                }
            }
    }
}

template <int KIND> __device__ __forceinline__ void gemm_phase(LAS unsigned char* lds, const Gemm g, const StaticOrder& S) {
    const int tid = otid(), wid = __builtin_amdgcn_readfirstlane(tid >> 6), lane = tid & 63, wr = wid >> 2, wc = wid & 3, fr = lane & 15, fq = lane >> 4;
    const int K = g.K, nt = K / BK, lda = g.lda;
    constexpr bool perm = KIND != 0;
    unsigned voffA[2], voffB[2];
#pragma unroll
    for (int i = 0; i < 2; ++i) { int R, C; stage_rc(tid * 16 + i * 8192, R, C); const int Rb = perm ? ((R & ~31) + perm32(R & 31)) : R;
        voffA[i] = (unsigned)(R * lda + C) * 2u; voffB[i] = (unsigned)(Rb * K + C) * 2u; }
    const size_t kstep = (size_t)(BK * 2);
    const size_t hstepA = (size_t)HALF * lda * 2, hstepB = (size_t)HALF * K * 2;
    const size_t tstepA = 2 * hstepA, tstepB = 2 * hstepB;
    const unsigned ldsw = (unsigned)wid * 1024u;
    const int aoff = lds_byte(wr * 64 + fr, fq * 8), boff = lds_byte(wc * 32 + fr, fq * 8);
#define PG8_SA(b, h) (((b) * 2 + (h)) * HTB)
#define PG8_SB(b, h) ((4 + (b) * 2 + (h)) * HTB)
#define PG8_STAGE(bufoff, gbase, voff) do { _Pragma("unroll") for (int _i = 0; _i < 2; ++_i) \
        __builtin_amdgcn_global_load_lds((const unsigned*)((const char*)(gbase) + (voff)[_i]), (LAS unsigned*)(lds + (bufoff) + ldsw + _i * 8192), 16, 0, 0); } while (0)
#define PG8_LDA(dst, b, h) do { _Pragma("unroll") for (int m = 0; m < 4; ++m) _Pragma("unroll") for (int k = 0; k < 2; ++k) dst[m][k] = *(const LAS bf16x8*)(lds + PG8_SA(b, h) + aoff + m * 2048 + k * 1024); } while (0)
#define PG8_LDB(dst, b, h) do { _Pragma("unroll") for (int n = 0; n < 2; ++n) _Pragma("unroll") for (int k = 0; k < 2; ++k) dst[n][k] = *(const LAS bf16x8*)(lds + PG8_SB(b, h) + boff + n * 2048 + k * 1024); } while (0)
#define PG8_MMA(ai, bj, At, Bt) do { __builtin_amdgcn_s_setprio(1); _Pragma("unroll") for (int m = 0; m < 4; ++m) _Pragma("unroll") for (int n = 0; n < 2; ++n) _Pragma("unroll") for (int k = 0; k < 2; ++k) \
        acc[ai][bj][m][n] = __builtin_amdgcn_mfma_f32_16x16x32_bf16(Bt[n][k], At[m][k], acc[ai][bj][m][n], 0, 0, 0); __builtin_amdgcn_s_setprio(0); } while (0)
#define PG8_WAIT_V(n) asm volatile("s_waitcnt vmcnt(" #n ")" ::: "memory")
#define PG8_WAIT_L(n) asm volatile("s_waitcnt lgkmcnt(" #n ")" ::: "memory")
#define PG8_BAR __builtin_amdgcn_s_barrier()
#define PG8_SCHED __builtin_amdgcn_sched_barrier(0)
    Unit cur, nxt; int ui = 0;
    if (!S.next(0, cur)) return;
    f32x4 acc[2][2][4][2];
#pragma unroll
    for (int a = 0; a < 2; ++a)
#pragma unroll
        for (int b = 0; b < 2; ++b)
#pragma unroll
            for (int m = 0; m < 4; ++m)
#pragma unroll
                for (int n = 0; n < 2; ++n) acc[a][b][m][n] = (f32x4){0.f, 0.f, 0.f, 0.f};
    bf16x8 At[4][2], B0[2][2], B1[2][2];
    const char* cA = (const char*)g.A + (size_t)cur.pm * tstepA; const char* cB = (const char*)g.Bt + (size_t)cur.pn * tstepB;
    PG8_STAGE(PG8_SB(0, 0), cB, voffB); PG8_STAGE(PG8_SA(0, 0), cA, voffA); PG8_STAGE(PG8_SB(0, 1), cB + hstepB, voffB); PG8_STAGE(PG8_SA(0, 1), cA + hstepA, voffA);
    if (wr == 1) PG8_BAR;
    PG8_WAIT_V(4); PG8_BAR;
    PG8_STAGE(PG8_SB(1, 0), cB + kstep, voffB); PG8_STAGE(PG8_SA(1, 0), cA + kstep, voffA); PG8_STAGE(PG8_SB(1, 1), cB + hstepB + kstep, voffB);
    PG8_WAIT_V(6); PG8_BAR;
    for (;;) {
        const bool has_next = S.next(ui + 1, nxt);
        const char* nA = has_next ? (const char*)g.A + (size_t)nxt.pm * tstepA : cA; const char* nB = has_next ? (const char*)g.Bt + (size_t)nxt.pn * tstepB : cB;
        for (int t = 0; t < nt; t += 2) {
            const bool last = (t == nt - 2);
            const char* a1 = cA + (size_t)(t + 1) * kstep;
            const char* a2 = last ? nA : cA + (size_t)(t + 2) * kstep; const char* b2 = last ? nB : cB + (size_t)(t + 2) * kstep;
            const char* a3 = a2 + kstep; const char* b3 = b2 + kstep;
            PG8_LDB(B0, 0, 0); PG8_SCHED; PG8_LDA(At, 0, 0); PG8_STAGE(PG8_SA(1, 1), a1 + hstepA, voffA);
            PG8_WAIT_L(8); PG8_BAR; PG8_WAIT_L(0); PG8_MMA(0, 0, At, B0); PG8_BAR; PG8_SCHED;
            PG8_LDB(B1, 0, 1); PG8_STAGE(PG8_SB(0, 0), b2, voffB);
            PG8_BAR; PG8_WAIT_L(0); PG8_MMA(0, 1, At, B1); PG8_BAR;
            PG8_LDA(At, 0, 1); PG8_STAGE(PG8_SA(0, 0), a2, voffA);
            PG8_BAR; PG8_WAIT_L(0); PG8_MMA(1, 0, At, B0); PG8_BAR; PG8_SCHED;
            PG8_STAGE(PG8_SB(0, 1), b2 + hstepB, voffB);
            PG8_WAIT_V(6); PG8_BAR; PG8_MMA(1, 1, At, B1); PG8_BAR;
            PG8_LDB(B0, 1, 0); PG8_SCHED; PG8_LDA(At, 1, 0); PG8_STAGE(PG8_SA(0, 1), a2 + hstepA, voffA);
            PG8_WAIT_L(8); PG8_BAR; PG8_WAIT_L(0); PG8_MMA(0, 0, At, B0); PG8_BAR; PG8_SCHED;
            PG8_LDB(B1, 1, 1); PG8_STAGE(PG8_SB(1, 0), b3, voffB);
            PG8_BAR; PG8_WAIT_L(0); PG8_MMA(0, 1, At, B1); PG8_BAR;
            PG8_LDA(At, 1, 1); PG8_STAGE(PG8_SA(1, 0), a3, voffA);
            PG8_BAR; PG8_WAIT_L(0); PG8_MMA(1, 0, At, B0); PG8_BAR; PG8_SCHED;
            PG8_STAGE(PG8_SB(1, 1), b3 + hstepB, voffB);
            PG8_WAIT_V(6); PG8_BAR; PG8_MMA(1, 1, At, B1); PG8_BAR;
        }
        epilogue<KIND>(g, acc, cur, wr, wc, fr, fq);
        if (!has_next) break;
#pragma unroll
        for (int a = 0; a < 2; ++a)
#pragma unroll
            for (int b = 0; b < 2; ++b)
#pragma unroll
                for (int m = 0; m < 4; ++m)
#pragma unroll
                    for (int n = 0; n < 2; ++n) acc[a][b][m][n] = (f32x4){0.f, 0.f, 0.f, 0.f};
        cur = nxt; cA = nA; cB = nB; ++ui;
    }
    PG8_WAIT_V(0);
    if (wr == 0) PG8_BAR;
    PG8_BAR;
#undef PG8_SA
#undef PG8_SB
#undef PG8_STAGE
#undef PG8_LDA
#undef PG8_LDB
#undef PG8_MMA
#undef PG8_WAIT_V
#undef PG8_WAIT_L
#undef PG8_BAR
#undef PG8_SCHED
}
}

struct ConvDesc { const float* src; bf16_t* dst; int K, Nsrc, Ndst, permq; };
__device__ __forceinline__ void convert_w(const ConvDesc& c, LAS unsigned char* lds, int wg, int G) {
    const int tid = otid();
    constexpr int RS = 144;
    const int nnt = c.Ndst / 128, ntile = (c.K / 64) * nnt;
    const int c4 = tid & 31, kq = tid >> 5;
    f32x4 r[4];
#define CW_LOAD(u_) do { const int nt_ = (u_) % nnt, kt_ = (u_) / nnt; const int col_ = nt_ * 128 + c4 * 4; \
        const float* sp_ = c.src + (size_t)(kt_ * 64 + kq * 4) * c.Nsrc + col_; const bool ok_ = col_ < c.Nsrc; \
        _Pragma("unroll") for (int i_ = 0; i_ < 4; ++i_) r[i_] = ok_ ? *(const f32x4*)(sp_ + (size_t)i_ * c.Nsrc) : (f32x4){0.f, 0.f, 0.f, 0.f}; } while (0)
    int u = wg;
    if (u < ntile) CW_LOAD(u);
    while (u < ntile) {
#pragma unroll
        for (int e = 0; e < 4; ++e) { u32x2 w; w.x = pk2(r[0][e], r[1][e]); w.y = pk2(r[2][e], r[3][e]); *(LAS u32x2*)(lds + (c4 * 4 + e) * RS + kq * 8) = w; }
        const int un = u + G;
        if (un < ntile) CW_LOAD(un);
        LDS_BARRIER();
        {
            const int nt = u % nnt, kt = u / nnt, n0 = nt * 128;
            const bool pm = c.permq && n0 < 4096;
#pragma unroll
            for (int i = 0; i < 2; ++i) { const int idx = i * 512 + tid, row = idx >> 3, kb = idx & 7;
                const u32x4 v = *(const LAS u32x4*)(lds + row * RS + kb * 16);
                const int drow = pm ? ((n0 & ~255) + 2 * row + ((n0 >> 7) & 1)) : (n0 + row);
                *(u32x4*)(c.dst + (size_t)drow * c.K + kt * 64 + kb * 8) = v; }
        }
        LDS_BARRIER();
        u = un;
    }
#undef CW_LOAD
}

struct NormDesc { int mode; const void* m; const void* hres; void* hout; const float* wpost; const float* wpre; bf16_t* ub; int hin_bf16, hout_bf16; };
__device__ __forceinline__ void norm_pass(const NormDesc& d, int wg, int G) {
    const int tid_ = otid(); const int wave = tid_ >> 6, lane = tid_ & 63;
    constexpr int NR = 2;
    for (int row0 = (wg * 8 + wave) * NR; row0 < T; row0 += G * 8 * NR) {
        float v[NR][4][8]; float ss[NR], r[NR], r2[NR];
#pragma unroll
        for (int q = 0; q < NR; ++q) {
            const size_t ro = (size_t)(row0 + q) * DM;
            if (d.mode == 0) {
#pragma unroll
                for (int i = 0; i < 4; ++i) { const int c = (i * 64 + lane) * 8; const f32x4 a = *(const f32x4*)((const float*)d.m + ro + c), b = *(const f32x4*)((const float*)d.m + ro + c + 4);
#pragma unroll
                    for (int e = 0; e < 4; ++e) { v[q][i][e] = a[e]; v[q][i][4 + e] = b[e]; } }
            } else {
#pragma unroll
                for (int i = 0; i < 4; ++i) { const int c = (i * 64 + lane) * 8; const u32x4 a = *(const u32x4*)((const bf16_t*)d.m + ro + c);
                    v[q][i][0] = bflo(a.x); v[q][i][1] = bfhi(a.x); v[q][i][2] = bflo(a.y); v[q][i][3] = bfhi(a.y); v[q][i][4] = bflo(a.z); v[q][i][5] = bfhi(a.z); v[q][i][6] = bflo(a.w); v[q][i][7] = bfhi(a.w); }
            }
        }
#pragma unroll
        for (int q = 0; q < NR; ++q) {
            float s = 0.f;
#pragma unroll
            for (int i = 0; i < 4; ++i)
#pragma unroll
                for (int e = 0; e < 8; ++e) s += v[q][i][e] * v[q][i][e];
            ss[q] = s;
        }
#pragma unroll
        for (int q = 0; q < NR; ++q) { ss[q] = wave_sum(ss[q]); r[q] = rsqrtf(ss[q] * (1.0f / DM) + 1e-6f); r2[q] = r[q]; }
        if (d.mode != 0) {
            float s2[NR];
#pragma unroll
            for (int q = 0; q < NR; ++q) {
                const size_t ro = (size_t)(row0 + q) * DM;
                float s = 0.f;
#pragma unroll
                for (int i = 0; i < 4; ++i) { const int c = (i * 64 + lane) * 8;
                    const f32x4 w0 = *(const f32x4*)(d.wpost + c), w1 = *(const f32x4*)(d.wpost + c + 4);
                    f32x4 h0, h1;
                    if (d.hin_bf16) { const u32x4 hv = *(const u32x4*)((const bf16_t*)d.hres + ro + c); h0[0] = bflo(hv.x); h0[1] = bfhi(hv.x); h0[2] = bflo(hv.y); h0[3] = bfhi(hv.y); h1[0] = bflo(hv.z); h1[1] = bfhi(hv.z); h1[2] = bflo(hv.w); h1[3] = bfhi(hv.w); }
                    else { h0 = *(const f32x4*)((const float*)d.hres + ro + c); h1 = *(const f32x4*)((const float*)d.hres + ro + c + 4); }
                    f32x4 o0, o1;
#pragma unroll
                    for (int e = 0; e < 4; ++e) { o0[e] = h0[e] + v[q][i][e] * r[q] * w0[e]; o1[e] = h1[e] + v[q][i][4 + e] * r[q] * w1[e]; v[q][i][e] = o0[e]; v[q][i][4 + e] = o1[e]; s += o0[e] * o0[e] + o1[e] * o1[e]; }
                    if (d.hout_bf16) { u32x4 hw; hw.x = pk2(o0[0], o0[1]); hw.y = pk2(o0[2], o0[3]); hw.z = pk2(o1[0], o1[1]); hw.w = pk2(o1[2], o1[3]); *(u32x4*)((bf16_t*)d.hout + ro + c) = hw; }
                    else { *(f32x4*)((float*)d.hout + ro + c) = o0; *(f32x4*)((float*)d.hout + ro + c + 4) = o1; } }
                s2[q] = s;
            }
            if (d.mode == 1) {
#pragma unroll
                for (int q = 0; q < NR; ++q) { s2[q] = wave_sum(s2[q]); r2[q] = rsqrtf(s2[q] * (1.0f / DM) + 1e-6f); }
            }
        }
        if (d.mode != 2) {
#pragma unroll
            for (int q = 0; q < NR; ++q) {
                const size_t ro = (size_t)(row0 + q) * DM;
#pragma unroll
                for (int i = 0; i < 4; ++i) { const int c = (i * 64 + lane) * 8;
                    const f32x4 w0 = *(const f32x4*)(d.wpre + c), w1 = *(const f32x4*)(d.wpre + c + 4);
                    u32x4 o; o.x = pk2(v[q][i][0] * r2[q] * w0[0], v[q][i][1] * r2[q] * w0[1]); o.y = pk2(v[q][i][2] * r2[q] * w0[2], v[q][i][3] * r2[q] * w0[3]);
                    o.z = pk2(v[q][i][4] * r2[q] * w1[0], v[q][i][5] * r2[q] * w1[1]); o.w = pk2(v[q][i][6] * r2[q] * w1[2], v[q][i][7] * r2[q] * w1[3]);
                    *(u32x4*)(d.ub + ro + c) = o; }
            }
        }
    }
}

__device__ __forceinline__ void rot_table(float* rot, int wg, int G) {
    for (int e = wg * NTHREADS + otid(); e < SEQ * 128; e += G * NTHREADS) {
        const int pos = e >> 7, jf = e & 127;
        const float inv = exp2f(-(float)jf * (13.287712379549449f / 128.0f));
        const float ang = (float)pos * inv;
        const double a = (double)ang; const double k = rint(a * 0.15915494309189535); const float rf = (float)(a - k * 6.283185307179586);
        f32x2 cs; cs.x = cosf(rf); cs.y = sinf(rf);
        *(f32x2*)(rot + 2 * (size_t)e) = cs;
    }
}

__device__ __forceinline__ void ret_pre(const bf16_t* proj, bf16_t* Pg, LAS unsigned char* lds, int wg, int G) {
    const int tid = otid(), lane = tid & 63, wid = __builtin_amdgcn_readfirstlane(tid >> 6), fr = lane & 15, fq = lane >> 4;
    constexpr int QS = 528;
    LAS unsigned char* Qs = lds; LAS unsigned char* Ks = lds + 33792;
    const int lm = wid >> 1, c2 = wid & 1;
    u32x4 rq[4], rk[4];
    int u = wg;
    if (u < 2048) {
        const bf16_t* qb = proj + (size_t)((u >> 3) * 64) * RIN + (u & 7) * 256;
#pragma unroll
        for (int i = 0; i < 4; ++i) { const int idx = i * 512 + tid, row = idx >> 5, ch = idx & 31; rq[i] = *(const u32x4*)(qb + (size_t)row * RIN + ch * 8); rk[i] = *(const u32x4*)(qb + 2048 + (size_t)row * RIN + ch * 8); }
    }
    for (; u < 2048; u += G) {
        const int h = u & 7, t0 = (u >> 3) * 64;
#pragma unroll
        for (int i = 0; i < 4; ++i) { const int idx = i * 512 + tid, row = idx >> 5, ch = idx & 31; *(LAS u32x4*)(Qs + row * QS + ch * 16) = rq[i]; *(LAS u32x4*)(Ks + row * QS + ch * 16) = rk[i]; }
        LDS_BARRIER();
        const int un = u + G;
        if (un < 2048) {
            const bf16_t* qb = proj + (size_t)((un >> 3) * 64) * RIN + (un & 7) * 256;
#pragma unroll
            for (int i = 0; i < 4; ++i) { const int idx = i * 512 + tid, row = idx >> 5, ch = idx & 31; rq[i] = *(const u32x4*)(qb + (size_t)row * RIN + ch * 8); rk[i] = *(const u32x4*)(qb + 2048 + (size_t)row * RIN + ch * 8); }
        }
        const float lg = log1pf(-exp2f(-5.0f - (float)h));
        f32x4 aP0 = {0.f, 0.f, 0.f, 0.f}, aP1 = {0.f, 0.f, 0.f, 0.f};
#pragma unroll
        for (int ks = 0; ks < 8; ++ks) {
            const bf16x8 a = *(const LAS bf16x8*)(Qs + (lm * 16 + fr) * QS + ks * 64 + fq * 16);
            const bf16x8 b0 = *(const LAS bf16x8*)(Ks + ((c2 * 2 + 0) * 16 + fr) * QS + ks * 64 + fq * 16);
            const bf16x8 b1 = *(const LAS bf16x8*)(Ks + ((c2 * 2 + 1) * 16 + fr) * QS + ks * 64 + fq * 16);
            aP0 = __builtin_amdgcn_mfma_f32_16x16x32_bf16(a, b0, aP0, 0, 0, 0);
            aP1 = __builtin_amdgcn_mfma_f32_16x16x32_bf16(a, b1, aP1, 0, 0, 0);
        }
#pragma unroll
        for (int j = 0; j < 4; ++j) { const int l = lm * 16 + fq * 4 + j;
            const int m0 = (c2 * 2 + 0) * 16 + fr, m1 = m0 + 16;
            const int d0 = l > m0 ? l - m0 : m0 - l, d1 = l > m1 ? l - m1 : m1 - l;
            bf16_t* pp = Pg + ((size_t)(t0 + l) * 8 + h) * 64;
            pp[m0] = (bf16_t)f2bf(aP0[j] * expf((float)d0 * lg));
            pp[m1] = (bf16_t)f2bf(aP1[j] * expf((float)d1 * lg)); }
        LDS_BARRIER();
    }
}

__device__ __forceinline__ void ret_scan(bf16_t* proj, const bf16_t* Pg, LAS unsigned char* lds, int wg, int G) {
    const int tid = otid(), lane = tid & 63, wid = __builtin_amdgcn_readfirstlane(tid >> 6), fr = lane & 15, fq = lane >> 4;
    constexpr int QS = 528, VS = 80, PS = 144;
    LAS unsigned char* Qs = lds; LAS unsigned char* Ks = lds + 33792; LAS unsigned char* Vs = lds + 67584; LAS unsigned char* Vz = lds + 72704;
    LAS unsigned char* Ps = lds + 77824; LAS unsigned char* St0 = lds + 87040;
    const int lm = wid >> 1, c2 = wid & 1;
    for (int unit = wg; unit < 256; unit += G) {
        const int xc = unit & 7, ii = unit >> 3, bh = xc * 2 + (ii >> 4), vs = ii & 15, b = bh >> 3, h = bh & 7;
        const float lg = log1pf(-exp2f(-5.0f - (float)h));
        float xi[4];
#pragma unroll
        for (int j = 0; j < 4; ++j) { const int l = lm * 16 + fq * 4 + j; xi[j] = expf((float)(l + 1) * lg); }
        const float cdecay = expf(64.0f * lg);
        const int vrow = (tid & 255) >> 2, vch = tid & 3;
        const float zeta = expf((float)(63 - vrow) * lg);
        const int prow = tid >> 3, pch = tid & 7;
        f32x4 accS[2][2];
#pragma unroll
        for (int a = 0; a < 2; ++a)
#pragma unroll
            for (int c = 0; c < 2; ++c) accS[a][c] = (f32x4){0.f, 0.f, 0.f, 0.f};
        for (int i = tid; i < 16896 / 4; i += NTHREADS) ((LAS unsigned*)St0)[i] = 0u;
        const bf16_t* qb = proj + (size_t)(b * SEQ) * RIN + h * 256;
        const bf16_t* kb = qb + 2048;
        bf16_t* vb = proj + (size_t)(b * SEQ) * RIN + 4096 + h * 512 + vs * 32;
        const bf16_t* pb = Pg + ((size_t)(b * SEQ + prow) * 8 + h) * 64 + pch * 8;
        u32x4 rq[2][4], rk[2][4], rv[2], rp[2];
#define RET_LOAD(S_, cc_) do { const size_t ro_ = (size_t)(cc_) * 64 * RIN; \
            _Pragma("unroll") for (int i = 0; i < 4; ++i) { const int idx = i * 512 + tid, row = idx >> 5, ch = idx & 31; rq[S_][i] = *(const u32x4*)(qb + ro_ + (size_t)row * RIN + ch * 8); rk[S_][i] = *(const u32x4*)(kb + ro_ + (size_t)row * RIN + ch * 8); } \
            if (tid < 256) rv[S_] = *(const u32x4*)(vb + ro_ + (size_t)vrow * RIN + vch * 8); \
            rp[S_] = *(const u32x4*)(pb + (size_t)(cc_) * 64 * 512); } while (0)
        rv[0] = (u32x4){0u, 0u, 0u, 0u}; rv[1] = rv[0];
        RET_LOAD(0, 0); RET_LOAD(1, 1);
        for (int c0 = 0; c0 < 128; c0 += 2) {
#pragma unroll
          for (int par = 0; par < 2; ++par) {
            const int c = c0 + par;
            LAS unsigned char* Stc = St0 + par * 16896; LAS unsigned char* Stn = St0 + (par ^ 1) * 16896;
#pragma unroll
            for (int i = 0; i < 4; ++i) { const int idx = i * 512 + tid, row = idx >> 5, ch = idx & 31; *(LAS u32x4*)(Qs + row * QS + ch * 16) = rq[par][i]; *(LAS u32x4*)(Ks + row * QS + ch * 16) = rk[par][i]; }
            if (tid < 256) {
                const u32x4 rvv = rv[par];
                *(LAS u32x4*)(Vs + vrow * VS + vch * 16) = rvv;
                u32x4 z; z.x = pk2(bflo(rvv.x) * zeta, bfhi(rvv.x) * zeta); z.y = pk2(bflo(rvv.y) * zeta, bfhi(rvv.y) * zeta);
                z.z = pk2(bflo(rvv.z) * zeta, bfhi(rvv.z) * zeta); z.w = pk2(bflo(rvv.w) * zeta, bfhi(rvv.w) * zeta);
                *(LAS u32x4*)(Vz + vrow * VS + vch * 16) = z;
            }
            *(LAS u32x4*)(Ps + prow * PS + pch * 16) = rp[par];
            LDS_BARRIER();
            if (c + 2 < 128) RET_LOAD(par, c + 2);
            f32x4 aX0 = {0.f, 0.f, 0.f, 0.f}, aX1 = {0.f, 0.f, 0.f, 0.f}, aI = {0.f, 0.f, 0.f, 0.f};
#pragma unroll
            for (int ks = 0; ks < 8; ks += 2) {
                const bf16x8 a0 = *(const LAS bf16x8*)(Qs + (lm * 16 + fr) * QS + ks * 64 + fq * 16);
                const bf16x8 s0 = *(const LAS bf16x8*)(Stc + (c2 * 16 + fr) * QS + ks * 64 + fq * 16);
                const bf16x8 a1 = *(const LAS bf16x8*)(Qs + (lm * 16 + fr) * QS + (ks + 1) * 64 + fq * 16);
                const bf16x8 s1 = *(const LAS bf16x8*)(Stc + (c2 * 16 + fr) * QS + (ks + 1) * 64 + fq * 16);
                aX0 = __builtin_amdgcn_mfma_f32_16x16x32_bf16(a0, s0, aX0, 0, 0, 0);
                aX1 = __builtin_amdgcn_mfma_f32_16x16x32_bf16(a1, s1, aX1, 0, 0, 0);
            }
#pragma unroll
            for (int ks = 0; ks < 2; ++ks) {
                const bf16x8 a = *(const LAS bf16x8*)(Ps + (lm * 16 + fr) * PS + ks * 64 + fq * 16);
                const bf16x8 bv = tr_frag(Vs, VS, ks * 32, c2 * 16, lane);
                aI = __builtin_amdgcn_mfma_f32_16x16x32_bf16(a, bv, aI, 0, 0, 0);
            }
            {
                bf16_t* ob = vb + (size_t)(c * 64) * RIN + c2 * 16 + fr;
#pragma unroll
                for (int j = 0; j < 4; ++j) { const int l = lm * 16 + fq * 4 + j; ob[(size_t)l * RIN] = (bf16_t)f2bf(aI[j] + (aX0[j] + aX1[j]) * xi[j]); }
            }
#pragma unroll
            for (int a = 0; a < 2; ++a)
#pragma unroll
                for (int cc = 0; cc < 2; ++cc) accS[a][cc] *= cdecay;
#pragma unroll
            for (int ks = 0; ks < 2; ++ks) {
                const bf16x8 ad0 = tr_frag(Ks, QS, ks * 32, (wid * 2 + 0) * 16, lane);
                const bf16x8 ad1 = tr_frag(Ks, QS, ks * 32, (wid * 2 + 1) * 16, lane);
                const bf16x8 bv0 = tr_frag(Vz, VS, ks * 32, 0, lane);
                const bf16x8 bv1 = tr_frag(Vz, VS, ks * 32, 16, lane);
                accS[0][0] = __builtin_amdgcn_mfma_f32_16x16x32_bf16(ad0, bv0, accS[0][0], 0, 0, 0);
                accS[0][1] = __builtin_amdgcn_mfma_f32_16x16x32_bf16(ad0, bv1, accS[0][1], 0, 0, 0);
                accS[1][0] = __builtin_amdgcn_mfma_f32_16x16x32_bf16(ad1, bv0, accS[1][0], 0, 0, 0);
                accS[1][1] = __builtin_amdgcn_mfma_f32_16x16x32_bf16(ad1, bv1, accS[1][1], 0, 0, 0);
            }
#pragma unroll
            for (int a = 0; a < 2; ++a)
#pragma unroll
                for (int cc = 0; cc < 2; ++cc) {
                    u32x2 w; w.x = pk2(accS[a][cc][0], accS[a][cc][1]); w.y = pk2(accS[a][cc][2], accS[a][cc][3]);
                    *(LAS u32x2*)(Stn + (cc * 16 + fr) * QS + ((wid * 2 + a) * 16 + fq * 4) * 2) = w;
                }
            LDS_BARRIER();
          }
        }
#undef RET_LOAD
    }
}

__device__ __forceinline__ void ret_gn(bf16_t* proj, const float* gnw, int wg, int G) {
    const int tid_ = otid(); const int wave = tid_ >> 6, lane = tid_ & 63;
    constexpr int NP = 4;
    for (int pair0 = (wg * 8 + wave) * NP; pair0 < T * 8; pair0 += G * 8 * NP) {
        u32x4 ov[NP], gv[NP];
#pragma unroll
        for (int q = 0; q < NP; ++q) { const int pair = pair0 + q, t = pair >> 3, h = pair & 7;
            const bf16_t* op = proj + (size_t)t * RIN + 4096 + h * 512 + lane * 8; ov[q] = *(const u32x4*)op; gv[q] = *(const u32x4*)(op + 4096); }
#pragma unroll
        for (int q = 0; q < NP; ++q) { const int pair = pair0 + q, t = pair >> 3, h = pair & 7;
            bf16_t* gp = proj + (size_t)t * RIN + 8192 + h * 512 + lane * 8;
            float o[8] = {bflo(ov[q].x), bfhi(ov[q].x), bflo(ov[q].y), bfhi(ov[q].y), bflo(ov[q].z), bfhi(ov[q].z), bflo(ov[q].w), bfhi(ov[q].w)};
            float g[8] = {bflo(gv[q].x), bfhi(gv[q].x), bflo(gv[q].y), bfhi(gv[q].y), bflo(gv[q].z), bfhi(gv[q].z), bflo(gv[q].w), bfhi(gv[q].w)};
            float s = 0.f;
#pragma unroll
            for (int e = 0; e < 8; ++e) s += o[e];
            const float mu = wave_sum(s) * (1.0f / 512.0f);
            float qq = 0.f;
#pragma unroll
            for (int e = 0; e < 8; ++e) { o[e] -= mu; qq += o[e] * o[e]; }
            const float rstd = rsqrtf(wave_sum(qq) * (1.0f / 512.0f) + 1e-5f);
            const f32x4 w0 = *(const f32x4*)(gnw + h * 512 + lane * 8), w1 = *(const f32x4*)(gnw + h * 512 + lane * 8 + 4);
            float y[8];
#pragma unroll
            for (int e = 0; e < 8; ++e) y[e] = silu(g[e]) * (o[e] * rstd) * (e < 4 ? w0[e & 3] : w1[e & 3]);
            u32x4 w; w.x = pk2(y[0], y[1]); w.y = pk2(y[2], y[3]); w.z = pk2(y[4], y[5]); w.w = pk2(y[6], y[7]);
            *(u32x4*)gp = w; }
    }
}

__device__ __forceinline__ void ssd_dt(const bf16_t* U, const bf16_t* Wdt, const float* dt_bias, const float* a_log, float* dtv, float* acv, LAS unsigned char* lds, int wg, int G) {
    const int tid = otid(), lane = tid & 63, wid = __builtin_amdgcn_readfirstlane(tid >> 6), fr = lane & 15, fq = lane >> 4;
    constexpr int QS = 528;
    LAS unsigned char* As = lds; LAS unsigned char* Bs = lds + 33792;
    LAS float* dtl = (LAS float*)(lds + 67584);
    const int lm = wid >> 1, c2 = wid & 1;
    for (int ck = wg; ck < 256; ck += G) {
        const bf16_t* ab = U + (size_t)(ck * 64) * DM;
        u32x4 ra[4], rb[4];
#define DT_LOAD(sl_) do { _Pragma("unroll") for (int i = 0; i < 4; ++i) { const int idx = i * 512 + tid, row = idx >> 5, ch = idx & 31; \
            ra[i] = *(const u32x4*)(ab + (size_t)row * DM + (sl_) * 256 + ch * 8); rb[i] = *(const u32x4*)(Wdt + (size_t)row * DM + (sl_) * 256 + ch * 8); } } while (0)
        DT_LOAD(0);
        f32x4 a0 = {0.f, 0.f, 0.f, 0.f}, a1 = {0.f, 0.f, 0.f, 0.f};
        for (int sl = 0; sl < 8; ++sl) {
#pragma unroll
            for (int i = 0; i < 4; ++i) { const int idx = i * 512 + tid, row = idx >> 5, ch = idx & 31; *(LAS u32x4*)(As + row * QS + ch * 16) = ra[i]; *(LAS u32x4*)(Bs + row * QS + ch * 16) = rb[i]; }
            LDS_BARRIER();
            if (sl + 1 < 8) DT_LOAD(sl + 1);
#pragma unroll
            for (int ks = 0; ks < 8; ++ks) {
                const bf16x8 a = *(const LAS bf16x8*)(As + (lm * 16 + fr) * QS + ks * 64 + fq * 16);
                const bf16x8 b0 = *(const LAS bf16x8*)(Bs + ((c2 * 2 + 0) * 16 + fr) * QS + ks * 64 + fq * 16);
                const bf16x8 b1 = *(const LAS bf16x8*)(Bs + ((c2 * 2 + 1) * 16 + fr) * QS + ks * 64 + fq * 16);
                a0 = __builtin_amdgcn_mfma_f32_16x16x32_bf16(a, b0, a0, 0, 0, 0);
                a1 = __builtin_amdgcn_mfma_f32_16x16x32_bf16(a, b1, a1, 0, 0, 0);
            }
            LDS_BARRIER();
        }
#undef DT_LOAD
        {
            const int h0 = (c2 * 2 + 0) * 16 + fr, h1 = h0 + 16;
            const float b0 = dt_bias[h0], b1 = dt_bias[h1];
            f32x4 d0, d1;
#pragma unroll
            for (int j = 0; j < 4; ++j) { const float x0 = a0[j] + b0, x1 = a1[j] + b1; d0[j] = x0 > 20.f ? x0 : log1pf(expf(x0)); d1[j] = x1 > 20.f ? x1 : log1pf(expf(x1)); }
            *(LAS f32x4*)(dtl + h0 * 64 + lm * 16 + fq * 4) = d0;
            *(LAS f32x4*)(dtl + h1 * 64 + lm * 16 + fq * 4) = d1;
        }
        LDS_BARRIER();
#pragma unroll
        for (int hh = 0; hh < 8; ++hh) {
            const int hd = wid * 8 + hh;
            const float dt = dtl[hd * 64 + lane];
            float sa = dt * (-expf(a_log[hd]));
#pragma unroll
            for (int o = 1; o < 64; o <<= 1) { const float tt = __shfl_up(sa, o); if (lane >= o) sa += tt; }
            dtv[((size_t)ck * 64 + hd) * 64 + lane] = dt; acv[((size_t)ck * 64 + hd) * 64 + lane] = sa;
        }
        LDS_BARRIER();
    }
}

__device__ __forceinline__ void ssd_cb(bf16_t* proj, const bf16_t* halo, const float* cw, const float* cbias, bf16_t* CBg, LAS unsigned char* lds, int wg, int G) {
    const int tid = otid(), lane = tid & 63, wid = __builtin_amdgcn_readfirstlane(tid >> 6), fr = lane & 15, fq = lane >> 4;
    constexpr int CS = 272;
    LAS unsigned char* Cs = lds; LAS unsigned char* Bs = lds + 17408; LAS unsigned char* RB = lds + 34816; LAS unsigned char* RC = lds + 53248;
    LAS float* Wl = (LAS float*)(lds + 71680);
    const int lm = wid >> 1, c2 = wid & 1;
    u32x4 rc[2], rb[2], rh; f32x4 rw;
    const int hm = tid / 48, hr = (tid % 48) >> 4, hch = tid & 15;
#define CB_LOAD(u_) do { const int g_ = (u_) & 7, bc_ = (u_) >> 3; const bf16_t* bb_ = proj + (size_t)(bc_ * 64) * SINP + 8192 + g_ * 128; \
        _Pragma("unroll") for (int i = 0; i < 2; ++i) { const int idx = i * 512 + tid, row = idx >> 4, ch = idx & 15; rb[i] = *(const u32x4*)(bb_ + (size_t)row * SINP + ch * 8); rc[i] = *(const u32x4*)(bb_ + 1024 + (size_t)row * SINP + ch * 8); } \
        rh = (u32x4){0u, 0u, 0u, 0u}; \
        if (tid < 96 && (bc_ & 127) != 0) rh = *(const u32x4*)(halo + ((size_t)(bc_ - 1) * 3 + hr) * 6144 + 4096 + hm * 1024 + g_ * 128 + hch * 8); \
        if (tid < 320) { const int m_ = tid / 160, q_ = tid % 160, tp_ = q_ >> 5, c4_ = q_ & 31; const int col_ = 4096 + m_ * 1024 + g_ * 128 + c4_ * 4; \
            rw = tp_ < 4 ? *(const f32x4*)(cw + tp_ * 6144 + col_) : *(const f32x4*)(cbias + col_); } } while (0)
    int u = wg;
    if (u < 2048) CB_LOAD(u);
    for (; u < 2048; u += G) {
        const int g = u & 7, t0 = (u >> 3) * 64;
#pragma unroll
        for (int i = 0; i < 2; ++i) { const int idx = i * 512 + tid, row = idx >> 4, ch = idx & 15; *(LAS u32x4*)(RC + (row + 3) * CS + ch * 16) = rc[i]; *(LAS u32x4*)(RB + (row + 3) * CS + ch * 16) = rb[i]; }
        if (tid < 96) *(LAS u32x4*)((hm ? RC : RB) + hr * CS + hch * 16) = rh;
        if (tid < 320) { const int m_ = tid / 160, q_ = tid % 160; *(LAS f32x4*)(Wl + m_ * 640 + (q_ >> 5) * 128 + (q_ & 31) * 4) = rw; }
        LDS_BARRIER();
        const int un = u + G;
        if (un < 2048) CB_LOAD(un);
#pragma unroll
        for (int mtx = 0; mtx < 2; ++mtx) {
            LAS unsigned char* R = mtx ? RC : RB; LAS unsigned char* O = mtx ? Cs : Bs;
            const LAS float* wl = Wl + mtx * 640;
#pragma unroll
            for (int i = 0; i < 2; ++i) {
                const int idx = i * 512 + tid, row = idx >> 4, ch = idx & 15;
                float acc8[8];
                { const f32x4 b0 = *(const LAS f32x4*)(wl + 512 + ch * 8), b1 = *(const LAS f32x4*)(wl + 512 + ch * 8 + 4);
#pragma unroll
                  for (int e = 0; e < 4; ++e) { acc8[e] = b0[e]; acc8[4 + e] = b1[e]; } }
#pragma unroll
                for (int tp = 0; tp < 4; ++tp) {
                    const u32x4 xv = *(const LAS u32x4*)(R + (row + tp) * CS + ch * 16);
                    const f32x4 w0 = *(const LAS f32x4*)(wl + tp * 128 + ch * 8), w1 = *(const LAS f32x4*)(wl + tp * 128 + ch * 8 + 4);
                    acc8[0] += w0[0] * bflo(xv.x); acc8[1] += w0[1] * bfhi(xv.x); acc8[2] += w0[2] * bflo(xv.y); acc8[3] += w0[3] * bfhi(xv.y);
                    acc8[4] += w1[0] * bflo(xv.z); acc8[5] += w1[1] * bfhi(xv.z); acc8[6] += w1[2] * bflo(xv.w); acc8[7] += w1[3] * bfhi(xv.w);
                }
                u32x4 o; o.x = pk2(silu(acc8[0]), silu(acc8[1])); o.y = pk2(silu(acc8[2]), silu(acc8[3])); o.z = pk2(silu(acc8[4]), silu(acc8[5])); o.w = pk2(silu(acc8[6]), silu(acc8[7]));
                *(LAS u32x4*)(O + row * CS + ch * 16) = o;
                *(u32x4*)(proj + (size_t)(t0 + row) * SINP + 8192 + mtx * 1024 + g * 128 + ch * 8) = o;
            }
        }
        LDS_BARRIER();
        f32x4 aW0 = {0.f, 0.f, 0.f, 0.f}, aW1 = {0.f, 0.f, 0.f, 0.f};
#pragma unroll
        for (int ks = 0; ks < 4; ++ks) {
            const bf16x8 a = *(const LAS bf16x8*)(Cs + (lm * 16 + fr) * CS + ks * 64 + fq * 16);
            const bf16x8 b0 = *(const LAS bf16x8*)(Bs + ((c2 * 2 + 0) * 16 + fr) * CS + ks * 64 + fq * 16);
            const bf16x8 b1 = *(const LAS bf16x8*)(Bs + ((c2 * 2 + 1) * 16 + fr) * CS + ks * 64 + fq * 16);
            aW0 = __builtin_amdgcn_mfma_f32_16x16x32_bf16(a, b0, aW0, 0, 0, 0);
            aW1 = __builtin_amdgcn_mfma_f32_16x16x32_bf16(a, b1, aW1, 0, 0, 0);
        }
#pragma unroll
        for (int j = 0; j < 4; ++j) { const int l = lm * 16 + fq * 4 + j;
            bf16_t* pp = CBg + ((size_t)(t0 + l) * 8 + g) * 64 + (c2 * 2) * 16 + fr;
            pp[0] = (bf16_t)f2bf(aW0[j]); pp[16] = (bf16_t)f2bf(aW1[j]); }
        LDS_BARRIER();
    }
#undef CB_LOAD
}

__device__ __forceinline__ void ssd_scan(bf16_t* proj, const bf16_t* halo, const float* cw, const float* cbias, const bf16_t* CBg, const float* dtv, const float* acv, const float* d_skip, LAS unsigned char* lds, int wg, int G) {
    const int tid = otid(), lane = tid & 63, wid = __builtin_amdgcn_readfirstlane(tid >> 6), fr = lane & 15, fq = lane >> 4;
    constexpr int CS = 272, XS = 80, WS = 144;
    LAS unsigned char* Cs = lds; LAS unsigned char* Bs = lds + 17408; LAS unsigned char* Xs = lds + 34816; LAS unsigned char* Xw = lds + 39936; LAS unsigned char* Zs = lds + 45056;
    LAS unsigned char* Ws = lds + 50176; LAS unsigned char* Sts0 = lds + 59392; LAS float* acum = (LAS float*)(lds + 76800);
    LAS float* Wx = (LAS float*)(lds + 77056);
    const int lm = wid >> 1, c2 = wid & 1;
    for (int unit = wg; unit < 256; unit += G) {
        const int grp = unit & 7, ii = unit >> 3, b = ii >> 4, hd = grp * 8 + ((ii & 15) >> 1), ph = ii & 1;
        const float dsk = d_skip[hd];
        f32x4 accT[2];
        accT[0] = (f32x4){0.f, 0.f, 0.f, 0.f}; accT[1] = (f32x4){0.f, 0.f, 0.f, 0.f};
        for (int i = tid; i < 8704 / 4; i += NTHREADS) ((LAS unsigned*)Sts0)[i] = 0u;
        const bf16_t* base = proj + (size_t)(b * SEQ) * SINP;
        const bf16_t* bb = base + 8192 + grp * 128;
        const bf16_t* cbp = base + 9216 + grp * 128;
        bf16_t* xb = (bf16_t*)base + 4096 + hd * 64 + ph * 32;
        const bf16_t* zb = base + hd * 64 + ph * 32;
        const int xrow = (tid & 255) >> 2, xch = tid & 3;
        const int wrow = tid >> 3, ws0 = (tid & 7) * 8;
        if (tid < 40) { const int tp = tid >> 3, c4 = tid & 7; const int col = hd * 64 + ph * 32 + c4 * 4; *(LAS f32x4*)(Wx + tp * 32 + c4 * 4) = tp < 4 ? *(const f32x4*)(cw + tp * 6144 + col) : *(const f32x4*)(cbias + col); }
        const bf16_t* hxb = halo + (size_t)(b * 128) * 3 * 6144 + hd * 64 + ph * 32 + xch * 8;
        const bf16_t* cgp = CBg + ((size_t)(b * SEQ + wrow) * 8 + grp) * 64 + ws0;
        const float* dtp = dtv + ((size_t)(b * 128) * 64 + hd) * 64;
        const float* acp = acv + ((size_t)(b * 128) * 64 + hd) * 64;
        u32x4 rc[2][2], rb[2][2], rxz[2], rcb[2], rxh[2][3]; f32x4 rds[2][2], ras[2][2]; float ral[2], rax[2], rdx[2], rat[2], ra0[2] = {0.f, 0.f};
#define SSD_PREFETCH(S_, cc_) do { const size_t ro_ = (size_t)(cc_) * 64 * SINP; \
            _Pragma("unroll") for (int i = 0; i < 2; ++i) { const int idx = i * 512 + tid, row = idx >> 4, ch = idx & 15; rc[S_][i] = *(const u32x4*)(cbp + ro_ + (size_t)row * SINP + ch * 8); rb[S_][i] = *(const u32x4*)(bb + ro_ + (size_t)row * SINP + ch * 8); } \
            rxz[S_] = *(const u32x4*)((tid < 256 ? (const bf16_t*)xb : zb) + ro_ + (size_t)xrow * SINP + xch * 8); \
            if (tid < 256) { _Pragma("unroll") for (int k_ = 1; k_ <= 3; ++k_) { const int r_ = xrow - k_; \
                rxh[S_][k_ - 1] = r_ >= 0 ? *(const u32x4*)(xb + ro_ + (size_t)r_ * SINP + xch * 8) : ((cc_) > 0 ? *(const u32x4*)(hxb + ((size_t)((cc_) - 1) * 3 + (3 + r_)) * 6144) : (u32x4){0u, 0u, 0u, 0u}); } } \
            rcb[S_] = *(const u32x4*)(cgp + (size_t)(cc_) * 64 * 512); \
            const float* d_ = dtp + (size_t)(cc_) * 4096; const float* a_ = acp + (size_t)(cc_) * 4096; \
            rds[S_][0] = *(const f32x4*)(d_ + ws0); rds[S_][1] = *(const f32x4*)(d_ + ws0 + 4); ras[S_][0] = *(const f32x4*)(a_ + ws0); ras[S_][1] = *(const f32x4*)(a_ + ws0 + 4); \
            ral[S_] = a_[wrow]; rax[S_] = a_[xrow]; rdx[S_] = d_[xrow]; rat[S_] = a_[63]; if (tid < 64) ra0[S_] = a_[tid]; } while (0)
        LDS_BARRIER();
        SSD_PREFETCH(0, 0);
        for (int c0 = 0; c0 < 128; c0 += 2) {
#pragma unroll
          for (int par = 0; par < 2; ++par) {
            const int c = c0 + par;
            LAS unsigned char* Stc = Sts0 + par * 8704; LAS unsigned char* Stn = Sts0 + (par ^ 1) * 8704;
#pragma unroll
            for (int i = 0; i < 2; ++i) { const int idx = i * 512 + tid, row = idx >> 4, ch = idx & 15; *(LAS u32x4*)(Cs + row * CS + ch * 16) = rc[0][i]; *(LAS u32x4*)(Bs + row * CS + ch * 16) = rb[0][i]; }
            if (tid >= 256) *(LAS u32x4*)(Zs + xrow * XS + xch * 16) = rxz[0];
            else {
                float xc[8];
                { const f32x4 b0 = *(const LAS f32x4*)(Wx + 128 + xch * 8), b1 = *(const LAS f32x4*)(Wx + 128 + xch * 8 + 4);
#pragma unroll
                  for (int e = 0; e < 4; ++e) { xc[e] = b0[e]; xc[4 + e] = b1[e]; } }
#pragma unroll
                for (int tp = 0; tp < 4; ++tp) {
                    const u32x4 xv = tp == 3 ? rxz[0] : rxh[0][2 - tp];
                    const f32x4 w0 = *(const LAS f32x4*)(Wx + tp * 32 + xch * 8), w1 = *(const LAS f32x4*)(Wx + tp * 32 + xch * 8 + 4);
                    xc[0] += w0[0] * bflo(xv.x); xc[1] += w0[1] * bfhi(xv.x); xc[2] += w0[2] * bflo(xv.y); xc[3] += w0[3] * bfhi(xv.y);
                    xc[4] += w1[0] * bflo(xv.z); xc[5] += w1[1] * bfhi(xv.z); xc[6] += w1[2] * bflo(xv.w); xc[7] += w1[3] * bfhi(xv.w);
                }
#pragma unroll
                for (int e = 0; e < 8; ++e) xc[e] = silu(xc[e]);
                u32x4 xo; xo.x = pk2(xc[0], xc[1]); xo.y = pk2(xc[2], xc[3]); xo.z = pk2(xc[4], xc[5]); xo.w = pk2(xc[6], xc[7]);
                *(LAS u32x4*)(Xs + xrow * XS + xch * 16) = xo;
                const float f = rdx[0] * __expf(rat[0] - rax[0]);
                u32x4 z; z.x = pk2(bflo(xo.x) * f, bfhi(xo.x) * f); z.y = pk2(bflo(xo.y) * f, bfhi(xo.y) * f); z.z = pk2(bflo(xo.z) * f, bfhi(xo.z) * f); z.w = pk2(bflo(xo.w) * f, bfhi(xo.w) * f);
                *(LAS u32x4*)(Xw + xrow * XS + xch * 16) = z;
            }
            {
                const u32x4 rcv = rcb[0];
                const float cv[8] = {bflo(rcv.x), bfhi(rcv.x), bflo(rcv.y), bfhi(rcv.y), bflo(rcv.z), bfhi(rcv.z), bflo(rcv.w), bfhi(rcv.w)};
                float wv[8];
#pragma unroll
                for (int e = 0; e < 8; ++e) { const float as = e < 4 ? ras[0][0][e & 3] : ras[0][1][e & 3], ds = e < 4 ? rds[0][0][e & 3] : rds[0][1][e & 3];
                    wv[e] = (wrow >= ws0 + e) ? cv[e] * __expf(ral[0] - as) * ds : 0.f; }
                u32x4 w; w.x = pk2(wv[0], wv[1]); w.y = pk2(wv[2], wv[3]); w.z = pk2(wv[4], wv[5]); w.w = pk2(wv[6], wv[7]);
                *(LAS u32x4*)(Ws + wrow * WS + ws0 * 2) = w;
            }
            if (tid < 64) acum[tid] = ra0[0];
            LDS_BARRIER();
            if (c + 1 < 128) SSD_PREFETCH(0, c + 1);
            const float atot = acum[63];
            float al[4];
#pragma unroll
            for (int j = 0; j < 4; ++j) al[j] = acum[lm * 16 + fq * 4 + j];
            f32x4 aY0 = {0.f, 0.f, 0.f, 0.f}, aY1 = {0.f, 0.f, 0.f, 0.f}, aD = {0.f, 0.f, 0.f, 0.f};
#pragma unroll
            for (int ks = 0; ks < 4; ks += 2) {
                const bf16x8 a0 = *(const LAS bf16x8*)(Cs + (lm * 16 + fr) * CS + ks * 64 + fq * 16);
                const bf16x8 s0 = *(const LAS bf16x8*)(Stc + (c2 * 16 + fr) * CS + ks * 64 + fq * 16);
                const bf16x8 a1 = *(const LAS bf16x8*)(Cs + (lm * 16 + fr) * CS + (ks + 1) * 64 + fq * 16);
                const bf16x8 s1 = *(const LAS bf16x8*)(Stc + (c2 * 16 + fr) * CS + (ks + 1) * 64 + fq * 16);
                aY0 = __builtin_amdgcn_mfma_f32_16x16x32_bf16(a0, s0, aY0, 0, 0, 0);
                aY1 = __builtin_amdgcn_mfma_f32_16x16x32_bf16(a1, s1, aY1, 0, 0, 0);
            }
#pragma unroll
            for (int ks = 0; ks < 2; ++ks) {
                const bf16x8 a = *(const LAS bf16x8*)(Ws + (lm * 16 + fr) * WS + ks * 64 + fq * 16);
                const bf16x8 bx = tr_frag(Xs, XS, ks * 32, c2 * 16, lane);
                aD = __builtin_amdgcn_mfma_f32_16x16x32_bf16(a, bx, aD, 0, 0, 0);
            }
            {
                const int pc = c2 * 16 + fr;
                bf16_t* ob = xb + (size_t)(c * 64) * SINP + pc;
#pragma unroll
                for (int j = 0; j < 4; ++j) { const int l = lm * 16 + fq * 4 + j;
                    const float xv = bf2f(*(const LAS bf16_t*)(Xs + l * XS + pc * 2)), zv = bf2f(*(const LAS bf16_t*)(Zs + l * XS + pc * 2));
                    const float y = aD[j] + (aY0[j] + aY1[j]) * __expf(al[j]) + dsk * xv;
                    ob[(size_t)l * SINP] = (bf16_t)f2bf(y * silu(zv)); }
            }
            const float sdec = __expf(atot);
            accT[0] *= sdec; accT[1] *= sdec;
#pragma unroll
            for (int ks = 0; ks < 2; ++ks) {
                const bf16x8 an_ = tr_frag(Bs, CS, ks * 32, wid * 16, lane);
                const bf16x8 bp0 = tr_frag(Xw, XS, ks * 32, 0, lane);
                const bf16x8 bp1 = tr_frag(Xw, XS, ks * 32, 16, lane);
                accT[0] = __builtin_amdgcn_mfma_f32_16x16x32_bf16(an_, bp0, accT[0], 0, 0, 0);
                accT[1] = __builtin_amdgcn_mfma_f32_16x16x32_bf16(an_, bp1, accT[1], 0, 0, 0);
            }
#pragma unroll
            for (int pi = 0; pi < 2; ++pi) {
                u32x2 w; w.x = pk2(accT[pi][0], accT[pi][1]); w.y = pk2(accT[pi][2], accT[pi][3]);
                *(LAS u32x2*)(Stn + (pi * 16 + fr) * CS + (wid * 16 + fq * 4) * 2) = w;
            }
            LDS_BARRIER();
          }
        }
#undef SSD_PREFETCH
    }
}

__device__ __forceinline__ void ssd_norm(bf16_t* proj, const float* nw, int wg, int G) {
    const int tid_ = otid(); const int wave = tid_ >> 6, lane = tid_ & 63;
    constexpr int NP = 4;
    for (int pair0 = (wg * 8 + wave) * NP; pair0 < T * 8; pair0 += G * 8 * NP) {
        u32x4 yv[NP];
#pragma unroll
        for (int q = 0; q < NP; ++q) { const int pair = pair0 + q, t = pair >> 3, gr = pair & 7; yv[q] = *(const u32x4*)(proj + (size_t)t * SINP + 4096 + gr * 512 + lane * 8); }
#pragma unroll
        for (int q = 0; q < NP; ++q) { const int pair = pair0 + q, t = pair >> 3, gr = pair & 7;
            bf16_t* yp = proj + (size_t)t * SINP + 4096 + gr * 512 + lane * 8;
            float y[8] = {bflo(yv[q].x), bfhi(yv[q].x), bflo(yv[q].y), bfhi(yv[q].y), bflo(yv[q].z), bfhi(yv[q].z), bflo(yv[q].w), bfhi(yv[q].w)};
            float qq = 0.f;
#pragma unroll
            for (int e = 0; e < 8; ++e) qq += y[e] * y[e];
            const float r = rsqrtf(wave_sum(qq) * (1.0f / 512.0f) + 1e-6f);
            const f32x4 w0 = *(const f32x4*)(nw + gr * 512 + lane * 8), w1 = *(const f32x4*)(nw + gr * 512 + lane * 8 + 4);
            u32x4 w; w.x = pk2(y[0] * r * w0[0], y[1] * r * w0[1]); w.y = pk2(y[2] * r * w0[2], y[3] * r * w0[3]);
            w.z = pk2(y[4] * r * w1[0], y[5] * r * w1[1]); w.w = pk2(y[6] * r * w1[2], y[7] * r * w1[3]);
            *(u32x4*)yp = w; }
    }
}

#define XB_TMO      128
#define XB_XCNT(j)  (256  + 64 * (j))
#define XB_XSUB(j)  (1280 + 64 * (j))
#define XB_XGEN(j)  (2304 + 64 * (j))
#define XB_TOP      3328
#define XB_TOPGEN   3392
#define XCD_BAR_WORDS 3456
#define XB_SPIN_CAP (1u << 18)
__device__ __forceinline__ unsigned xb_ld(unsigned* p)              { return __hip_atomic_load(p, __ATOMIC_RELAXED, __HIP_MEMORY_SCOPE_AGENT); }
__device__ __forceinline__ unsigned xb_add(unsigned* p, unsigned v) { return __hip_atomic_fetch_add(p, v, __ATOMIC_RELAXED, __HIP_MEMORY_SCOPE_AGENT); }
__device__ __forceinline__ unsigned xb_xcc_id() { return (unsigned)__builtin_amdgcn_s_getreg((3 << 11) | 20) & 0xFu; }
#define XB_SPIN(cond, bar) do { unsigned _sp = 0; while (cond) { __builtin_amdgcn_s_sleep(1); \
    if ((++_sp & 255u) == 0u) { if (xb_ld(&(bar)[XB_TMO])) break; if (_sp > XB_SPIN_CAP) { atomicAdd(&(bar)[XB_TMO], 1u); break; } } } } while (0)
struct XcdBarrier { unsigned* bar; unsigned x; volatile LAS unsigned* st; };
__device__ __forceinline__ XcdBarrier xcd_barrier_post(unsigned* bar, volatile LAS unsigned* st) {
    XcdBarrier b; b.bar = bar; b.x = xb_xcc_id(); b.st = st;
    if (threadIdx.x == 0) (void)xb_add(&bar[XB_XCNT(b.x)], 1u);
    return b;
}
__device__ __forceinline__ void xcd_barrier_complete(unsigned* bar, unsigned x, unsigned& nloc, unsigned& nx) {
    const unsigned G = gridDim.x * gridDim.y * gridDim.z;
    unsigned sum, cnt, mine, sp = 0u;
    for (;;) {
        sum = 0u; cnt = 0u; mine = 0u;
#pragma unroll
        for (unsigned j = 0; j < 16; ++j) { const unsigned c = xb_ld(&bar[XB_XCNT(j)]); sum += c; cnt += (c > 0u) ? 1u : 0u; mine = (j == x) ? c : mine; }
        if (sum == G) break;
        __builtin_amdgcn_s_sleep(1);
        if ((++sp & 255u) == 0u) { if (xb_ld(&bar[XB_TMO])) break; if (sp > XB_SPIN_CAP) { atomicAdd(&bar[XB_TMO], 1u); break; } }
    }
    nloc = mine > 0u ? mine : 1u; nx = cnt > 0u ? cnt : 1u;
}
__device__ __forceinline__ void xcd_barrier(const XcdBarrier& b) {
    asm volatile("s_waitcnt vmcnt(0)" ::: "memory");
    __syncthreads();
    if (threadIdx.x == 0) {
        unsigned* bar = b.bar;
        __builtin_amdgcn_s_waitcnt(0);
        unsigned nloc = b.st[0], nx = b.st[1];
        if (nloc == 0u) { xcd_barrier_complete(bar, b.x, nloc, nx); b.st[0] = nloc; b.st[1] = nx; }
        const unsigned old = xb_add(&bar[XB_XSUB(b.x)], 1u);
        const unsigned gen = old / nloc;
        if (old + 1u == (gen + 1u) * nloc) {
            __builtin_amdgcn_fence(__ATOMIC_RELEASE, "agent");
            asm volatile("s_waitcnt vmcnt(0)" ::: "memory");
            const unsigned og = xb_add(&bar[XB_TOP], 1u);
            const unsigned tg = og / nx;
            if (og + 1u == (tg + 1u) * nx) xb_add(&bar[XB_TOPGEN], 1u);
            else XB_SPIN(xb_ld(&bar[XB_TOPGEN]) == tg, bar);
            __builtin_amdgcn_fence(__ATOMIC_ACQUIRE, "agent");
            xb_add(&bar[XB_XGEN(b.x)], 1u);
            asm volatile("s_waitcnt vmcnt(0)" ::: "memory");
        } else {
            XB_SPIN(xb_ld(&bar[XB_XGEN(b.x)]) == gen, bar);
            __builtin_amdgcn_fence(__ATOMIC_ACQUIRE, "agent");
            asm volatile("s_waitcnt vmcnt(0)" ::: "memory");
        }
    }
    __syncthreads();
}

struct Params {
    const float* x; const float* nmp; const float* nmq; const float* nfp; const float* nfq;
    const float* ret_w_in; const float* ret_gn_w; const float* ret_w_out;
    const float* ssd_w_in; const float* conv_w; const float* conv_b; const float* dt_bias; const float* a_log; const float* d_skip; const float* ssd_norm_w; const float* ssd_w_out;
    const float* w_up; const float* w_down;
    float* out; unsigned char* ws;
};


__global__ void __launch_bounds__(NTHREADS, 2) mega(Params p) {
    extern __shared__ __attribute__((aligned(16))) unsigned char lds_raw[];
    LAS unsigned char* lds = (LAS unsigned char*)lds_raw;
    cg::grid_group grid = cg::this_grid();
    const int G = gridDim.x, wg = blockIdx.x;
    bf16_t* WA = (bf16_t*)(p.ws + OFF_WA); bf16_t* WB = (bf16_t*)(p.ws + OFF_WB);
    bf16_t* ACT = (bf16_t*)(p.ws + OFF_ACT); bf16_t* U_ACT = (bf16_t*)(p.ws + OFF_ACT + HID_BYTES); bf16_t* F_ACT = (bf16_t*)(p.ws + OFF_ACT + HID_BYTES);
    bf16_t* U_R2 = (bf16_t*)(p.ws + OFF_R2); bf16_t* MF_R2 = (bf16_t*)(p.ws + OFF_R2);
    float* ROT = (float*)(p.ws + OFF_ROT); bf16_t* HALO = (bf16_t*)(p.ws + OFF_HALO); float* DTV = (float*)(p.ws + OFF_DTV); float* ACV = (float*)(p.ws + OFF_ACV); bf16_t* CBG = (bf16_t*)(p.ws + OFF_CBG); bf16_t* PG = (bf16_t*)p.out; bf16_t* HB1 = (bf16_t*)p.out; bf16_t* HB2 = (bf16_t*)(p.ws + OFF_ACT + HID_BYTES + 67108864);

#define GEMM(KIND, ...) do { const pg8::Gemm gd = pg8::Gemm{__VA_ARGS__}; pg8::StaticOrder S; S.init(gd.M, gd.N, G, wg); pg8::gemm_phase<KIND>(lds, gd, S); GSYNC(); } while (0)
    unsigned* barw = (unsigned*)(p.ws + OFF_BAR);
    volatile LAS unsigned* bst = (volatile LAS unsigned*)(lds + LDS_STAGE);
    if (threadIdx.x < 2) bst[threadIdx.x] = 0u;
    if (p.ws == nullptr) grid.sync();
    const XcdBarrier xb = xcd_barrier_post(barw, bst);
#define GSYNC() xcd_barrier(xb)
    norm_pass(NormDesc{0, p.x, nullptr, nullptr, nullptr, p.nmp, U_R2, 0, 0}, wg, G);
    convert_w(ConvDesc{p.ret_w_in, WA, 2048, RIN, RIN, 1}, lds, wg, G);
    convert_w(ConvDesc{p.ret_w_out, WB, 4096, 2048, 2048, 0}, lds, wg, G);
    rot_table(ROT, wg, G);
    GSYNC();
    GEMM(3, U_R2, WA, T, RIN, 2048, 2048, 3, ACT, RIN, ROT);
    ret_pre(ACT, PG, lds, wg, G); GSYNC();
    ret_scan(ACT, PG, lds, wg, G); GSYNC();
    ret_gn(ACT, p.ret_gn_w, wg, G); GSYNC();
    GEMM(1, ACT + 8192, WB, T, 2048, 4096, RIN, 1, MF_R2, 2048, nullptr);
    norm_pass(NormDesc{1, MF_R2, p.x, HB1, p.nmq, p.nfp, U_ACT, 0, 1}, wg, G);
    convert_w(ConvDesc{p.w_up, WA, 2048, DFF, DFF, 0}, lds, wg, G);
    convert_w(ConvDesc{p.w_down, WB, DFF, 2048, 2048, 0}, lds, wg, G);
    GSYNC();
    GEMM(2, U_ACT, WA, T, DFF, 2048, 2048, 2, ACT, DFF, nullptr);
    GEMM(1, ACT, WB, T, 2048, DFF, DFF, 1, F_ACT, 2048, nullptr);
    norm_pass(NormDesc{1, F_ACT, HB1, HB1, p.nfq, p.nmp + DM, U_R2, 1, 1}, wg, G);
    convert_w(ConvDesc{p.ssd_w_in, WA, 2048, SIN, SINW, 0}, lds, wg, G);
    convert_w(ConvDesc{p.ssd_w_out, WB, 4096, 2048, 2048, 0}, lds, wg, G);
    GSYNC();
    GEMM(5, U_R2, WA, T, SING, 2048, 2048, 5, ACT, SINP, (const float*)HALO);
    ssd_dt(U_R2, WA + (size_t)SING * 2048, p.dt_bias, p.a_log, DTV, ACV, lds, wg, G);
    ssd_cb(ACT, HALO, p.conv_w, p.conv_b, CBG, lds, wg, G); GSYNC();
    ssd_scan(ACT, HALO, p.conv_w, p.conv_b, CBG, DTV, ACV, p.d_skip, lds, wg, G); GSYNC();
    ssd_norm(ACT, p.ssd_norm_w, wg, G); GSYNC();
    GEMM(1, ACT + 4096, WB, T, 2048, 4096, SINP, 1, MF_R2, 2048, nullptr);
    norm_pass(NormDesc{1, MF_R2, HB1, HB2, p.nmq + DM, p.nfp + DM, U_ACT, 1, 1}, wg, G);
    convert_w(ConvDesc{p.w_up + (size_t)2048 * DFF, WA, 2048, DFF, DFF, 0}, lds, wg, G);
    convert_w(ConvDesc{p.w_down + (size_t)DFF * 2048, WB, DFF, 2048, 2048, 0}, lds, wg, G);
    GSYNC();
    GEMM(2, U_ACT, WA, T, DFF, 2048, 2048, 2, ACT, DFF, nullptr);
    GEMM(1, ACT, WB, T, 2048, DFF, DFF, 1, F_ACT, 2048, nullptr);
    norm_pass(NormDesc{2, F_ACT, HB2, p.out, p.nfq + DM, nullptr, nullptr, 1, 0}, wg, G);
#undef GEMM
#undef GSYNC
}

extern "C" void kernel_launch(void* const* d_in, const int* in_sizes, int n_in, void* d_out, int out_size, void* d_ws, size_t ws_size, hipStream_t stream) {
    static int grid_blocks = 0;
    if (!grid_blocks) {
        int dev = 0, cus = 0, per_cu = 0;
        hipGetDevice(&dev);
        hipDeviceGetAttribute(&cus, hipDeviceAttributeMultiprocessorCount, dev);
        hipFuncSetAttribute((const void*)mega, hipFuncAttributeMaxDynamicSharedMemorySize, LDS_BYTES);
        hipOccupancyMaxActiveBlocksPerMultiprocessor(&per_cu, (const void*)mega, NTHREADS, LDS_BYTES);
        if (per_cu < 1) per_cu = 1;
        grid_blocks = cus * per_cu;
        if (ws_size < WS_END) { fprintf(stderr, "kernel_launch: workspace too small: %zu < %zu\n", ws_size, (size_t)WS_END); grid_blocks = -1; }
    }
    if (grid_blocks < 0) return;
    Params p{};
    p.x = (const float*)d_in[0]; p.nmp = (const float*)d_in[1]; p.nmq = (const float*)d_in[2]; p.nfp = (const float*)d_in[3]; p.nfq = (const float*)d_in[4];
    p.ret_w_in = (const float*)d_in[5]; p.ret_gn_w = (const float*)d_in[6]; p.ret_w_out = (const float*)d_in[7];
    p.ssd_w_in = (const float*)d_in[8]; p.conv_w = (const float*)d_in[9]; p.conv_b = (const float*)d_in[10]; p.dt_bias = (const float*)d_in[11];
    p.a_log = (const float*)d_in[12]; p.d_skip = (const float*)d_in[13]; p.ssd_norm_w = (const float*)d_in[14]; p.ssd_w_out = (const float*)d_in[15];
    p.w_up = (const float*)d_in[16]; p.w_down = (const float*)d_in[17];
    p.out = (float*)d_out; p.ws = (unsigned char*)d_ws;
    void* args[] = {&p};
    (void)hipMemsetAsync((char*)d_ws + OFF_BAR, 0, XCD_BAR_WORDS * sizeof(unsigned), stream);
    hipError_t e = hipLaunchCooperativeKernel((const void*)mega, dim3(grid_blocks), dim3(NTHREADS), args, LDS_BYTES, stream);
    if (e != hipSuccess) fprintf(stderr, "cooperative launch failed: %s (grid %d)\n", hipGetErrorString(e), grid_blocks);
}
```

```cpp
#include <hip/hip_runtime.h>
#include <hip/hip_cooperative_groups.h>
#include <cstdio>
namespace cg = cooperative_groups;

#define LAS __attribute__((address_space(3)))
typedef unsigned short bf16_t;
typedef short bf16x8 __attribute__((ext_vector_type(8)));
typedef short s16x4 __attribute__((ext_vector_type(4)));
typedef float f32x4 __attribute__((ext_vector_type(4)));
typedef float f32x2 __attribute__((ext_vector_type(2)));
typedef unsigned u32x4 __attribute__((ext_vector_type(4)));
typedef unsigned u32x2 __attribute__((ext_vector_type(2)));

constexpr int T = 16384, DM = 2048, SEQ = 8192;
constexpr int RIN = 12288;
constexpr int SIN = 10304, SINP = 10496, SINW = 10368, SING = 10240;
constexpr int DFF = 8192;
constexpr int NTHREADS = 512;
constexpr int LDS_STAGE = 131072;
constexpr int LDS_BYTES = LDS_STAGE + 16;

constexpr size_t OFF_WA = 0;
constexpr size_t OFF_WB = 50331648;
constexpr size_t OFF_ACT = OFF_WB + 33554432;
constexpr size_t ACT_BYTES = 402653184;
constexpr size_t HID_BYTES = 268435456;
constexpr size_t OFF_R2 = OFF_ACT + ACT_BYTES;
constexpr size_t R2_BYTES = 134217728;
constexpr size_t OFF_ROT = OFF_R2 + 67108864;
constexpr size_t OFF_HALO = OFF_R2 + 67108864;
constexpr size_t OFF_DTV = OFF_R2 + 67108864 + 16777216;
constexpr size_t OFF_ACV = OFF_DTV + 4194304;
constexpr size_t OFF_CBG = OFF_R2 + 109051904;
constexpr size_t OFF_BAR = OFF_R2 + 100663296;
constexpr size_t WS_END = OFF_R2 + R2_BYTES;

typedef __bf16 bf16x2v __attribute__((ext_vector_type(2)));
__device__ __forceinline__ unsigned cvt_pk_bf16(float lo, float hi) { const f32x2 v = {lo, hi}; const bf16x2v b = __builtin_convertvector(v, bf16x2v); return __builtin_bit_cast(unsigned, b); }
__device__ __forceinline__ unsigned pk2(float lo, float hi) { return cvt_pk_bf16(lo, hi); }
__device__ __forceinline__ unsigned f2bf(float f) { return (unsigned)__builtin_bit_cast(unsigned short, (__bf16)f); }
__device__ __forceinline__ float bflo(unsigned w) { return __uint_as_float(w << 16); }
__device__ __forceinline__ float bfhi(unsigned w) { return __uint_as_float(w & 0xffff0000u); }
__device__ __forceinline__ float bf2f(bf16_t b) { return __uint_as_float(((unsigned)b) << 16); }
__device__ __forceinline__ float wave_sum(float v) {
#pragma unroll
    for (int o = 32; o >= 1; o >>= 1) v += __shfl_xor(v, o);
    return v;
}
__device__ __forceinline__ int otid() { int t = threadIdx.x; asm volatile("" : "+v"(t)); return t; }
#define LDS_BARRIER() do { asm volatile("s_waitcnt lgkmcnt(0)" ::: "memory"); __builtin_amdgcn_s_barrier(); asm volatile("" ::: "memory"); } while (0)
__device__ __forceinline__ float silu(float x) { return x * __builtin_amdgcn_rcpf(1.0f + __expf(-x)); }

__device__ __forceinline__ bf16x8 tr_frag(LAS unsigned char* img, int rs, int kbase, int n0, int lane) {
    const int g = lane >> 4, q = (lane & 15) >> 2, p = lane & 3;
    LAS unsigned char* a0 = img + (kbase + 8 * g + q) * rs + (n0 + 4 * p) * 2;
    s16x4 a = __builtin_amdgcn_ds_read_tr16_b64_v4i16((LAS s16x4*)a0);
    s16x4 b = __builtin_amdgcn_ds_read_tr16_b64_v4i16((LAS s16x4*)(a0 + 4 * rs));
    bf16x8 r = {a[0], a[1], a[2], a[3], b[0], b[1], b[2], b[3]};
    return r;
}

namespace pg8 {
constexpr int BM = 256, BK = 64, HALF = 128, HTB = HALF * BK * 2, STAGE_BYTES = 8 * HTB, NXCD = 8, WGM = 8;
__device__ __forceinline__ int lds_byte(int r, int c) { const int st = (r >> 4) * 2 + (c >> 5), rr = r & 15, cc = c & 31, ob = rr * 64 + cc * 2; return st * 1024 + (ob ^ (((ob >> 9) & 1) << 5)); }
__device__ __forceinline__ void stage_rc(int b, int& R, int& C) { const int st = b / 1024, sb = b % 1024, swz = sb ^ (((sb >> 9) & 1) << 5); R = (st >> 1) * 16 + swz / 64; C = (st & 1) * 32 + (swz % 64) / 2; }
__device__ __forceinline__ int perm32(int rho) { const int n = rho >> 4, i = rho & 15; return 8 * (i >> 2) + 4 * n + (i & 3); }
struct Unit { int pm, pn; };
struct Gemm { const bf16_t* A; const bf16_t* Bt; int M, N, K, lda; int kind; void* out; int ldc; const float* rot; };
struct StaticOrder {
    int nM, nN, nwg, G, c;
    __device__ void init(int M, int N, int G_, int c_) { nM = M / BM; nN = N / BM; nwg = nM * nN; G = G_; c = c_; }
    __device__ bool next(int i, Unit& u) const {
        const long L = (long)i * G + c; if (L >= nwg) return false;
        int wgid = (int)L; { const int q = nwg / NXCD, r = nwg % NXCD, xcd = wgid % NXCD, off = wgid / NXCD; wgid = (xcd < r ? xcd * (q + 1) : r * (q + 1) + (xcd - r) * q) + off; }
        const int nig = WGM * nN, gid = wgid / nig, fm = gid * WGM, gsz = (nM - fm) < WGM ? (nM - fm) : WGM;
        u.pm = fm + ((wgid % nig) % gsz); u.pn = (wgid % nig) / gsz; return true;
    }
};

template <int KIND> __device__ __forceinline__ void epilogue(const Gemm& g, const f32x4 (&acc)[2][2][4][2], const Unit& u, int wr, int wc, int fr, int fq) {
    if constexpr (KIND == 0) {
        float* C = (float*)g.out; const int ldc = g.ldc;
        const int row0 = u.pm * BM + wr * 64 + fr, col0 = u.pn * BM + wc * 32 + 4 * fq;
#pragma unroll
        for (int ai = 0; ai < 2; ++ai)
#pragma unroll
            for (int m = 0; m < 4; ++m) { float* rowp = C + (size_t)(row0 + ai * HALF + m * 16) * ldc + col0;
#pragma unroll
                for (int bj = 0; bj < 2; ++bj)
#pragma unroll
                    for (int n = 0; n < 2; ++n) *(f32x4*)(rowp + bj * HALF + n * 16) = acc[ai][bj][m][n]; }
    } else {
        bf16_t* O = (bf16_t*)g.out; const int ldc = g.ldc;
        const int row0 = u.pm * BM + wr * 64 + fr, col0 = u.pn * BM + wc * 32 + 8 * fq;
        const bool isrot = (KIND == 3) && (u.pn < 16);
        const float sc = (u.pn >= 8) ? 0.0625f : 1.0f;
        constexpr bool relu2 = (KIND == 2);
#pragma unroll
        for (int ai = 0; ai < 2; ++ai)
#pragma unroll
            for (int m = 0; m < 4; ++m) {
                const int row = row0 + ai * HALF + m * 16;
                bf16_t* rowp = O + (size_t)row * ldc + col0;
                const int pos = row & (SEQ - 1);
#pragma unroll
                for (int bj = 0; bj < 2; ++bj) {
                    f32x4 v0 = acc[ai][bj][m][0], v1 = acc[ai][bj][m][1];
                    if (relu2) {
#pragma unroll
                        for (int j = 0; j < 4; ++j) { const float a = fmaxf(v0[j], 0.f), b = fmaxf(v1[j], 0.f); v0[j] = a * a; v1[j] = b * b; }
                    }
                    if (isrot) {
                        const float* rp = g.rot + ((size_t)pos * 128 + 64 * bj + 16 * wc + 4 * fq) * 2;
                        const f32x4 c0 = *(const f32x4*)rp, c1 = *(const f32x4*)(rp + 4);
                        f32x4 r0, r1;
                        r0[0] = v0[0] * c0[0] - v0[1] * c0[1]; r0[1] = v0[0] * c0[1] + v0[1] * c0[0];
                        r0[2] = v0[2] * c0[2] - v0[3] * c0[3]; r0[3] = v0[2] * c0[3] + v0[3] * c0[2];
                        r1[0] = v1[0] * c1[0] - v1[1] * c1[1]; r1[1] = v1[0] * c1[1] + v1[1] * c1[0];
                        r1[2] = v1[2] * c1[2] - v1[3] * c1[3]; r1[3] = v1[2] * c1[3] + v1[3] * c1[2];
                        v0 = r0 * sc; v1 = r1 * sc;
                    }
                    u32x4 w; w.x = cvt_pk_bf16(v0[0], v0[1]); w.y = cvt_pk_bf16(v0[2], v0[3]); w.z = cvt_pk_bf16(v1[0], v1[1]); w.w = cvt_pk_bf16(v1[2], v1[3]);
                    *(u32x4*)(rowp + bj * HALF) = w;
                    if constexpr (KIND == 5) {
                        if (m == 3 && fr >= 13 && u.pn >= 16) *(u32x4*)((bf16_t*)g.rot + ((size_t)(row >> 6) * 3 + (fr - 13)) * 6144 + (col0 - 4096) + bj * HALF) = w;
                    }
                }
            }
    }
}

template <int KIND> __device__ __forceinline__ void gemm_phase(LAS unsigned char* lds, const Gemm g, const StaticOrder& S) {
    const int tid = otid(), wid = __builtin_amdgcn_readfirstlane(tid >> 6), lane = tid & 63, wr = wid >> 2, wc = wid & 3, fr = lane & 15, fq = lane >> 4;
    const int K = g.K, nt = K / BK, lda = g.lda;
    constexpr bool perm = KIND != 0;
    unsigned voffA[2], voffB[2];
#pragma unroll
    for (int i = 0; i < 2; ++i) { int R, C; stage_rc(tid * 16 + i * 8192, R, C); const int Rb = perm ? ((R & ~31) + perm32(R & 31)) : R;
        voffA[i] = (unsigned)(R * lda + C) * 2u; voffB[i] = (unsigned)(Rb * K + C) * 2u; }
    const size_t kstep = (size_t)(BK * 2);
    const size_t hstepA = (size_t)HALF * lda * 2, hstepB = (size_t)HALF * K * 2;
    const size_t tstepA = 2 * hstepA, tstepB = 2 * hstepB;
    const unsigned ldsw = (unsigned)wid * 1024u;
    const int aoff = lds_byte(wr * 64 + fr, fq * 8), boff = lds_byte(wc * 32 + fr, fq * 8);
#define PG8_SA(b, h) (((b) * 2 + (h)) * HTB)
#define PG8_SB(b, h) ((4 + (b) * 2 + (h)) * HTB)
#define PG8_STAGE(bufoff, gbase, voff) do { _Pragma("unroll") for (int _i = 0; _i < 2; ++_i) \
        __builtin_amdgcn_global_load_lds((const unsigned*)((const char*)(gbase) + (voff)[_i]), (LAS unsigned*)(lds + (bufoff) + ldsw + _i * 8192), 16, 0, 0); } while (0)
#define PG8_LDA(dst, b, h) do { _Pragma("unroll") for (int m = 0; m < 4; ++m) _Pragma("unroll") for (int k = 0; k < 2; ++k) dst[m][k] = *(const LAS bf16x8*)(lds + PG8_SA(b, h) + aoff + m * 2048 + k * 1024); } while (0)
#define PG8_LDB(dst, b, h) do { _Pragma("unroll") for (int n = 0; n < 2; ++n) _Pragma("unroll") for (int k = 0; k < 2; ++k) dst[n][k] = *(const LAS bf16x8*)(lds + PG8_SB(b, h) + boff + n * 2048 + k * 1024); } while (0)
#define PG8_MMA(ai, bj, At, Bt) do { __builtin_amdgcn_s_setprio(1); _Pragma("unroll") for (int m = 0; m < 4; ++m) _Pragma("unroll") for (int n = 0; n < 2; ++n) _Pragma("unroll") for (int k = 0; k < 2; ++k) \
        acc[ai][bj][m][n] = __builtin_amdgcn_mfma_f32_16x16x32_bf16(Bt[n][k], At[m][k], acc[ai][bj][m][n], 0, 0, 0); __builtin_amdgcn_s_setprio(0); } while (0)
#define PG8_WAIT_V(n) asm volatile("s_waitcnt vmcnt(" #n ")" ::: "memory")
#define PG8_WAIT_L(n) asm volatile("s_waitcnt lgkmcnt(" #n ")" ::: "memory")
#define PG8_BAR __builtin_amdgcn_s_barrier()
#define PG8_SCHED __builtin_amdgcn_sched_barrier(0)
    Unit cur, nxt; int ui = 0;
    if (!S.next(0, cur)) return;
    f32x4 acc[2][2][4][2];
#pragma unroll
    for (int a = 0; a < 2; ++a)
#pragma unroll
        for (int b = 0; b < 2; ++b)
#pragma unroll
            for (int m = 0; m < 4; ++m)
#pragma unroll
                for (int n = 0; n < 2; ++n) acc[a][b][m][n] = (f32x4){0.f, 0.f, 0.f, 0.f};
    bf16x8 At[4][2], B0[2][2], B1[2][2];
    const char* cA = (const char*)g.A + (size_t)cur.pm * tstepA; const char* cB = (const char*)g.Bt + (size_t)cur.pn * tstepB;
    PG8_STAGE(PG8_SB(0, 0), cB, voffB); PG8_STAGE(PG8_SA(0, 0), cA, voffA); PG8_STAGE(PG8_SB(0, 1), cB + hstepB, voffB); PG8_STAGE(PG8_SA(0, 1), cA + hstepA, voffA);
    if (wr == 1) PG8_BAR;
    PG8_WAIT_V(4); PG8_BAR;
    PG8_STAGE(PG8_SB(1, 0), cB + kstep, voffB); PG8_STAGE(PG8_SA(1, 0), cA + kstep, voffA); PG8_STAGE(PG8_SB(1, 1), cB + hstepB + kstep, voffB);
    PG8_WAIT_V(6); PG8_BAR;
    for (;;) {
        const bool has_next = S.next(ui + 1, nxt);
        const char* nA = has_next ? (const char*)g.A + (size_t)nxt.pm * tstepA : cA; const char* nB = has_next ? (const char*)g.Bt + (size_t)nxt.pn * tstepB : cB;
        for (int t = 0; t < nt; t += 2) {
            const bool last = (t == nt - 2);
            const char* a1 = cA + (size_t)(t + 1) * kstep;
            const char* a2 = last ? nA : cA + (size_t)(t + 2) * kstep; const char* b2 = last ? nB : cB + (size_t)(t + 2) * kstep;
            const char* a3 = a2 + kstep; const char* b3 = b2 + kstep;
            PG8_LDB(B0, 0, 0); PG8_SCHED; PG8_LDA(At, 0, 0); PG8_STAGE(PG8_SA(1, 1), a1 + hstepA, voffA);
            PG8_WAIT_L(8); PG8_BAR; PG8_WAIT_L(0); PG8_MMA(0, 0, At, B0); PG8_BAR; PG8_SCHED;
            PG8_LDB(B1, 0, 1); PG8_STAGE(PG8_SB(0, 0), b2, voffB);
            PG8_BAR; PG8_WAIT_L(0); PG8_MMA(0, 1, At, B1); PG8_BAR;
            PG8_LDA(At, 0, 1); PG8_STAGE(PG8_SA(0, 0), a2, voffA);
            PG8_BAR; PG8_WAIT_L(0); PG8_MMA(1, 0, At, B0); PG8_BAR; PG8_SCHED;
            PG8_STAGE(PG8_SB(0, 1), b2 + hstepB, voffB);
            PG8_WAIT_V(6); PG8_BAR; PG8_MMA(1, 1, At, B1); PG8_BAR;
            PG8_LDB(B0, 1, 0); PG8_SCHED; PG8_LDA(At, 1, 0); PG8_STAGE(PG8_SA(0, 1), a2 + hstepA, voffA);
            PG8_WAIT_L(8); PG8_BAR; PG8_WAIT_L(0); PG8_MMA(0, 0, At, B0); PG8_BAR; PG8_SCHED;
            PG8_LDB(B1, 1, 1); PG8_STAGE(PG8_SB(1, 0), b3, voffB);
            PG8_BAR; PG8_WAIT_L(0); PG8_MMA(0, 1, At, B1); PG8_BAR;
            PG8_LDA(At, 1, 1); PG8_STAGE(PG8_SA(1, 0), a3, voffA);
            PG8_BAR; PG8_WAIT_L(0); PG8_MMA(1, 0, At, B0); PG8_BAR; PG8_SCHED;
            PG8_STAGE(PG8_SB(1, 1), b3 + hstepB, voffB);
            PG8_WAIT_V(6); PG8_BAR; PG8_MMA(1, 1, At, B1); PG8_BAR;
        }
        epilogue<KIND>(g, acc, cur, wr, wc, fr, fq);
        if (!has_next) break;
#pragma unroll
        for (int a = 0; a < 2; ++a)
#pragma unroll
            for (int b = 0; b < 2; ++b)
#pragma unroll
                for (int m = 0; m < 4; ++m)
#pragma unroll
                    for (int n = 0; n < 2; ++n) acc[a][b][m][n] = (f32x4){0.f, 0.f, 0.f, 0.f};
        cur = nxt; cA = nA; cB = nB; ++ui;
    }
    PG8_WAIT_V(0);
    if (wr == 0) PG8_BAR;
    PG8_BAR;
#undef PG8_SA
#undef PG8_SB
#undef PG8_STAGE
#undef PG8_LDA
#undef PG8_LDB
#undef PG8_MMA
#undef PG8_WAIT_V
#undef PG8_WAIT_L
#undef PG8_BAR
#undef PG8_SCHED
}
}

struct ConvDesc { const float* src; bf16_t* dst; int K, Nsrc, Ndst, permq; };
__device__ __forceinline__ void convert_w(const ConvDesc& c, LAS unsigned char* lds, int wg, int G) {
    const int tid = otid();
    constexpr int RS = 144;
    const int nnt = c.Ndst / 128, ntile = (c.K / 64) * nnt;
    const int c4 = tid & 31, kq = tid >> 5;
    f32x4 r[4];
#define CW_LOAD(u_) do { const int nt_ = (u_) % nnt, kt_ = (u_) / nnt; const int col_ = nt_ * 128 + c4 * 4; \
        const float* sp_ = c.src + (size_t)(kt_ * 64 + kq * 4) * c.Nsrc + col_; const bool ok_ = col_ < c.Nsrc; \
        _Pragma("unroll") for (int i_ = 0; i_ < 4; ++i_) r[i_] = ok_ ? __builtin_nontemporal_load((const f32x4*)(sp_ + (size_t)i_ * c.Nsrc)) : (f32x4){0.f, 0.f, 0.f, 0.f};     } while (0)
    int u = wg;
    if (u < ntile) CW_LOAD(u);
    while (u < ntile) {
#pragma unroll
        for (int e = 0; e < 4; ++e) { u32x2 w; w.x = pk2(r[0][e], r[1][e]); w.y = pk2(r[2][e], r[3][e]); *(LAS u32x2*)(lds + (c4 * 4 + e) * RS + kq * 8) = w; }
        const int un = u + G;
        if (un < ntile) CW_LOAD(un);
        LDS_BARRIER();
        {
            const int nt = u % nnt, kt = u / nnt, n0 = nt * 128;
            const bool pm = c.permq && n0 < 4096;
#pragma unroll
            for (int i = 0; i < 2; ++i) { const int idx = i * 512 + tid, row = idx >> 3, kb = idx & 7;
                const u32x4 v = *(const LAS u32x4*)(lds + row * RS + kb * 16);
                const int drow = pm ? ((n0 & ~255) + 2 * row + ((n0 >> 7) & 1)) : (n0 + row);
                *(u32x4*)(c.dst + (size_t)drow * c.K + kt * 64 + kb * 8) = v; }
        }
        LDS_BARRIER();
        u = un;
    }
#undef CW_LOAD
}

struct NormDesc { int mode; const void* m; const void* hres; void* hout; const float* wpost; const float* wpre; bf16_t* ub; int hin_bf16, hout_bf16; };
__device__ __forceinline__ void norm_pass(const NormDesc& d, int wg, int G) {
    const int tid_ = otid(); const int wave = tid_ >> 6, lane = tid_ & 63;
    constexpr int NR = 2;
    for (int row0 = (wg * 8 + wave) * NR; row0 < T; row0 += G * 8 * NR) {
        float v[NR][4][8]; float ss[NR], r[NR], r2[NR];
#pragma unroll
        for (int q = 0; q < NR; ++q) {
            const size_t ro = (size_t)(row0 + q) * DM;
            if (d.mode == 0) {
#pragma unroll
                for (int i = 0; i < 4; ++i) { const int c = (i * 64 + lane) * 8; const f32x4 a = *(const f32x4*)((const float*)d.m + ro + c), b = *(const f32x4*)((const float*)d.m + ro + c + 4);
#pragma unroll
                    for (int e = 0; e < 4; ++e) { v[q][i][e] = a[e]; v[q][i][4 + e] = b[e]; } }
            } else {
#pragma unroll
                for (int i = 0; i < 4; ++i) { const int c = (i * 64 + lane) * 8; const u32x4 a = *(const u32x4*)((const bf16_t*)d.m + ro + c);
                    v[q][i][0] = bflo(a.x); v[q][i][1] = bfhi(a.x); v[q][i][2] = bflo(a.y); v[q][i][3] = bfhi(a.y); v[q][i][4] = bflo(a.z); v[q][i][5] = bfhi(a.z); v[q][i][6] = bflo(a.w); v[q][i][7] = bfhi(a.w); }
            }
        }
#pragma unroll
        for (int q = 0; q < NR; ++q) {
            float s = 0.f;
#pragma unroll
            for (int i = 0; i < 4; ++i)
#pragma unroll
                for (int e = 0; e < 8; ++e) s += v[q][i][e] * v[q][i][e];
            ss[q] = s;
        }
#pragma unroll
        for (int q = 0; q < NR; ++q) { ss[q] = wave_sum(ss[q]); r[q] = rsqrtf(ss[q] * (1.0f / DM) + 1e-6f); r2[q] = r[q]; }
        if (d.mode != 0) {
            float s2[NR];
#pragma unroll
            for (int q = 0; q < NR; ++q) {
                const size_t ro = (size_t)(row0 + q) * DM;
                float s = 0.f;
#pragma unroll
                for (int i = 0; i < 4; ++i) { const int c = (i * 64 + lane) * 8;
                    const f32x4 w0 = *(const f32x4*)(d.wpost + c), w1 = *(const f32x4*)(d.wpost + c + 4);
                    f32x4 h0, h1;
                    if (d.hin_bf16) { const u32x4 hv = *(const u32x4*)((const bf16_t*)d.hres + ro + c); h0[0] = bflo(hv.x); h0[1] = bfhi(hv.x); h0[2] = bflo(hv.y); h0[3] = bfhi(hv.y); h1[0] = bflo(hv.z); h1[1] = bfhi(hv.z); h1[2] = bflo(hv.w); h1[3] = bfhi(hv.w); }
                    else { h0 = *(const f32x4*)((const float*)d.hres + ro + c); h1 = *(const f32x4*)((const float*)d.hres + ro + c + 4); }
                    f32x4 o0, o1;
#pragma unroll
                    for (int e = 0; e < 4; ++e) { o0[e] = h0[e] + v[q][i][e] * r[q] * w0[e]; o1[e] = h1[e] + v[q][i][4 + e] * r[q] * w1[e]; v[q][i][e] = o0[e]; v[q][i][4 + e] = o1[e]; s += o0[e] * o0[e] + o1[e] * o1[e]; }
                    if (d.hout_bf16) { u32x4 hw; hw.x = pk2(o0[0], o0[1]); hw.y = pk2(o0[2], o0[3]); hw.z = pk2(o1[0], o1[1]); hw.w = pk2(o1[2], o1[3]); *(u32x4*)((bf16_t*)d.hout + ro + c) = hw; }
                    else { *(f32x4*)((float*)d.hout + ro + c) = o0; *(f32x4*)((float*)d.hout + ro + c + 4) = o1; } }
                s2[q] = s;
            }
            if (d.mode == 1) {
#pragma unroll
                for (int q = 0; q < NR; ++q) { s2[q] = wave_sum(s2[q]); r2[q] = rsqrtf(s2[q] * (1.0f / DM) + 1e-6f); }
            }
        }
        if (d.mode != 2) {
#pragma unroll
            for (int q = 0; q < NR; ++q) {
                const size_t ro = (size_t)(row0 + q) * DM;
#pragma unroll
                for (int i = 0; i < 4; ++i) { const int c = (i * 64 + lane) * 8;
                    const f32x4 w0 = *(const f32x4*)(d.wpre + c), w1 = *(const f32x4*)(d.wpre + c + 4);
                    u32x4 o; o.x = pk2(v[q][i][0] * r2[q] * w0[0], v[q][i][1] * r2[q] * w0[1]); o.y = pk2(v[q][i][2] * r2[q] * w0[2], v[q][i][3] * r2[q] * w0[3]);
                    o.z = pk2(v[q][i][4] * r2[q] * w1[0], v[q][i][5] * r2[q] * w1[1]); o.w = pk2(v[q][i][6] * r2[q] * w1[2], v[q][i][7] * r2[q] * w1[3]);
                    *(u32x4*)(d.ub + ro + c) = o; }
            }
        }
    }
}

__device__ __forceinline__ void rot_table(float* rot, int wg, int G) {
    for (int e = wg * NTHREADS + otid(); e < SEQ * 128; e += G * NTHREADS) {
        const int pos = e >> 7, jf = e & 127;
        const float inv = exp2f(-(float)jf * (13.287712379549449f / 128.0f));
        const float ang = (float)pos * inv;
        const double a = (double)ang; const double k = rint(a * 0.15915494309189535); const float rf = (float)(a - k * 6.283185307179586);
        f32x2 cs; cs.x = cosf(rf); cs.y = sinf(rf);
        *(f32x2*)(rot + 2 * (size_t)e) = cs;
    }
}

__device__ __forceinline__ void ret_pre(const bf16_t* proj, bf16_t* Pg, LAS unsigned char* lds, int wg, int G) {
    const int tid = otid(), lane = tid & 63, wid = __builtin_amdgcn_readfirstlane(tid >> 6), fr = lane & 15, fq = lane >> 4;
    constexpr int QS = 528;
    LAS unsigned char* Qs = lds; LAS unsigned char* Ks = lds + 33792;
    const int lm = wid >> 1, c2 = wid & 1;
    u32x4 rq[4], rk[4];
    int u = wg;
    if (u < 2048) {
        const bf16_t* qb = proj + (size_t)((u >> 3) * 64) * RIN + (u & 7) * 256;
#pragma unroll
        for (int i = 0; i < 4; ++i) { const int idx = i * 512 + tid, row = idx >> 5, ch = idx & 31; rq[i] = *(const u32x4*)(qb + (size_t)row * RIN + ch * 8); rk[i] = *(const u32x4*)(qb + 2048 + (size_t)row * RIN + ch * 8); }
    }
    for (; u < 2048; u += G) {
        const int h = u & 7, t0 = (u >> 3) * 64;
#pragma unroll
        for (int i = 0; i < 4; ++i) { const int idx = i * 512 + tid, row = idx >> 5, ch = idx & 31; *(LAS u32x4*)(Qs + row * QS + ch * 16) = rq[i]; *(LAS u32x4*)(Ks + row * QS + ch * 16) = rk[i]; }
        LDS_BARRIER();
        const int un = u + G;
        if (un < 2048) {
            const bf16_t* qb = proj + (size_t)((un >> 3) * 64) * RIN + (un & 7) * 256;
#pragma unroll
            for (int i = 0; i < 4; ++i) { const int idx = i * 512 + tid, row = idx >> 5, ch = idx & 31; rq[i] = *(const u32x4*)(qb + (size_t)row * RIN + ch * 8); rk[i] = *(const u32x4*)(qb + 2048 + (size_t)row * RIN + ch * 8); }
        }
        const float lg = log1pf(-exp2f(-5.0f - (float)h));
        f32x4 aP0 = {0.f, 0.f, 0.f, 0.f}, aP1 = {0.f, 0.f, 0.f, 0.f};
#pragma unroll
        for (int ks = 0; ks < 8; ++ks) {
            const bf16x8 a = *(const LAS bf16x8*)(Qs + (lm * 16 + fr) * QS + ks * 64 + fq * 16);
            const bf16x8 b0 = *(const LAS bf16x8*)(Ks + ((c2 * 2 + 0) * 16 + fr) * QS + ks * 64 + fq * 16);
            const bf16x8 b1 = *(const LAS bf16x8*)(Ks + ((c2 * 2 + 1) * 16 + fr) * QS + ks * 64 + fq * 16);
            aP0 = __builtin_amdgcn_mfma_f32_16x16x32_bf16(a, b0, aP0, 0, 0, 0);
            aP1 = __builtin_amdgcn_mfma_f32_16x16x32_bf16(a, b1, aP1, 0, 0, 0);
        }
#pragma unroll
        for (int j = 0; j < 4; ++j) { const int l = lm * 16 + fq * 4 + j;
            const int m0 = (c2 * 2 + 0) * 16 + fr, m1 = m0 + 16;
            const int d0 = l > m0 ? l - m0 : m0 - l, d1 = l > m1 ? l - m1 : m1 - l;
            bf16_t* pp = Pg + ((size_t)(t0 + l) * 8 + h) * 64;
            pp[m0] = (bf16_t)f2bf(aP0[j] * expf((float)d0 * lg));
            pp[m1] = (bf16_t)f2bf(aP1[j] * expf((float)d1 * lg)); }
        LDS_BARRIER();
    }
}

__device__ __forceinline__ void ret_scan(bf16_t* proj, const bf16_t* Pg, LAS unsigned char* lds, int wg, int G) {
    const int tid = otid(), lane = tid & 63, wid = __builtin_amdgcn_readfirstlane(tid >> 6), fr = lane & 15, fq = lane >> 4;
    constexpr int QS = 528, VS = 80, PS = 144;
    LAS unsigned char* Qs = lds; LAS unsigned char* Ks = lds + 33792; LAS unsigned char* Vs = lds + 67584; LAS unsigned char* Vz = lds + 72704;
    LAS unsigned char* Ps = lds + 77824; LAS unsigned char* St0 = lds + 87040;
    const int lm = wid >> 1, c2 = wid & 1;
    for (int unit = wg; unit < 256; unit += G) {
        const int xc = unit & 7, ii = unit >> 3, bh = xc * 2 + (ii >> 4), vs = ii & 15, b = bh >> 3, h = bh & 7;
        const float lg = log1pf(-exp2f(-5.0f - (float)h));
        float xi[4];
#pragma unroll
        for (int j = 0; j < 4; ++j) { const int l = lm * 16 + fq * 4 + j; xi[j] = expf((float)(l + 1) * lg); }
        const float cdecay = expf(64.0f * lg);
        const int vrow = (tid & 255) >> 2, vch = tid & 3;
        const float zeta = expf((float)(63 - vrow) * lg);
        const int prow = tid >> 3, pch = tid & 7;
        f32x4 accS[2][2];
#pragma unroll
        for (int a = 0; a < 2; ++a)
#pragma unroll
            for (int c = 0; c < 2; ++c) accS[a][c] = (f32x4){0.f, 0.f, 0.f, 0.f};
        for (int i = tid; i < 16896 / 4; i += NTHREADS) ((LAS unsigned*)St0)[i] = 0u;
        const bf16_t* qb = proj + (size_t)(b * SEQ) * RIN + h * 256;
        const bf16_t* kb = qb + 2048;
        bf16_t* vb = proj + (size_t)(b * SEQ) * RIN + 4096 + h * 512 + vs * 32;
        const bf16_t* pb = Pg + ((size_t)(b * SEQ + prow) * 8 + h) * 64 + pch * 8;
        u32x4 rq[2][4], rk[2][4], rv[2], rp[2];
#define RET_LOAD(S_, cc_) do { const size_t ro_ = (size_t)(cc_) * 64 * RIN; \
            _Pragma("unroll") for (int i = 0; i < 4; ++i) { const int idx = i * 512 + tid, row = idx >> 5, ch = idx & 31; rq[S_][i] = *(const u32x4*)(qb + ro_ + (size_t)row * RIN + ch * 8); rk[S_][i] = *(const u32x4*)(kb + ro_ + (size_t)row * RIN + ch * 8); } \
            if (tid < 256) rv[S_] = *(const u32x4*)(vb + ro_ + (size_t)vrow * RIN + vch * 8); \
            rp[S_] = *(const u32x4*)(pb + (size_t)(cc_) * 64 * 512); } while (0)
        rv[0] = (u32x4){0u, 0u, 0u, 0u}; rv[1] = rv[0];
        RET_LOAD(0, 0); RET_LOAD(1, 1);
        for (int c0 = 0; c0 < 128; c0 += 2) {
#pragma unroll
          for (int par = 0; par < 2; ++par) {
            const int c = c0 + par;
            LAS unsigned char* Stc = St0 + par * 16896; LAS unsigned char* Stn = St0 + (par ^ 1) * 16896;
#pragma unroll
            for (int i = 0; i < 4; ++i) { const int idx = i * 512 + tid, row = idx >> 5, ch = idx & 31; *(LAS u32x4*)(Qs + row * QS + ch * 16) = rq[par][i]; *(LAS u32x4*)(Ks + row * QS + ch * 16) = rk[par][i]; }
            if (tid < 256) {
                const u32x4 rvv = rv[par];
                *(LAS u32x4*)(Vs + vrow * VS + vch * 16) = rvv;
                u32x4 z; z.x = pk2(bflo(rvv.x) * zeta, bfhi(rvv.x) * zeta); z.y = pk2(bflo(rvv.y) * zeta, bfhi(rvv.y) * zeta);
                z.z = pk2(bflo(rvv.z) * zeta, bfhi(rvv.z) * zeta); z.w = pk2(bflo(rvv.w) * zeta, bfhi(rvv.w) * zeta);
                *(LAS u32x4*)(Vz + vrow * VS + vch * 16) = z;
            }
            *(LAS u32x4*)(Ps + prow * PS + pch * 16) = rp[par];
            LDS_BARRIER();
            if (c + 2 < 128) RET_LOAD(par, c + 2);
            f32x4 aX0 = {0.f, 0.f, 0.f, 0.f}, aX1 = {0.f, 0.f, 0.f, 0.f}, aI = {0.f, 0.f, 0.f, 0.f};
#pragma unroll
            for (int ks = 0; ks < 8; ks += 2) {
                const bf16x8 a0 = *(const LAS bf16x8*)(Qs + (lm * 16 + fr) * QS + ks * 64 + fq * 16);
                const bf16x8 s0 = *(const LAS bf16x8*)(Stc + (c2 * 16 + fr) * QS + ks * 64 + fq * 16);
                const bf16x8 a1 = *(const LAS bf16x8*)(Qs + (lm * 16 + fr) * QS + (ks + 1) * 64 + fq * 16);
                const bf16x8 s1 = *(const LAS bf16x8*)(Stc + (c2 * 16 + fr) * QS + (ks + 1) * 64 + fq * 16);
                aX0 = __builtin_amdgcn_mfma_f32_16x16x32_bf16(a0, s0, aX0, 0, 0, 0);
                aX1 = __builtin_amdgcn_mfma_f32_16x16x32_bf16(a1, s1, aX1, 0, 0, 0);
            }
#pragma unroll
            for (int ks = 0; ks < 2; ++ks) {
                const bf16x8 a = *(const LAS bf16x8*)(Ps + (lm * 16 + fr) * PS + ks * 64 + fq * 16);
                const bf16x8 bv = tr_frag(Vs, VS, ks * 32, c2 * 16, lane);
                aI = __builtin_amdgcn_mfma_f32_16x16x32_bf16(a, bv, aI, 0, 0, 0);
            }
            {
                bf16_t* ob = vb + (size_t)(c * 64) * RIN + c2 * 16 + fr;
#pragma unroll
                for (int j = 0; j < 4; ++j) { const int l = lm * 16 + fq * 4 + j; ob[(size_t)l * RIN] = (bf16_t)f2bf(aI[j] + (aX0[j] + aX1[j]) * xi[j]); }
            }
#pragma unroll
            for (int a = 0; a < 2; ++a)
#pragma unroll
                for (int cc = 0; cc < 2; ++cc) accS[a][cc] *= cdecay;
#pragma unroll
            for (int ks = 0; ks < 2; ++ks) {
                const bf16x8 ad0 = tr_frag(Ks, QS, ks * 32, (wid * 2 + 0) * 16, lane);
                const bf16x8 ad1 = tr_frag(Ks, QS, ks * 32, (wid * 2 + 1) * 16, lane);
                const bf16x8 bv0 = tr_frag(Vz, VS, ks * 32, 0, lane);
                const bf16x8 bv1 = tr_frag(Vz, VS, ks * 32, 16, lane);
                accS[0][0] = __builtin_amdgcn_mfma_f32_16x16x32_bf16(ad0, bv0, accS[0][0], 0, 0, 0);
                accS[0][1] = __builtin_amdgcn_mfma_f32_16x16x32_bf16(ad0, bv1, accS[0][1], 0, 0, 0);
                accS[1][0] = __builtin_amdgcn_mfma_f32_16x16x32_bf16(ad1, bv0, accS[1][0], 0, 0, 0);
                accS[1][1] = __builtin_amdgcn_mfma_f32_16x16x32_bf16(ad1, bv1, accS[1][1], 0, 0, 0);
            }
#pragma unroll
            for (int a = 0; a < 2; ++a)
#pragma unroll
                for (int cc = 0; cc < 2; ++cc) {
                    u32x2 w; w.x = pk2(accS[a][cc][0], accS[a][cc][1]); w.y = pk2(accS[a][cc][2], accS[a][cc][3]);
                    *(LAS u32x2*)(Stn + (cc * 16 + fr) * QS + ((wid * 2 + a) * 16 + fq * 4) * 2) = w;
                }
            LDS_BARRIER();
          }
        }
#undef RET_LOAD
    }
}

__device__ __forceinline__ void ret_gn(bf16_t* proj, const float* gnw, int wg, int G) {
    const int tid_ = otid(); const int wave = tid_ >> 6, lane = tid_ & 63;
    constexpr int NP = 4;
    for (int pair0 = (wg * 8 + wave) * NP; pair0 < T * 8; pair0 += G * 8 * NP) {
        u32x4 ov[NP], gv[NP];
#pragma unroll
        for (int q = 0; q < NP; ++q) { const int pair = pair0 + q, t = pair >> 3, h = pair & 7;
            const bf16_t* op = proj + (size_t)t * RIN + 4096 + h * 512 + lane * 8; ov[q] = *(const u32x4*)op; gv[q] = *(const u32x4*)(op + 4096); }
#pragma unroll
        for (int q = 0; q < NP; ++q) { const int pair = pair0 + q, t = pair >> 3, h = pair & 7;
            bf16_t* gp = proj + (size_t)t * RIN + 8192 + h * 512 + lane * 8;
            float o[8] = {bflo(ov[q].x), bfhi(ov[q].x), bflo(ov[q].y), bfhi(ov[q].y), bflo(ov[q].z), bfhi(ov[q].z), bflo(ov[q].w), bfhi(ov[q].w)};
            float g[8] = {bflo(gv[q].x), bfhi(gv[q].x), bflo(gv[q].y), bfhi(gv[q].y), bflo(gv[q].z), bfhi(gv[q].z), bflo(gv[q].w), bfhi(gv[q].w)};
            float s = 0.f;
#pragma unroll
            for (int e = 0; e < 8; ++e) s += o[e];
            const float mu = wave_sum(s) * (1.0f / 512.0f);
            float qq = 0.f;
#pragma unroll
            for (int e = 0; e < 8; ++e) { o[e] -= mu; qq += o[e] * o[e]; }
            const float rstd = rsqrtf(wave_sum(qq) * (1.0f / 512.0f) + 1e-5f);
            const f32x4 w0 = *(const f32x4*)(gnw + h * 512 + lane * 8), w1 = *(const f32x4*)(gnw + h * 512 + lane * 8 + 4);
            float y[8];
#pragma unroll
            for (int e = 0; e < 8; ++e) y[e] = silu(g[e]) * (o[e] * rstd) * (e < 4 ? w0[e & 3] : w1[e & 3]);
            u32x4 w; w.x = pk2(y[0], y[1]); w.y = pk2(y[2], y[3]); w.z = pk2(y[4], y[5]); w.w = pk2(y[6], y[7]);
            *(u32x4*)gp = w; }
    }
}

__device__ __forceinline__ void ssd_dt(const bf16_t* U, const bf16_t* Wdt, const float* dt_bias, const float* a_log, float* dtv, float* acv, LAS unsigned char* lds, int wg, int G) {
    const int tid = otid(), lane = tid & 63, wid = __builtin_amdgcn_readfirstlane(tid >> 6), fr = lane & 15, fq = lane >> 4;
    constexpr int QS = 528;
    LAS unsigned char* As = lds; LAS unsigned char* Bs = lds + 33792;
    LAS float* dtl = (LAS float*)(lds + 67584);
    const int lm = wid >> 1, c2 = wid & 1;
    for (int ck = wg; ck < 256; ck += G) {
        const bf16_t* ab = U + (size_t)(ck * 64) * DM;
        u32x4 ra[4], rb[4];
#define DT_LOAD(sl_) do { _Pragma("unroll") for (int i = 0; i < 4; ++i) { const int idx = i * 512 + tid, row = idx >> 5, ch = idx & 31; \
            ra[i] = *(const u32x4*)(ab + (size_t)row * DM + (sl_) * 256 + ch * 8); rb[i] = *(const u32x4*)(Wdt + (size_t)row * DM + (sl_) * 256 + ch * 8); } } while (0)
        DT_LOAD(0);
        f32x4 a0 = {0.f, 0.f, 0.f, 0.f}, a1 = {0.f, 0.f, 0.f, 0.f};
        for (int sl = 0; sl < 8; ++sl) {
#pragma unroll
            for (int i = 0; i < 4; ++i) { const int idx = i * 512 + tid, row = idx >> 5, ch = idx & 31; *(LAS u32x4*)(As + row * QS + ch * 16) = ra[i]; *(LAS u32x4*)(Bs + row * QS + ch * 16) = rb[i]; }
            LDS_BARRIER();
            if (sl + 1 < 8) DT_LOAD(sl + 1);
#pragma unroll
            for (int ks = 0; ks < 8; ++ks) {
                const bf16x8 a = *(const LAS bf16x8*)(As + (lm * 16 + fr) * QS + ks * 64 + fq * 16);
                const bf16x8 b0 = *(const LAS bf16x8*)(Bs + ((c2 * 2 + 0) * 16 + fr) * QS + ks * 64 + fq * 16);
                const bf16x8 b1 = *(const LAS bf16x8*)(Bs + ((c2 * 2 + 1) * 16 + fr) * QS + ks * 64 + fq * 16);
                a0 = __builtin_amdgcn_mfma_f32_16x16x32_bf16(a, b0, a0, 0, 0, 0);
                a1 = __builtin_amdgcn_mfma_f32_16x16x32_bf16(a, b1, a1, 0, 0, 0);
            }
            LDS_BARRIER();
        }
#undef DT_LOAD
        {
            const int h0 = (c2 * 2 + 0) * 16 + fr, h1 = h0 + 16;
            const float b0 = dt_bias[h0], b1 = dt_bias[h1];
            f32x4 d0, d1;
#pragma unroll
            for (int j = 0; j < 4; ++j) { const float x0 = a0[j] + b0, x1 = a1[j] + b1; d0[j] = x0 > 20.f ? x0 : log1pf(expf(x0)); d1[j] = x1 > 20.f ? x1 : log1pf(expf(x1)); }
            *(LAS f32x4*)(dtl + h0 * 64 + lm * 16 + fq * 4) = d0;
            *(LAS f32x4*)(dtl + h1 * 64 + lm * 16 + fq * 4) = d1;
        }
        LDS_BARRIER();
#pragma unroll
        for (int hh = 0; hh < 8; ++hh) {
            const int hd = wid * 8 + hh;
            const float dt = dtl[hd * 64 + lane];
            float sa = dt * (-expf(a_log[hd]));
#pragma unroll
            for (int o = 1; o < 64; o <<= 1) { const float tt = __shfl_up(sa, o); if (lane >= o) sa += tt; }
            dtv[((size_t)ck * 64 + hd) * 64 + lane] = dt; acv[((size_t)ck * 64 + hd) * 64 + lane] = sa;
        }
        LDS_BARRIER();
    }
}

__device__ __forceinline__ void ssd_cb(bf16_t* proj, const bf16_t* halo, const float* cw, const float* cbias, bf16_t* CBg, LAS unsigned char* lds, int wg, int G) {
    const int tid = otid(), lane = tid & 63, wid = __builtin_amdgcn_readfirstlane(tid >> 6), fr = lane & 15, fq = lane >> 4;
    constexpr int CS = 272;
    LAS unsigned char* Cs = lds; LAS unsigned char* Bs = lds + 17408; LAS unsigned char* RB = lds + 34816; LAS unsigned char* RC = lds + 53248;
    LAS float* Wl = (LAS float*)(lds + 71680);
    const int lm = wid >> 1, c2 = wid & 1;
    u32x4 rc[2], rb[2], rh; f32x4 rw;
    const int hm = tid / 48, hr = (tid % 48) >> 4, hch = tid & 15;
#define CB_LOAD(u_) do { const int g_ = (u_) & 7, bc_ = (u_) >> 3; const bf16_t* bb_ = proj + (size_t)(bc_ * 64) * SINP + 8192 + g_ * 128; \
        _Pragma("unroll") for (int i = 0; i < 2; ++i) { const int idx = i * 512 + tid, row = idx >> 4, ch = idx & 15; rb[i] = *(const u32x4*)(bb_ + (size_t)row * SINP + ch * 8); rc[i] = *(const u32x4*)(bb_ + 1024 + (size_t)row * SINP + ch * 8); } \
        rh = (u32x4){0u, 0u, 0u, 0u}; \
        if (tid < 96 && (bc_ & 127) != 0) rh = *(const u32x4*)(halo + ((size_t)(bc_ - 1) * 3 + hr) * 6144 + 4096 + hm * 1024 + g_ * 128 + hch * 8); \
        if (tid < 320) { const int m_ = tid / 160, q_ = tid % 160, tp_ = q_ >> 5, c4_ = q_ & 31; const int col_ = 4096 + m_ * 1024 + g_ * 128 + c4_ * 4; \
            rw = tp_ < 4 ? *(const f32x4*)(cw + tp_ * 6144 + col_) : *(const f32x4*)(cbias + col_); } } while (0)
    int u = wg;
    if (u < 2048) CB_LOAD(u);
    for (; u < 2048; u += G) {
        const int g = u & 7, t0 = (u >> 3) * 64;
#pragma unroll
        for (int i = 0; i < 2; ++i) { const int idx = i * 512 + tid, row = idx >> 4, ch = idx & 15; *(LAS u32x4*)(RC + (row + 3) * CS + ch * 16) = rc[i]; *(LAS u32x4*)(RB + (row + 3) * CS + ch * 16) = rb[i]; }
        if (tid < 96) *(LAS u32x4*)((hm ? RC : RB) + hr * CS + hch * 16) = rh;
        if (tid < 320) { const int m_ = tid / 160, q_ = tid % 160; *(LAS f32x4*)(Wl + m_ * 640 + (q_ >> 5) * 128 + (q_ & 31) * 4) = rw; }
        LDS_BARRIER();
        const int un = u + G;
        if (un < 2048) CB_LOAD(un);
#pragma unroll
        for (int mtx = 0; mtx < 2; ++mtx) {
            LAS unsigned char* R = mtx ? RC : RB; LAS unsigned char* O = mtx ? Cs : Bs;
            const LAS float* wl = Wl + mtx * 640;
#pragma unroll
            for (int i = 0; i < 2; ++i) {
                const int idx = i * 512 + tid, row = idx >> 4, ch = idx & 15;
                float acc8[8];
                { const f32x4 b0 = *(const LAS f32x4*)(wl + 512 + ch * 8), b1 = *(const LAS f32x4*)(wl + 512 + ch * 8 + 4);
#pragma unroll
                  for (int e = 0; e < 4; ++e) { acc8[e] = b0[e]; acc8[4 + e] = b1[e]; } }
#pragma unroll
                for (int tp = 0; tp < 4; ++tp) {
                    const u32x4 xv = *(const LAS u32x4*)(R + (row + tp) * CS + ch * 16);
                    const f32x4 w0 = *(const LAS f32x4*)(wl + tp * 128 + ch * 8), w1 = *(const LAS f32x4*)(wl + tp * 128 + ch * 8 + 4);
                    acc8[0] += w0[0] * bflo(xv.x); acc8[1] += w0[1] * bfhi(xv.x); acc8[2] += w0[2] * bflo(xv.y); acc8[3] += w0[3] * bfhi(xv.y);
                    acc8[4] += w1[0] * bflo(xv.z); acc8[5] += w1[1] * bfhi(xv.z); acc8[6] += w1[2] * bflo(xv.w); acc8[7] += w1[3] * bfhi(xv.w);
                }
                u32x4 o; o.x = pk2(silu(acc8[0]), silu(acc8[1])); o.y = pk2(silu(acc8[2]), silu(acc8[3])); o.z = pk2(silu(acc8[4]), silu(acc8[5])); o.w = pk2(silu(acc8[6]), silu(acc8[7]));
                *(LAS u32x4*)(O + row * CS + ch * 16) = o;
                *(u32x4*)(proj + (size_t)(t0 + row) * SINP + 8192 + mtx * 1024 + g * 128 + ch * 8) = o;
            }
        }
        LDS_BARRIER();
        f32x4 aW0 = {0.f, 0.f, 0.f, 0.f}, aW1 = {0.f, 0.f, 0.f, 0.f};
#pragma unroll
        for (int ks = 0; ks < 4; ++ks) {
            const bf16x8 a = *(const LAS bf16x8*)(Cs + (lm * 16 + fr) * CS + ks * 64 + fq * 16);
            const bf16x8 b0 = *(const LAS bf16x8*)(Bs + ((c2 * 2 + 0) * 16 + fr) * CS + ks * 64 + fq * 16);
            const bf16x8 b1 = *(const LAS bf16x8*)(Bs + ((c2 * 2 + 1) * 16 + fr) * CS + ks * 64 + fq * 16);
            aW0 = __builtin_amdgcn_mfma_f32_16x16x32_bf16(a, b0, aW0, 0, 0, 0);
            aW1 = __builtin_amdgcn_mfma_f32_16x16x32_bf16(a, b1, aW1, 0, 0, 0);
        }
#pragma unroll
        for (int j = 0; j < 4; ++j) { const int l = lm * 16 + fq * 4 + j;
            bf16_t* pp = CBg + ((size_t)(t0 + l) * 8 + g) * 64 + (c2 * 2) * 16 + fr;
            pp[0] = (bf16_t)f2bf(aW0[j]); pp[16] = (bf16_t)f2bf(aW1[j]); }
        LDS_BARRIER();
    }
#undef CB_LOAD
}

__device__ __forceinline__ void ssd_scan(bf16_t* proj, const bf16_t* halo, const float* cw, const float* cbias, const bf16_t* CBg, const float* dtv, const float* acv, const float* d_skip, LAS unsigned char* lds, int wg, int G) {
    const int tid = otid(), lane = tid & 63, wid = __builtin_amdgcn_readfirstlane(tid >> 6), fr = lane & 15, fq = lane >> 4;
    constexpr int CS = 272, XS = 80, WS = 144;
    LAS unsigned char* Cs = lds; LAS unsigned char* Bs = lds + 17408; LAS unsigned char* Xs = lds + 34816; LAS unsigned char* Xw = lds + 39936; LAS unsigned char* Zs = lds + 45056;
    LAS unsigned char* Ws = lds + 50176; LAS unsigned char* Sts0 = lds + 59392; LAS float* acum = (LAS float*)(lds + 76800);
    LAS float* Wx = (LAS float*)(lds + 77056);
    const int lm = wid >> 1, c2 = wid & 1;
    for (int unit = wg; unit < 256; unit += G) {
        const int grp = unit & 7, ii = unit >> 3, b = ii >> 4, hd = grp * 8 + ((ii & 15) >> 1), ph = ii & 1;
        const float dsk = d_skip[hd];
        f32x4 accT[2];
        accT[0] = (f32x4){0.f, 0.f, 0.f, 0.f}; accT[1] = (f32x4){0.f, 0.f, 0.f, 0.f};
        for (int i = tid; i < 8704 / 4; i += NTHREADS) ((LAS unsigned*)Sts0)[i] = 0u;
        const bf16_t* base = proj + (size_t)(b * SEQ) * SINP;
        const bf16_t* bb = base + 8192 + grp * 128;
        const bf16_t* cbp = base + 9216 + grp * 128;
        bf16_t* xb = (bf16_t*)base + 4096 + hd * 64 + ph * 32;
        const bf16_t* zb = base + hd * 64 + ph * 32;
        const int xrow = (tid & 255) >> 2, xch = tid & 3;
        const int wrow = tid >> 3, ws0 = (tid & 7) * 8;
        if (tid < 40) { const int tp = tid >> 3, c4 = tid & 7; const int col = hd * 64 + ph * 32 + c4 * 4; *(LAS f32x4*)(Wx + tp * 32 + c4 * 4) = tp < 4 ? *(const f32x4*)(cw + tp * 6144 + col) : *(const f32x4*)(cbias + col); }
        const bf16_t* hxb = halo + (size_t)(b * 128) * 3 * 6144 + hd * 64 + ph * 32 + xch * 8;
        const bf16_t* cgp = CBg + ((size_t)(b * SEQ + wrow) * 8 + grp) * 64 + ws0;
        const float* dtp = dtv + ((size_t)(b * 128) * 64 + hd) * 64;
        const float* acp = acv + ((size_t)(b * 128) * 64 + hd) * 64;
        u32x4 rc[2][2], rb[2][2], rxz[2], rcb[2], rxh[2][3]; f32x4 rds[2][2], ras[2][2]; float ral[2], rax[2], rdx[2], rat[2], ra0[2] = {0.f, 0.f};
#define SSD_PREFETCH(S_, cc_) do { const size_t ro_ = (size_t)(cc_) * 64 * SINP; \
            _Pragma("unroll") for (int i = 0; i < 2; ++i) { const int idx = i * 512 + tid, row = idx >> 4, ch = idx & 15; rc[S_][i] = *(const u32x4*)(cbp + ro_ + (size_t)row * SINP + ch * 8); rb[S_][i] = *(const u32x4*)(bb + ro_ + (size_t)row * SINP + ch * 8); } \
            rxz[S_] = *(const u32x4*)((tid < 256 ? (const bf16_t*)xb : zb) + ro_ + (size_t)xrow * SINP + xch * 8); \
            if (tid < 256) { _Pragma("unroll") for (int k_ = 1; k_ <= 3; ++k_) { const int r_ = xrow - k_; \
                rxh[S_][k_ - 1] = r_ >= 0 ? *(const u32x4*)(xb + ro_ + (size_t)r_ * SINP + xch * 8) : ((cc_) > 0 ? *(const u32x4*)(hxb + ((size_t)((cc_) - 1) * 3 + (3 + r_)) * 6144) : (u32x4){0u, 0u, 0u, 0u}); } } \
            rcb[S_] = *(const u32x4*)(cgp + (size_t)(cc_) * 64 * 512); \
            const float* d_ = dtp + (size_t)(cc_) * 4096; const float* a_ = acp + (size_t)(cc_) * 4096; \
            rds[S_][0] = *(const f32x4*)(d_ + ws0); rds[S_][1] = *(const f32x4*)(d_ + ws0 + 4); ras[S_][0] = *(const f32x4*)(a_ + ws0); ras[S_][1] = *(const f32x4*)(a_ + ws0 + 4); \
            ral[S_] = a_[wrow]; rax[S_] = a_[xrow]; rdx[S_] = d_[xrow]; rat[S_] = a_[63]; if (tid < 64) ra0[S_] = a_[tid]; } while (0)
        LDS_BARRIER();
        SSD_PREFETCH(0, 0);
        for (int c0 = 0; c0 < 128; c0 += 2) {
#pragma unroll
          for (int par = 0; par < 2; ++par) {
            const int c = c0 + par;
            LAS unsigned char* Stc = Sts0 + par * 8704; LAS unsigned char* Stn = Sts0 + (par ^ 1) * 8704;
#pragma unroll
            for (int i = 0; i < 2; ++i) { const int idx = i * 512 + tid, row = idx >> 4, ch = idx & 15; *(LAS u32x4*)(Cs + row * CS + ch * 16) = rc[0][i]; *(LAS u32x4*)(Bs + row * CS + ch * 16) = rb[0][i]; }
            if (tid >= 256) *(LAS u32x4*)(Zs + xrow * XS + xch * 16) = rxz[0];
            else {
                float xc[8];
                { const f32x4 b0 = *(const LAS f32x4*)(Wx + 128 + xch * 8), b1 = *(const LAS f32x4*)(Wx + 128 + xch * 8 + 4);
#pragma unroll
                  for (int e = 0; e < 4; ++e) { xc[e] = b0[e]; xc[4 + e] = b1[e]; } }
#pragma unroll
                for (int tp = 0; tp < 4; ++tp) {
                    const u32x4 xv = tp == 3 ? rxz[0] : rxh[0][2 - tp];
                    const f32x4 w0 = *(const LAS f32x4*)(Wx + tp * 32 + xch * 8), w1 = *(const LAS f32x4*)(Wx + tp * 32 + xch * 8 + 4);
                    xc[0] += w0[0] * bflo(xv.x); xc[1] += w0[1] * bfhi(xv.x); xc[2] += w0[2] * bflo(xv.y); xc[3] += w0[3] * bfhi(xv.y);
                    xc[4] += w1[0] * bflo(xv.z); xc[5] += w1[1] * bfhi(xv.z); xc[6] += w1[2] * bflo(xv.w); xc[7] += w1[3] * bfhi(xv.w);
                }
#pragma unroll
                for (int e = 0; e < 8; ++e) xc[e] = silu(xc[e]);
                u32x4 xo; xo.x = pk2(xc[0], xc[1]); xo.y = pk2(xc[2], xc[3]); xo.z = pk2(xc[4], xc[5]); xo.w = pk2(xc[6], xc[7]);
                *(LAS u32x4*)(Xs + xrow * XS + xch * 16) = xo;
                const float f = rdx[0] * __expf(rat[0] - rax[0]);
                u32x4 z; z.x = pk2(bflo(xo.x) * f, bfhi(xo.x) * f); z.y = pk2(bflo(xo.y) * f, bfhi(xo.y) * f); z.z = pk2(bflo(xo.z) * f, bfhi(xo.z) * f); z.w = pk2(bflo(xo.w) * f, bfhi(xo.w) * f);
                *(LAS u32x4*)(Xw + xrow * XS + xch * 16) = z;
            }
            {
                const u32x4 rcv = rcb[0];
                const float cv[8] = {bflo(rcv.x), bfhi(rcv.x), bflo(rcv.y), bfhi(rcv.y), bflo(rcv.z), bfhi(rcv.z), bflo(rcv.w), bfhi(rcv.w)};
                float wv[8];
#pragma unroll
                for (int e = 0; e < 8; ++e) { const float as = e < 4 ? ras[0][0][e & 3] : ras[0][1][e & 3], ds = e < 4 ? rds[0][0][e & 3] : rds[0][1][e & 3];
                    wv[e] = (wrow >= ws0 + e) ? cv[e] * __expf(ral[0] - as) * ds : 0.f; }
                u32x4 w; w.x = pk2(wv[0], wv[1]); w.y = pk2(wv[2], wv[3]); w.z = pk2(wv[4], wv[5]); w.w = pk2(wv[6], wv[7]);
                *(LAS u32x4*)(Ws + wrow * WS + ws0 * 2) = w;
            }
            if (tid < 64) acum[tid] = ra0[0];
            LDS_BARRIER();
            if (c + 1 < 128) SSD_PREFETCH(0, c + 1);
            const float atot = acum[63];
            float al[4];
#pragma unroll
            for (int j = 0; j < 4; ++j) al[j] = acum[lm * 16 + fq * 4 + j];
            f32x4 aY0 = {0.f, 0.f, 0.f, 0.f}, aY1 = {0.f, 0.f, 0.f, 0.f}, aD = {0.f, 0.f, 0.f, 0.f};
#pragma unroll
            for (int ks = 0; ks < 4; ks += 2) {
                const bf16x8 a0 = *(const LAS bf16x8*)(Cs + (lm * 16 + fr) * CS + ks * 64 + fq * 16);
                const bf16x8 s0 = *(const LAS bf16x8*)(Stc + (c2 * 16 + fr) * CS + ks * 64 + fq * 16);
                const bf16x8 a1 = *(const LAS bf16x8*)(Cs + (lm * 16 + fr) * CS + (ks + 1) * 64 + fq * 16);
                const bf16x8 s1 = *(const LAS bf16x8*)(Stc + (c2 * 16 + fr) * CS + (ks + 1) * 64 + fq * 16);
                aY0 = __builtin_amdgcn_mfma_f32_16x16x32_bf16(a0, s0, aY0, 0, 0, 0);
                aY1 = __builtin_amdgcn_mfma_f32_16x16x32_bf16(a1, s1, aY1, 0, 0, 0);
            }
#pragma unroll
            for (int ks = 0; ks < 2; ++ks) {
                const bf16x8 a = *(const LAS bf16x8*)(Ws + (lm * 16 + fr) * WS + ks * 64 + fq * 16);
                const bf16x8 bx = tr_frag(Xs, XS, ks * 32, c2 * 16, lane);
                aD = __builtin_amdgcn_mfma_f32_16x16x32_bf16(a, bx, aD, 0, 0, 0);
            }
            {
                const int pc = c2 * 16 + fr;
                bf16_t* ob = xb + (size_t)(c * 64) * SINP + pc;
#pragma unroll
                for (int j = 0; j < 4; ++j) { const int l = lm * 16 + fq * 4 + j;
                    const float xv = bf2f(*(const LAS bf16_t*)(Xs + l * XS + pc * 2)), zv = bf2f(*(const LAS bf16_t*)(Zs + l * XS + pc * 2));
                    const float y = aD[j] + (aY0[j] + aY1[j]) * __expf(al[j]) + dsk * xv;
                    ob[(size_t)l * SINP] = (bf16_t)f2bf(y * silu(zv)); }
            }
            const float sdec = __expf(atot);
            accT[0] *= sdec; accT[1] *= sdec;
#pragma unroll
            for (int ks = 0; ks < 2; ++ks) {
                const bf16x8 an_ = tr_frag(Bs, CS, ks * 32, wid * 16, lane);
                const bf16x8 bp0 = tr_frag(Xw, XS, ks * 32, 0, lane);
                const bf16x8 bp1 = tr_frag(Xw, XS, ks * 32, 16, lane);
                accT[0] = __builtin_amdgcn_mfma_f32_16x16x32_bf16(an_, bp0, accT[0], 0, 0, 0);
                accT[1] = __builtin_amdgcn_mfma_f32_16x16x32_bf16(an_, bp1, accT[1], 0, 0, 0);
            }
#pragma unroll
            for (int pi = 0; pi < 2; ++pi) {
                u32x2 w; w.x = pk2(accT[pi][0], accT[pi][1]); w.y = pk2(accT[pi][2], accT[pi][3]);
                *(LAS u32x2*)(Stn + (pi * 16 + fr) * CS + (wid * 16 + fq * 4) * 2) = w;
            }
            LDS_BARRIER();
          }
        }
#undef SSD_PREFETCH
    }
}

__device__ __forceinline__ void ssd_norm(bf16_t* proj, const float* nw, int wg, int G) {
    const int tid_ = otid(); const int wave = tid_ >> 6, lane = tid_ & 63;
    constexpr int NP = 4;
    for (int pair0 = (wg * 8 + wave) * NP; pair0 < T * 8; pair0 += G * 8 * NP) {
        u32x4 yv[NP];
#pragma unroll
        for (int q = 0; q < NP; ++q) { const int pair = pair0 + q, t = pair >> 3, gr = pair & 7; yv[q] = *(const u32x4*)(proj + (size_t)t * SINP + 4096 + gr * 512 + lane * 8); }
#pragma unroll
        for (int q = 0; q < NP; ++q) { const int pair = pair0 + q, t = pair >> 3, gr = pair & 7;
            bf16_t* yp = proj + (size_t)t * SINP + 4096 + gr * 512 + lane * 8;
            float y[8] = {bflo(yv[q].x), bfhi(yv[q].x), bflo(yv[q].y), bfhi(yv[q].y), bflo(yv[q].z), bfhi(yv[q].z), bflo(yv[q].w), bfhi(yv[q].w)};
            float qq = 0.f;
#pragma unroll
            for (int e = 0; e < 8; ++e) qq += y[e] * y[e];
            const float r = rsqrtf(wave_sum(qq) * (1.0f / 512.0f) + 1e-6f);
            const f32x4 w0 = *(const f32x4*)(nw + gr * 512 + lane * 8), w1 = *(const f32x4*)(nw + gr * 512 + lane * 8 + 4);
            u32x4 w; w.x = pk2(y[0] * r * w0[0], y[1] * r * w0[1]); w.y = pk2(y[2] * r * w0[2], y[3] * r * w0[3]);
            w.z = pk2(y[4] * r * w1[0], y[5] * r * w1[1]); w.w = pk2(y[6] * r * w1[2], y[7] * r * w1[3]);
            *(u32x4*)yp = w; }
    }
}

#define XB_TMO      128
#define XB_XCNT(j)  (256  + 64 * (j))
#define XB_XSUB(j)  (1280 + 64 * (j))
#define XB_XGEN(j)  (2304 + 64 * (j))
#define XB_TOP      3328
#define XB_TOPGEN   3392
#define XCD_BAR_WORDS 3456
#define XB_SPIN_CAP (1u << 18)
__device__ __forceinline__ unsigned xb_ld(unsigned* p)              { return __hip_atomic_load(p, __ATOMIC_RELAXED, __HIP_MEMORY_SCOPE_AGENT); }
__device__ __forceinline__ unsigned xb_add(unsigned* p, unsigned v) { return __hip_atomic_fetch_add(p, v, __ATOMIC_RELAXED, __HIP_MEMORY_SCOPE_AGENT); }
__device__ __forceinline__ unsigned xb_xcc_id() { return (unsigned)__builtin_amdgcn_s_getreg((3 << 11) | 20) & 0xFu; }
#define XB_SPIN(cond, bar) do { unsigned _sp = 0; while (cond) { __builtin_amdgcn_s_sleep(1); \
    if ((++_sp & 255u) == 0u) { if (xb_ld(&(bar)[XB_TMO])) break; if (_sp > XB_SPIN_CAP) { atomicAdd(&(bar)[XB_TMO], 1u); break; } } } } while (0)
struct XcdBarrier { unsigned* bar; unsigned x; volatile LAS unsigned* st; };
__device__ __forceinline__ XcdBarrier xcd_barrier_post(unsigned* bar, volatile LAS unsigned* st) {
    XcdBarrier b; b.bar = bar; b.x = xb_xcc_id(); b.st = st;
    if (threadIdx.x == 0) (void)xb_add(&bar[XB_XCNT(b.x)], 1u);
    return b;
}
__device__ __forceinline__ void xcd_barrier_complete(unsigned* bar, unsigned x, unsigned& nloc, unsigned& nx) {
    const unsigned G = gridDim.x * gridDim.y * gridDim.z;
    unsigned sum, cnt, mine, sp = 0u;
    for (;;) {
        sum = 0u; cnt = 0u; mine = 0u;
#pragma unroll
        for (unsigned j = 0; j < 16; ++j) { const unsigned c = xb_ld(&bar[XB_XCNT(j)]); sum += c; cnt += (c > 0u) ? 1u : 0u; mine = (j == x) ? c : mine; }
        if (sum == G) break;
        __builtin_amdgcn_s_sleep(1);
        if ((++sp & 255u) == 0u) { if (xb_ld(&bar[XB_TMO])) break; if (sp > XB_SPIN_CAP) { atomicAdd(&bar[XB_TMO], 1u); break; } }
    }
    nloc = mine > 0u ? mine : 1u; nx = cnt > 0u ? cnt : 1u;
}
__device__ __forceinline__ void xcd_barrier(const XcdBarrier& b) {
    asm volatile("s_waitcnt vmcnt(0)" ::: "memory");
    __syncthreads();
    if (threadIdx.x == 0) {
        unsigned* bar = b.bar;
        __builtin_amdgcn_s_waitcnt(0);
        unsigned nloc = b.st[0], nx = b.st[1];
        if (nloc == 0u) { xcd_barrier_complete(bar, b.x, nloc, nx); b.st[0] = nloc; b.st[1] = nx; }
        const unsigned old = xb_add(&bar[XB_XSUB(b.x)], 1u);
        const unsigned gen = old / nloc;
        if (old + 1u == (gen + 1u) * nloc) {
            __builtin_amdgcn_fence(__ATOMIC_RELEASE, "agent");
            asm volatile("s_waitcnt vmcnt(0)" ::: "memory");
            const unsigned og = xb_add(&bar[XB_TOP], 1u);
            const unsigned tg = og / nx;
            if (og + 1u == (tg + 1u) * nx) xb_add(&bar[XB_TOPGEN], 1u);
            else XB_SPIN(xb_ld(&bar[XB_TOPGEN]) == tg, bar);
            __builtin_amdgcn_fence(__ATOMIC_ACQUIRE, "agent");
            xb_add(&bar[XB_XGEN(b.x)], 1u);
            asm volatile("s_waitcnt vmcnt(0)" ::: "memory");
        } else {
            XB_SPIN(xb_ld(&bar[XB_XGEN(b.x)]) == gen, bar);
            __builtin_amdgcn_fence(__ATOMIC_ACQUIRE, "agent");
            asm volatile("s_waitcnt vmcnt(0)" ::: "memory");
        }
    }
    __syncthreads();
}

struct Params {
    const float* x; const float* nmp; const float* nmq; const float* nfp; const float* nfq;
    const float* ret_w_in; const float* ret_gn_w; const float* ret_w_out;
    const float* ssd_w_in; const float* conv_w; const float* conv_b; const float* dt_bias; const float* a_log; const float* d_skip; const float* ssd_norm_w; const float* ssd_w_out;
    const float* w_up; const float* w_down;
    float* out; unsigned char* ws;
};


__global__ void __launch_bounds__(NTHREADS, 2) mega(Params p) {
    extern __shared__ __attribute__((aligned(16))) unsigned char lds_raw[];
    LAS unsigned char* lds = (LAS unsigned char*)lds_raw;
    cg::grid_group grid = cg::this_grid();
    const int G = gridDim.x, wg = blockIdx.x;
    bf16_t* WA = (bf16_t*)(p.ws + OFF_WA); bf16_t* WB = (bf16_t*)(p.ws + OFF_WB);
    bf16_t* ACT = (bf16_t*)(p.ws + OFF_ACT); bf16_t* U_ACT = (bf16_t*)(p.ws + OFF_ACT + HID_BYTES); bf16_t* F_ACT = (bf16_t*)(p.ws + OFF_ACT + HID_BYTES);
    bf16_t* U_R2 = (bf16_t*)(p.ws + OFF_R2); bf16_t* MF_R2 = (bf16_t*)(p.ws + OFF_R2);
    float* ROT = (float*)(p.ws + OFF_ROT); bf16_t* HALO = (bf16_t*)(p.ws + OFF_HALO); float* DTV = (float*)(p.ws + OFF_DTV); float* ACV = (float*)(p.ws + OFF_ACV); bf16_t* CBG = (bf16_t*)(p.ws + OFF_CBG); bf16_t* PG = (bf16_t*)p.out; bf16_t* HB1 = (bf16_t*)p.out; bf16_t* HB2 = (bf16_t*)(p.ws + OFF_ACT + HID_BYTES + 67108864);

#define GEMM(KIND, ...) do { const pg8::Gemm gd = pg8::Gemm{__VA_ARGS__}; pg8::StaticOrder S; S.init(gd.M, gd.N, G, wg); pg8::gemm_phase<KIND>(lds, gd, S); GSYNC(); } while (0)
    unsigned* barw = (unsigned*)(p.ws + OFF_BAR);
    volatile LAS unsigned* bst = (volatile LAS unsigned*)(lds + LDS_STAGE);
    if (threadIdx.x < 2) bst[threadIdx.x] = 0u;
    if (p.ws == nullptr) grid.sync();
    const XcdBarrier xb = xcd_barrier_post(barw, bst);
#define GSYNC() xcd_barrier(xb)
    norm_pass(NormDesc{0, p.x, nullptr, nullptr, nullptr, p.nmp, U_R2, 0, 0}, wg, G);
    convert_w(ConvDesc{p.ret_w_in, WA, 2048, RIN, RIN, 1}, lds, wg, G);
    convert_w(ConvDesc{p.ret_w_out, WB, 4096, 2048, 2048, 0}, lds, wg, G);
    rot_table(ROT, wg, G);
    GSYNC();
    GEMM(3, U_R2, WA, T, RIN, 2048, 2048, 3, ACT, RIN, ROT);
    ret_pre(ACT, PG, lds, wg, G); GSYNC();
    ret_scan(ACT, PG, lds, wg, G); GSYNC();
    ret_gn(ACT, p.ret_gn_w, wg, G); GSYNC();
    GEMM(1, ACT + 8192, WB, T, 2048, 4096, RIN, 1, MF_R2, 2048, nullptr);
    norm_pass(NormDesc{1, MF_R2, p.x, HB1, p.nmq, p.nfp, U_ACT, 0, 1}, wg, G);
    convert_w(ConvDesc{p.w_up, WA, 2048, DFF, DFF, 0}, lds, wg, G);
    convert_w(ConvDesc{p.w_down, WB, DFF, 2048, 2048, 0}, lds, wg, G);
    GSYNC();
    GEMM(2, U_ACT, WA, T, DFF, 2048, 2048, 2, ACT, DFF, nullptr);
    GEMM(1, ACT, WB, T, 2048, DFF, DFF, 1, F_ACT, 2048, nullptr);
    norm_pass(NormDesc{1, F_ACT, HB1, HB1, p.nfq, p.nmp + DM, U_R2, 1, 1}, wg, G);
    convert_w(ConvDesc{p.ssd_w_in, WA, 2048, SIN, SINW, 0}, lds, wg, G);
    convert_w(ConvDesc{p.ssd_w_out, WB, 4096, 2048, 2048, 0}, lds, wg, G);
    GSYNC();
    GEMM(5, U_R2, WA, T, SING, 2048, 2048, 5, ACT, SINP, (const float*)HALO);
    ssd_dt(U_R2, WA + (size_t)SING * 2048, p.dt_bias, p.a_log, DTV, ACV, lds, wg, G);
    ssd_cb(ACT, HALO, p.conv_w, p.conv_b, CBG, lds, wg, G); GSYNC();
    ssd_scan(ACT, HALO, p.conv_w, p.conv_b, CBG, DTV, ACV, p.d_skip, lds, wg, G); GSYNC();
    ssd_norm(ACT, p.ssd_norm_w, wg, G); GSYNC();
    GEMM(1, ACT + 4096, WB, T, 2048, 4096, SINP, 1, MF_R2, 2048, nullptr);
    norm_pass(NormDesc{1, MF_R2, HB1, HB2, p.nmq + DM, p.nfp + DM, U_ACT, 1, 1}, wg, G);
    convert_w(ConvDesc{p.w_up + (size_t)2048 * DFF, WA, 2048, DFF, DFF, 0}, lds, wg, G);
    convert_w(ConvDesc{p.w_down + (size_t)DFF * 2048, WB, DFF, 2048, 2048, 0}, lds, wg, G);
    GSYNC();
    GEMM(2, U_ACT, WA, T, DFF, 2048, 2048, 2, ACT, DFF, nullptr);
    GEMM(1, ACT, WB, T, 2048, DFF, DFF, 1, F_ACT, 2048, nullptr);
    norm_pass(NormDesc{2, F_ACT, HB2, p.out, p.nfq + DM, nullptr, nullptr, 1, 0}, wg, G);
#undef GEMM
#undef GSYNC
}

extern "C" void kernel_launch(void* const* d_in, const int* in_sizes, int n_in, void* d_out, int out_size, void* d_ws, size_t ws_size, hipStream_t stream) {
    static int grid_blocks = 0;
    if (!grid_blocks) {
        int dev = 0, cus = 0, per_cu = 0;
        hipGetDevice(&dev);
        hipDeviceGetAttribute(&cus, hipDeviceAttributeMultiprocessorCount, dev);
        hipFuncSetAttribute((const void*)mega, hipFuncAttributeMaxDynamicSharedMemorySize, LDS_BYTES);
        hipOccupancyMaxActiveBlocksPerMultiprocessor(&per_cu, (const void*)mega, NTHREADS, LDS_BYTES);
        if (per_cu < 1) per_cu = 1;
        grid_blocks = cus * per_cu;
        if (ws_size < WS_END) { fprintf(stderr, "kernel_launch: workspace too small: %zu < %zu\n", ws_size, (size_t)WS_END); grid_blocks = -1; }
    }
    if (grid_blocks < 0) return;
    Params p{};
    p.x = (const float*)d_in[0]; p.nmp = (const float*)d_in[1]; p.nmq = (const float*)d_in[2]; p.nfp = (const float*)d_in[3]; p.nfq = (const float*)d_in[4];
    p.ret_w_in = (const float*)d_in[5]; p.ret_gn_w = (const float*)d_in[6]; p.ret_w_out = (const float*)d_in[7];
    p.ssd_w_in = (const float*)d_in[8]; p.conv_w = (const float*)d_in[9]; p.conv_b = (const float*)d_in[10]; p.dt_bias = (const float*)d_in[11];
    p.a_log = (const float*)d_in[12]; p.d_skip = (const float*)d_in[13]; p.ssd_norm_w = (const float*)d_in[14]; p.ssd_w_out = (const float*)d_in[15];
    p.w_up = (const float*)d_in[16]; p.w_down = (const float*)d_in[17];
    p.out = (float*)d_out; p.ws = (unsigned char*)d_ws;
    void* args[] = {&p};
    (void)hipMemsetAsync((char*)d_ws + OFF_BAR, 0, XCD_BAR_WORDS * sizeof(unsigned), stream);
    hipError_t e = hipLaunchCooperativeKernel((const void*)mega, dim3(grid_blocks), dim3(NTHREADS), args, LDS_BYTES, stream);
    if (e != hipSuccess) fprintf(stderr, "cooperative launch failed: %s (grid %d)\n", hipGetErrorString(e), grid_blocks);
}
```
